# Optimizing an MI355X kernel written in HIP

```python
import math
import jax, jax.numpy as jnp
from jax import lax
import numpy as np

D_MODEL = 2048
BATCH = 4
SEQ = 4096
DEPTH = 1

HEAD_DIM = 128
A_Q_HEADS = 8
A_KV_HEADS = 2
B_Q_HEADS = 8
B_KV_HEADS = 2
D_MIX = (A_Q_HEADS + B_Q_HEADS) * HEAD_DIM
QKV_A = (A_Q_HEADS + 2 * A_KV_HEADS) * HEAD_DIM
QKV_B = (B_Q_HEADS + 2 * B_KV_HEADS) * HEAD_DIM
D_IN = QKV_A + QKV_B
BLOCK = 128
WINDOW = 128
GRID_W = 64
ROPE_THETA = 10000.0
ROPE_AXIS_DIM = HEAD_DIM // 2
N_BUCKETS = 32
MAX_DISTANCE = 128
N_EXPERTS = 16
CAPACITY_FACTOR = 2
D_EXPERT = 2048
EPS = 1e-6

kernel_name = "hybrid_axialgqa_swagqa_ecmoe_layer"


def rms_norm(x, g):
    x32 = x.astype(jnp.float32)
    y = x32 * lax.rsqrt(jnp.mean(x32 * x32, axis=-1, keepdims=True) + EPS)
    return (y * g.astype(jnp.float32)).astype(x.dtype)


def modulate(h, shift, scale):
    return h * (1.0 + scale[:, None, :]) + shift[:, None, :]


def axial_rope_tables(S):
    rows = S // GRID_W
    row = jnp.repeat(jnp.arange(rows, dtype=jnp.float32), GRID_W)
    col = jnp.tile(jnp.arange(GRID_W, dtype=jnp.float32), rows)
    inv = 1.0 / (ROPE_THETA ** (jnp.arange(0, ROPE_AXIS_DIM, 2, dtype=jnp.float32) / ROPE_AXIS_DIM))
    ang_r = row[:, None] * inv[None, :]
    ang_c = col[:, None] * inv[None, :]
    return jnp.cos(ang_r), jnp.sin(ang_r), jnp.cos(ang_c), jnp.sin(ang_c)


def rope_half(x, cos, sin):
    n = x.shape[-1] // 2
    x1, x2 = x[..., :n], x[..., n:]
    cos = cos[None, :, None, :]
    sin = sin[None, :, None, :]
    return jnp.concatenate([x1 * cos - x2 * sin, x2 * cos + x1 * sin], axis=-1)


def apply_axial_rope(x, tables):
    cr, sr, cc, sc = tables
    x32 = x.astype(jnp.float32)
    out = jnp.concatenate([rope_half(x32[..., :ROPE_AXIS_DIM], cr, sr),
                           rope_half(x32[..., ROPE_AXIS_DIM:], cc, sc)], axis=-1)
    return out.astype(x.dtype)


def t5_bucket(rel):
    nb = N_BUCKETS // 2
    ret = jnp.where(rel > 0, nb, 0)
    n = jnp.abs(rel)
    max_exact = nb // 2
    nf = jnp.maximum(n, 1).astype(jnp.float32)
    large = max_exact + (jnp.log(nf / max_exact) / math.log(MAX_DISTANCE / max_exact)
                         * (nb - max_exact)).astype(jnp.int32)
    large = jnp.minimum(large, nb - 1)
    return ret + jnp.where(n < max_exact, n, large)


def global_axial_gqa(q, k, v):
    B, S, Hq, d = q.shape
    Hkv = k.shape[2]
    G = Hq // Hkv
    nblk = S // BLOCK
    scale = 1.0 / math.sqrt(d)
    qb = q.reshape(B, nblk, BLOCK, Hkv, G, d).transpose(1, 0, 3, 4, 2, 5)
    kt = k.transpose(0, 2, 1, 3)
    vt = v.transpose(0, 2, 1, 3)

    def one_block(qi):
        s = jnp.einsum('bhgqd,bhkd->bhgqk', qi, kt).astype(jnp.float32) * scale
        p = jax.nn.softmax(s, axis=-1)
        return jnp.einsum('bhgqk,bhkd->bhgqd', p.astype(vt.dtype), vt)

    o = lax.map(one_block, qb)
    return o.transpose(1, 0, 4, 2, 3, 5).reshape(B, S, Hq * d)


def windowed_sink_gqa(q, k, v, rel_bias, sink):
    B, S, Hq, d = q.shape
    Hkv = k.shape[2]
    G = Hq // Hkv
    nblk = S // BLOCK
    scale = 1.0 / math.sqrt(d)
    qb = q.reshape(B, nblk, BLOCK, Hkv, G, d).transpose(0, 3, 4, 1, 2, 5)

    def band(t):
        tp = jnp.pad(t.transpose(0, 2, 1, 3), ((0, 0), (0, 0), (BLOCK, BLOCK), (0, 0)))
        tb = tp.reshape(B, Hkv, nblk + 2, BLOCK, d)
        return jnp.concatenate([tb[:, :, :-2], tb[:, :, 1:-1], tb[:, :, 2:]], axis=3)

    kw, vw = band(k), band(v)
    m = jnp.arange(3 * BLOCK)
    j = jnp.arange(BLOCK)
    rel = m[None, :] - BLOCK - j[:, None]
    kpos = jnp.arange(nblk)[:, None, None] * BLOCK - BLOCK + m[None, None, :]
    valid = (jnp.abs(rel) <= WINDOW)[None] & (kpos >= 0) & (kpos < S)
    bias = rel_bias.astype(jnp.float32)[t5_bucket(rel)]
    bias = bias.transpose(2, 0, 1).reshape(Hkv, G, BLOCK, 3 * BLOCK)

    s = jnp.einsum('bhgnqd,bhnkd->bhgnqk', qb, kw).astype(jnp.float32) * scale
    s = s + bias[None, :, :, None, :, :]
    s = jnp.where(valid[None, None, None], s, -1e30)
    sink_col = jnp.broadcast_to(sink.astype(jnp.float32).reshape(1, Hkv, G, 1, 1, 1),
                                s.shape[:-1] + (1,))
    p = jax.nn.softmax(jnp.concatenate([s, sink_col], axis=-1), axis=-1)[..., :-1]
    o = jnp.einsum('bhgnqk,bhnkd->bhgnqd', p.astype(vw.dtype), vw)
    return o.transpose(0, 3, 4, 1, 2, 5).reshape(B, S, Hq * d)


def expert_choice_moe(h, w_router, w_gate, w_up, w_down):
    B, S, D = h.shape
    C = CAPACITY_FACTOR * S // N_EXPERTS
    logits = jnp.einsum('bsd,de->bse', h, w_router).astype(jnp.float32)
    aff = jax.nn.softmax(logits, axis=-1)
    g, idx = lax.top_k(aff.transpose(0, 2, 1), C)
    xg = jax.vmap(lambda hb, ib: hb[ib])(h, idx)
    a = jnp.einsum('becd,edf->becf', xg, w_gate)
    u = jnp.einsum('becd,edf->becf', xg, w_up)
    y = jnp.einsum('becf,efd->becd', jax.nn.silu(a) * u, w_down)
    y = y * g[..., None].astype(y.dtype)
    return jax.vmap(lambda yb, ib: jnp.zeros((S, D), yb.dtype).at[ib.reshape(-1)].add(yb.reshape(-1, D)))(y, idx)


def setup_inputs(seed: int = 0) -> dict:
    key = jax.random.key(seed)
    ks = jax.random.split(key, 20)
    f32 = jnp.float32
    nrm = lambda k, shape, s: jax.random.normal(k, shape, f32) * s
    return {
        "x": nrm(ks[0], (BATCH, SEQ, D_MODEL), 1.0),
        "c": nrm(ks[1], (BATCH, D_MODEL), 1.0),
        "w_ada": nrm(ks[2], (D_MODEL, 6 * D_MODEL), 0.5 * D_MODEL ** -0.5),
        "b_ada": nrm(ks[3], (6 * D_MODEL,), 0.02),
        "g_norm1": 1.0 + nrm(ks[4], (D_MODEL,), 0.02),
        "w_in": nrm(ks[5], (D_MODEL, D_IN), D_MODEL ** -0.5),
        "qn_a": 1.0 + nrm(ks[6], (HEAD_DIM,), 0.02),
        "kn_a": 1.0 + nrm(ks[7], (HEAD_DIM,), 0.02),
        "qn_b": 1.0 + nrm(ks[8], (HEAD_DIM,), 0.02),
        "kn_b": 1.0 + nrm(ks[9], (HEAD_DIM,), 0.02),
        "sink_b": nrm(ks[10], (B_Q_HEADS,), 0.5),
        "rel_bias": nrm(ks[11], (N_BUCKETS, B_Q_HEADS), 0.1),
        "w_out": nrm(ks[12], (D_MIX, D_MODEL), D_MIX ** -0.5),
        "g_norm2": 1.0 + nrm(ks[13], (D_MODEL,), 0.02),
        "w_router": nrm(ks[14], (D_MODEL, N_EXPERTS), D_MODEL ** -0.5),
        "w_gate": nrm(ks[15], (N_EXPERTS, D_MODEL, D_EXPERT), D_MODEL ** -0.5),
        "w_up": nrm(ks[16], (N_EXPERTS, D_MODEL, D_EXPERT), D_MODEL ** -0.5),
        "w_down": nrm(ks[17], (N_EXPERTS, D_EXPERT, D_MODEL), D_EXPERT ** -0.5),
    }


def reference(x, c, w_ada, b_ada, g_norm1, w_in, qn_a, kn_a, qn_b, kn_b, sink_b,
              rel_bias, w_out, g_norm2, w_router, w_gate, w_up, w_down):
    B, S, D = x.shape
    tables = axial_rope_tables(S)
    oq = A_Q_HEADS * HEAD_DIM
    okv = A_KV_HEADS * HEAD_DIM
    bq = B_Q_HEADS * HEAD_DIM
    bkv = B_KV_HEADS * HEAD_DIM
    for _ in range(DEPTH):
        mod = jnp.einsum('bd,de->be', jax.nn.silu(c), w_ada) + b_ada
        sh1, sc1, gt1, sh2, sc2, gt2 = jnp.split(mod, 6, axis=-1)

        h = modulate(rms_norm(x, g_norm1), sh1, sc1)
        z = jnp.einsum('bsd,de->bse', h, w_in)
        qa = z[..., :oq].reshape(B, S, A_Q_HEADS, HEAD_DIM)
        ka = z[..., oq:oq + okv].reshape(B, S, A_KV_HEADS, HEAD_DIM)
        va = z[..., oq + okv:QKV_A].reshape(B, S, A_KV_HEADS, HEAD_DIM)
        zb = z[..., QKV_A:]
        qb = zb[..., :bq].reshape(B, S, B_Q_HEADS, HEAD_DIM)
        kb = zb[..., bq:bq + bkv].reshape(B, S, B_KV_HEADS, HEAD_DIM)
        vb = zb[..., bq + bkv:].reshape(B, S, B_KV_HEADS, HEAD_DIM)

        qa = apply_axial_rope(rms_norm(qa, qn_a), tables)
        ka = apply_axial_rope(rms_norm(ka, kn_a), tables)
        oa = global_axial_gqa(qa, ka, va)

        qb = rms_norm(qb, qn_b)
        kb = rms_norm(kb, kn_b)
        ob = windowed_sink_gqa(qb, kb, vb, rel_bias, sink_b)

        mix = jnp.einsum('bse,ed->bsd', jnp.concatenate([oa, ob], axis=-1), w_out)
        x = x + gt1[:, None, :] * mix

        h2 = modulate(rms_norm(x, g_norm2), sh2, sc2)
        x = x + gt2[:, None, :] * expert_choice_moe(h2, w_router, w_gate, w_up, w_down)
    return x
```

```cpp
#include <hip/hip_runtime.h>
#include <hip/hip_bf16.h>
#include <cstdio>
#include <cstdint>

#ifndef MK_PER_PHASE
#define MK_PER_PHASE 0
#endif

namespace pg8 {
#define PG8_LAS __attribute__((address_space(3)))
typedef unsigned short bf16_t;
typedef short bf16x8 __attribute__((ext_vector_type(8)));
typedef float f32x4 __attribute__((ext_vector_type(4)));
typedef unsigned u32x4 __attribute__((ext_vector_type(4)));
constexpr int BM = 256, BK = 64, HALF = 128, HTB = HALF * BK * 2, STAGE_BYTES = 8 * HTB, NXCD = 8, WGM = 8;

__host__ __device__ __forceinline__ int lds_byte(int r, int c) { const int st = (r >> 4) * 2 + (c >> 5), rr = r & 15, cc = c & 31, ob = rr * 64 + cc * 2; return st * 1024 + (ob ^ (((ob >> 9) & 1) << 5)); }
__host__ __device__ __forceinline__ void stage_rc(int b, int& R, int& C) { const int st = b / 1024, sb = b % 1024, swz = sb ^ (((sb >> 9) & 1) << 5); R = (st >> 1) * 16 + swz / 64; C = (st & 1) * 32 + (swz % 64) / 2; }
__host__ __device__ __forceinline__ int perm32(int rho) { const int n = rho >> 4, i = rho & 15; return 8 * (i >> 2) + 4 * n + (i & 3); }

struct Unit { int pm, pn; };
struct Gemm { const bf16_t* A; const bf16_t* Bt; int M, N, K; };

struct StaticOrder {
    int nM, nN, nwg, G, c;
    __host__ __device__ void init(int M, int N, int G_, int c_) { nM = M / BM; nN = N / BM; nwg = nM * nN; G = G_; c = c_; }
    __host__ __device__ bool next(int i, Unit& u) const {
        const long L = (long)i * G + c; if (L >= nwg) return false;
        int wgid = (int)L; { const int q = nwg / NXCD, r = nwg % NXCD, xcd = wgid % NXCD, off = wgid / NXCD; wgid = (xcd < r ? xcd * (q + 1) : r * (q + 1) + (xcd - r) * q) + off; }
        const int nig = WGM * nN, gid = wgid / nig, fm = gid * WGM, gsz = (nM - fm) < WGM ? (nM - fm) : WGM;
        u.pm = fm + ((wgid % nig) % gsz); u.pn = (wgid % nig) / gsz; return true;
    }
    __device__ __forceinline__ void a_ready(const Unit&) const {}
    __device__ __forceinline__ void done(const Unit&) const {}
};
struct OrderGU {
    int G, c;
    __device__ bool next(int i, Unit& u) const { const int L = i * G + c; if (L >= 2048) return false; const int e = L >> 7, j = L & 127, x = j & 7, jj = j >> 3;
        u.pm = e * 8 + (x >> 2) * 4 + (jj >> 2); u.pn = e * 16 + (x & 3) * 4 + (jj & 3); return true; }
    __device__ __forceinline__ void a_ready(const Unit&) const {}
    __device__ __forceinline__ void done(const Unit&) const {}
};
struct OrderDN {
    int G, c;
    __device__ bool next(int i, Unit& u) const { const int L = i * G + c; if (L >= 1024) return false; const int e = L >> 6, j = L & 63, x = j & 7, jj = j >> 3;
        u.pm = e * 8 + (x >> 1) * 2 + (jj >> 2); u.pn = e * 8 + (x & 1) * 4 + (jj & 3); return true; }
    __device__ __forceinline__ void a_ready(const Unit&) const {}
    __device__ __forceinline__ void done(const Unit&) const {}
};

__device__ __forceinline__ unsigned cvt_pk_bf16(float lo, float hi) { unsigned r; asm volatile("v_cvt_pk_bf16_f32 %0, %1, %2" : "=v"(r) : "v"(lo), "v"(hi)); return r; }

struct EpiZ {
    static constexpr bool PERM = true, AFTER_DRAIN = false;
    bf16_t* O; int ldc;
    __device__ __forceinline__ void operator()(const f32x4 (&acc)[2][2][4][2], const Unit& u, int wr, int wc, int fr, int fq) const {
        const int row0 = u.pm * BM + wr * 64 + fr, col0 = u.pn * BM + wc * 32 + 8 * fq;
#pragma unroll
        for (int ai = 0; ai < 2; ++ai)
#pragma unroll
            for (int m = 0; m < 4; ++m) { bf16_t* rowp = O + (size_t)(row0 + ai * HALF + m * 16) * ldc + col0;
#pragma unroll
                for (int bj = 0; bj < 2; ++bj) { const f32x4 v0 = acc[ai][bj][m][0], v1 = acc[ai][bj][m][1];
                    u32x4 w; w.x = cvt_pk_bf16(v0[0], v0[1]); w.y = cvt_pk_bf16(v0[2], v0[3]); w.z = cvt_pk_bf16(v1[0], v1[1]); w.w = cvt_pk_bf16(v1[2], v1[3]);
                    *(u32x4*)(rowp + bj * HALF) = w; } }
    }
};
struct EpiX1 {
    static constexpr bool PERM = true, AFTER_DRAIN = false;
    const float* x; float* out; const float* gate;
    __device__ __forceinline__ void operator()(const f32x4 (&acc)[2][2][4][2], const Unit& u, int wr, int wc, int fr, int fq) const {
        const int row0 = u.pm * BM + wr * 64 + fr, col0 = u.pn * BM + wc * 32 + 8 * fq, b = u.pm >> 4;
        f32x4 gv[2][2];
#pragma unroll
        for (int bj = 0; bj < 2; ++bj)
#pragma unroll
            for (int n = 0; n < 2; ++n) gv[bj][n] = *(const f32x4*)(gate + (size_t)b * 12288 + col0 + bj * HALF + 4 * n);
#pragma unroll
        for (int ai = 0; ai < 2; ++ai)
#pragma unroll
            for (int m = 0; m < 4; ++m) { const size_t ro = (size_t)(row0 + ai * HALF + m * 16) * 2048 + col0;
#pragma unroll
                for (int bj = 0; bj < 2; ++bj)
#pragma unroll
                    for (int n = 0; n < 2; ++n) { const f32x4 xi = *(const f32x4*)(x + ro + bj * HALF + 4 * n);
                        *(f32x4*)(out + ro + bj * HALF + 4 * n) = xi + gv[bj][n] * acc[ai][bj][m][n]; } }
    }
};
struct EpiSwiGLU {
    static constexpr bool PERM = true, AFTER_DRAIN = false;
    bf16_t* O;
    __device__ __forceinline__ void operator()(const f32x4 (&acc)[2][2][4][2], const Unit& u, int wr, int wc, int fr, int fq) const {
        const int row0 = u.pm * BM + wr * 64 + fr, col0 = (u.pn & 15) * HALF + wc * 32 + 8 * fq;
#pragma unroll
        for (int ai = 0; ai < 2; ++ai)
#pragma unroll
            for (int m = 0; m < 4; ++m) { bf16_t* rowp = O + (size_t)(row0 + ai * HALF + m * 16) * 2048 + col0;
                float r[8];
#pragma unroll
                for (int n = 0; n < 2; ++n)
#pragma unroll
                    for (int i = 0; i < 4; ++i) { const float a = acc[ai][0][m][n][i], uu = acc[ai][1][m][n][i];
                        const float sg = __builtin_amdgcn_rcpf(1.f + __builtin_amdgcn_exp2f(-1.4426950408889634f * a)); r[n * 4 + i] = a * sg * uu; }
                u32x4 w; w.x = cvt_pk_bf16(r[0], r[1]); w.y = cvt_pk_bf16(r[2], r[3]); w.z = cvt_pk_bf16(r[4], r[5]); w.w = cvt_pk_bf16(r[6], r[7]);
                *(u32x4*)rowp = w; }
    }
};
struct EpiDown {
    static constexpr bool PERM = true, AFTER_DRAIN = false;
    bf16_t* O; const float* gvr;
    __device__ __forceinline__ void operator()(const f32x4 (&acc)[2][2][4][2], const Unit& u, int wr, int wc, int fr, int fq) const {
        const int row0 = u.pm * BM + wr * 64 + fr, col0 = (u.pn & 7) * BM + wc * 32 + 8 * fq;
#pragma unroll
        for (int ai = 0; ai < 2; ++ai)
#pragma unroll
            for (int m = 0; m < 4; ++m) { const int row = row0 + ai * HALF + m * 16; const float g = gvr[row]; bf16_t* rowp = O + (size_t)row * 2048 + col0;
#pragma unroll
                for (int bj = 0; bj < 2; ++bj) { const f32x4 v0 = acc[ai][bj][m][0] * g, v1 = acc[ai][bj][m][1] * g;
                    u32x4 w; w.x = cvt_pk_bf16(v0[0], v0[1]); w.y = cvt_pk_bf16(v0[2], v0[3]); w.z = cvt_pk_bf16(v1[0], v1[1]); w.w = cvt_pk_bf16(v1[2], v1[3]);
                    *(u32x4*)(rowp + bj * HALF) = w; } }
    }
};

template <class Epi, class Sched, bool ALIGN_EPI = false, bool SP2 = false>
__device__ __forceinline__ void gemm_phase(PG8_LAS unsigned char* lds, const Gemm g, const Sched& S, const Epi& E) {
    int tid_ = threadIdx.x; asm volatile("" : "+v"(tid_));
    const int tid = tid_, wid = __builtin_amdgcn_readfirstlane(tid >> 6), lane = tid & 63, wr = wid >> 2, wc = wid & 3, fr = lane & 15, fq = lane >> 4;
    const int K = g.K, nt = K / BK;
    unsigned voffA[2], voffB[2];
#pragma unroll
    for (int i = 0; i < 2; ++i) { int R, C; stage_rc(tid * 16 + i * 8192, R, C); const int Rb = Epi::PERM ? ((R & ~31) + perm32(R & 31)) : R;
        voffA[i] = (unsigned)(R * K + C) * 2u; voffB[i] = (unsigned)(Rb * K + C) * 2u; }
    const size_t kstep = (size_t)(BK * 2);
    const size_t hstep = (size_t)HALF * K * 2;
    const size_t tstep = 2 * hstep;
    const unsigned ldsw = (unsigned)wid * 1024u;
    const int aoff = lds_byte(wr * 64 + fr, fq * 8), boff = lds_byte(wc * 32 + fr, fq * 8);
#define PG8_SA(b, h) (((b) * 2 + (h)) * HTB)
#define PG8_SB(b, h) ((4 + (b) * 2 + (h)) * HTB)
#define PG8_STAGE(bufoff, gbase, voff) do { _Pragma("unroll") for (int _i = 0; _i < 2; ++_i) \
        __builtin_amdgcn_global_load_lds((const unsigned*)((const char*)(gbase) + (voff)[_i]), (PG8_LAS unsigned*)(lds + (bufoff) + ldsw + _i * 8192), 16, 0, 0); } while (0)
#define PG8_LDA(dst, b, h) do { _Pragma("unroll") for (int m = 0; m < 4; ++m) _Pragma("unroll") for (int k = 0; k < 2; ++k) dst[m][k] = *(const PG8_LAS bf16x8*)(lds + PG8_SA(b, h) + aoff + m * 2048 + k * 1024); } while (0)
#define PG8_LDB(dst, b, h) do { _Pragma("unroll") for (int n = 0; n < 2; ++n) _Pragma("unroll") for (int k = 0; k < 2; ++k) dst[n][k] = *(const PG8_LAS bf16x8*)(lds + PG8_SB(b, h) + boff + n * 2048 + k * 1024); } while (0)
#define PG8_MMA(ai, bj, At, Bt) do { __builtin_amdgcn_s_setprio(1); _Pragma("unroll") for (int m = 0; m < 4; ++m) _Pragma("unroll") for (int n = 0; n < 2; ++n) _Pragma("unroll") for (int k = 0; k < 2; ++k) \
        acc[ai][bj][m][n] = __builtin_amdgcn_mfma_f32_16x16x32_bf16(Bt[n][k], At[m][k], acc[ai][bj][m][n], 0, 0, 0); __builtin_amdgcn_s_setprio(0); } while (0)
#define PG8_WAIT_V(n) asm volatile("s_waitcnt vmcnt(" #n ")" ::: "memory")
#define PG8_WAIT_L(n) asm volatile("s_waitcnt lgkmcnt(" #n ")" ::: "memory")
#define PG8_BAR __builtin_amdgcn_s_barrier()
#define PG8_SCHED __builtin_amdgcn_sched_barrier(0)
    Unit cur, nxt; int ui = 0;
    if (!S.next(0, cur)) return;
    f32x4 acc[2][2][4][2];
#pragma unroll
    for (int a = 0; a < 2; ++a)
#pragma unroll
        for (int b = 0; b < 2; ++b)
#pragma unroll
            for (int m = 0; m < 4; ++m)
#pragma unroll
                for (int n = 0; n < 2; ++n) acc[a][b][m][n] = (f32x4){0.f, 0.f, 0.f, 0.f};
    bf16x8 At[4][2], B0[2][2], B1[2][2];
    const char* cA = (const char*)g.A + (size_t)cur.pm * tstep; const char* cB = (const char*)g.Bt + (size_t)cur.pn * tstep;
    S.a_ready(cur);
    if constexpr (SP2) {
        PG8_STAGE(PG8_SB(0, 0), cB, voffB); PG8_STAGE(PG8_SB(0, 1), cB + hstep, voffB); PG8_STAGE(PG8_SA(0, 0), cA, voffA); PG8_STAGE(PG8_SA(0, 1), cA + hstep, voffA);
        if (wr == 1) PG8_BAR;
        PG8_WAIT_V(2); PG8_BAR;
        PG8_STAGE(PG8_SB(1, 0), cB + kstep, voffB); PG8_STAGE(PG8_SA(1, 0), cA + kstep, voffA); PG8_STAGE(PG8_SB(1, 1), cB + hstep + kstep, voffB);
        PG8_WAIT_V(6); PG8_BAR;
    } else {
        PG8_STAGE(PG8_SB(0, 0), cB, voffB); PG8_STAGE(PG8_SA(0, 0), cA, voffA); PG8_STAGE(PG8_SB(0, 1), cB + hstep, voffB); PG8_STAGE(PG8_SA(0, 1), cA + hstep, voffA);
        if (wr == 1) PG8_BAR;
        PG8_WAIT_V(4); PG8_BAR;
        PG8_STAGE(PG8_SB(1, 0), cB + kstep, voffB); PG8_STAGE(PG8_SA(1, 0), cA + kstep, voffA); PG8_STAGE(PG8_SB(1, 1), cB + hstep + kstep, voffB);
        PG8_WAIT_V(6); PG8_BAR;
    }
    for (;;) {
        const bool has_next = S.next(ui + 1, nxt);
        const char* nA = has_next ? (const char*)g.A + (size_t)nxt.pm * tstep : cA; const char* nB = has_next ? (const char*)g.Bt + (size_t)nxt.pn * tstep : cB;
        for (int t = 0; t < nt; t += 2) {
            const bool last = (t == nt - 2);
            const char* a1 = cA + (size_t)(t + 1) * kstep;
            const char* a2 = last ? nA : cA + (size_t)(t + 2) * kstep; const char* b2 = last ? nB : cB + (size_t)(t + 2) * kstep;
            const char* a3 = a2 + kstep; const char* b3 = b2 + kstep;
            if (last && has_next) S.a_ready(nxt);
            if constexpr (SP2) {
            PG8_LDB(B0, 0, 0); PG8_LDB(B1, 0, 1); PG8_SCHED; PG8_LDA(At, 0, 0); PG8_STAGE(PG8_SA(1, 1), a1 + hstep, voffA);
            PG8_WAIT_V(8); PG8_WAIT_L(0); PG8_BAR; PG8_MMA(0, 0, At, B0); PG8_MMA(0, 1, At, B1); PG8_BAR; PG8_SCHED;
            PG8_LDA(At, 0, 1); PG8_STAGE(PG8_SB(0, 0), b2, voffB); PG8_STAGE(PG8_SB(0, 1), b2 + hstep, voffB); PG8_STAGE(PG8_SA(0, 0), a2, voffA);
            PG8_WAIT_V(8); PG8_WAIT_L(0); PG8_BAR; PG8_MMA(1, 0, At, B0); PG8_MMA(1, 1, At, B1); PG8_BAR; PG8_SCHED;
            PG8_LDB(B0, 1, 0); PG8_LDB(B1, 1, 1); PG8_SCHED; PG8_LDA(At, 1, 0); PG8_STAGE(PG8_SA(0, 1), a2 + hstep, voffA);
            PG8_WAIT_V(8); PG8_WAIT_L(0); PG8_BAR; PG8_MMA(0, 0, At, B0); PG8_MMA(0, 1, At, B1); PG8_BAR; PG8_SCHED;
            PG8_LDA(At, 1, 1); PG8_STAGE(PG8_SB(1, 0), b3, voffB); PG8_STAGE(PG8_SB(1, 1), b3 + hstep, voffB); PG8_STAGE(PG8_SA(1, 0), a3, voffA);
            PG8_WAIT_V(8); PG8_WAIT_L(0); PG8_BAR; PG8_MMA(1, 0, At, B0); PG8_MMA(1, 1, At, B1); PG8_BAR; PG8_SCHED;
            } else {
            PG8_LDB(B0, 0, 0); PG8_SCHED; PG8_LDA(At, 0, 0); PG8_STAGE(PG8_SA(1, 1), a1 + hstep, voffA);
            PG8_WAIT_L(8); PG8_BAR; PG8_WAIT_L(0); PG8_MMA(0, 0, At, B0); PG8_BAR; PG8_SCHED;
            PG8_LDB(B1, 0, 1); PG8_STAGE(PG8_SB(0, 0), b2, voffB);
            PG8_BAR; PG8_WAIT_L(0); PG8_MMA(0, 1, At, B1); PG8_BAR;
            PG8_LDA(At, 0, 1); PG8_STAGE(PG8_SA(0, 0), a2, voffA);
            PG8_BAR; PG8_WAIT_L(0); PG8_MMA(1, 0, At, B0); PG8_BAR; PG8_SCHED;
            PG8_STAGE(PG8_SB(0, 1), b2 + hstep, voffB);
            PG8_WAIT_V(6); PG8_BAR; PG8_MMA(1, 1, At, B1); PG8_BAR;
            PG8_LDB(B0, 1, 0); PG8_SCHED; PG8_LDA(At, 1, 0); PG8_STAGE(PG8_SA(0, 1), a2 + hstep, voffA);
            PG8_WAIT_L(8); PG8_BAR; PG8_WAIT_L(0); PG8_MMA(0, 0, At, B0); PG8_BAR; PG8_SCHED;
            PG8_LDB(B1, 1, 1); PG8_STAGE(PG8_SB(1, 0), b3, voffB);
            PG8_BAR; PG8_WAIT_L(0); PG8_MMA(0, 1, At, B1); PG8_BAR;
            PG8_LDA(At, 1, 1); PG8_STAGE(PG8_SA(1, 0), a3, voffA);
            PG8_BAR; PG8_WAIT_L(0); PG8_MMA(1, 0, At, B0); PG8_BAR; PG8_SCHED;
            PG8_STAGE(PG8_SB(1, 1), b3 + hstep, voffB);
            PG8_WAIT_V(6); PG8_BAR; PG8_MMA(1, 1, At, B1); PG8_BAR;
            }
        }
        if constexpr (ALIGN_EPI) { if (wr == 0) PG8_BAR; }
        if constexpr (!Epi::AFTER_DRAIN) { E(acc, cur, wr, wc, fr, fq); S.done(cur); }
        if (!has_next) break;
#pragma unroll
        for (int a = 0; a < 2; ++a)
#pragma unroll
            for (int b = 0; b < 2; ++b)
#pragma unroll
                for (int m = 0; m < 4; ++m)
#pragma unroll
                    for (int n = 0; n < 2; ++n) acc[a][b][m][n] = (f32x4){0.f, 0.f, 0.f, 0.f};
        cur = nxt; cA = nA; cB = nB; ++ui;
        if constexpr (ALIGN_EPI) { if (wr == 1) PG8_BAR; }
    }
    PG8_WAIT_V(0);
    if constexpr (!ALIGN_EPI) { if (wr == 0) PG8_BAR; }
    PG8_BAR;
#undef PG8_SA
#undef PG8_SB
#undef PG8_STAGE
#undef PG8_LDA
#undef PG8_LDB
#undef PG8_MMA
#undef PG8_WAIT_V
#undef PG8_WAIT_L
#undef PG8_BAR
#undef PG8_SCHED
}
}

namespace att {
using bf16 = unsigned short;
using bf16x8 = __attribute__((ext_vector_type(8))) short;
using s16x4  = __attribute__((ext_vector_type(4))) short;
using f32x16 = __attribute__((ext_vector_type(16))) float;
using u32x4  = __attribute__((ext_vector_type(4))) unsigned;
constexpr int D = 128, NW = 8, QBLK = 32, KVBLK = 64;
constexpr float SCALE = 0.088388347648318440f;
constexpr float THR = 8.f;
#ifndef ATT_SDEPTH
#define ATT_SDEPTH 2
#endif
constexpr int SDEPTH = ATT_SDEPTH;
constexpr int LDZ = 3072, LDO = 2048;
constexpr int SHM_V = KVBLK * D * 2, SHM_K = KVBLK * D * 2;
constexpr int OFF_WS = 2 * SHM_V + 2 * SHM_K, OFF_TAB = OFF_WS + NW * 64 * 4, SHM_ATTN = OFF_TAB + 768 * 4;
constexpr float MASKV = -1e37f;
#define KSWZ(row, colB) ((row) * 256 + ((colB) ^ (((row) & 7) << 4)))
#define SBAR() __builtin_amdgcn_sched_barrier(0)
__device__ __forceinline__ int crow(int r, int hi) { return (r & 3) + 8 * (r >> 2) + 4 * hi; }
__device__ __forceinline__ unsigned cvtpk(float lo, float hi) { unsigned r; asm volatile("v_cvt_pk_bf16_f32 %0, %1, %2" : "=v"(r) : "v"(lo), "v"(hi)); return r; }
__device__ __forceinline__ float bf2f(unsigned short h) { return __builtin_bit_cast(float, (unsigned)h << 16); }

__device__ __forceinline__ void partialSM(f32x16& p0, f32x16& p1, float& m_reg, float& mn, float& alpha) {
  constexpr float C = SCALE * 1.4426950408889634f;
  float pmax = p0[0];
#pragma unroll
  for (int r = 1; r < 16; ++r) pmax = fmaxf(pmax, p0[r]);
#pragma unroll
  for (int r = 0; r < 16; ++r) pmax = fmaxf(pmax, p1[r]);
  { auto rr = __builtin_amdgcn_permlane32_swap(__float_as_uint(pmax), __float_as_uint(pmax), false, false);
    pmax = fmaxf(__uint_as_float(rr[0]), __uint_as_float(rr[1])); }
  if (__builtin_expect(__all(pmax - m_reg <= THR / SCALE), 1)) { mn = m_reg; alpha = 1.f; }
  else { mn = fmaxf(m_reg, pmax); alpha = __builtin_amdgcn_exp2f((m_reg - mn) * C); m_reg = mn; }
  float mnC = -mn * C;
#pragma unroll
  for (int r = 0; r < 16; ++r) p0[r] = fmaf(p0[r], C, mnC);
#pragma unroll
  for (int r = 0; r < 16; ++r) p1[r] = fmaf(p1[r], C, mnC);
#pragma unroll
  for (int r = 0; r < 16; ++r) p0[r] = __builtin_amdgcn_exp2f(p0[r]);
}
__device__ __forceinline__ void finishSM(f32x16& p0, f32x16& p1, float alpha, float& l_reg, bf16x8& pa0, bf16x8& pa1, bf16x8& pa2, bf16x8& pa3) {
#pragma unroll
  for (int r = 0; r < 16; ++r) p1[r] = __builtin_amdgcn_exp2f(p1[r]);
  float ps = 0;
#pragma unroll
  for (int r = 0; r < 16; ++r) ps += p0[r];
#pragma unroll
  for (int r = 0; r < 16; ++r) ps += p1[r];
  { auto rr = __builtin_amdgcn_permlane32_swap(__float_as_uint(ps), __float_as_uint(ps), false, false);
    ps = __uint_as_float(rr[0]) + __uint_as_float(rr[1]); }
  l_reg = l_reg * alpha + ps;
#define PK4(P, BASE, OUT) do { unsigned a0 = cvtpk(P[BASE + 0], P[BASE + 1]), a1 = cvtpk(P[BASE + 2], P[BASE + 3]);   \
    unsigned b0 = cvtpk(P[BASE + 4], P[BASE + 5]), b1 = cvtpk(P[BASE + 6], P[BASE + 7]);                              \
    auto r0 = __builtin_amdgcn_permlane32_swap(a0, b0, false, false); auto r1 = __builtin_amdgcn_permlane32_swap(a1, b1, false, false); \
    u32x4 w = {r0[0], r1[0], r0[1], r1[1]}; OUT = *reinterpret_cast<bf16x8*>(&w); } while (0)
  PK4(p0, 0, pa0); PK4(p0, 8, pa1); PK4(p1, 0, pa2); PK4(p1, 8, pa3);
#undef PK4
}
__device__ __forceinline__ void qkt(f32x16& p0, f32x16& p1, const char* Ks, const bf16x8* qr, int r32, int hi) {
  p0 = f32x16{}; p1 = f32x16{};
#pragma unroll
  for (int d0 = 0; d0 < 8; ++d0) { int cb = (d0 * 16 + hi * 8) * 2;
    bf16x8 b0 = *reinterpret_cast<const bf16x8*>(Ks + KSWZ(r32, cb));
    bf16x8 b1 = *reinterpret_cast<const bf16x8*>(Ks + KSWZ(32 + r32, cb));
    p0 = __builtin_amdgcn_mfma_f32_32x32x16_bf16(b0, qr[d0], p0, 0, 0, 0);
    p1 = __builtin_amdgcn_mfma_f32_32x32x16_bf16(b1, qr[d0], p1, 0, 0, 0); }
}
__device__ __forceinline__ int v_st(int k, int c) { const int kk = (k & ~0xC) | ((k & 4) << 1) | ((k & 8) >> 1); return ((kk >> 3) * 4 + (c >> 5)) * 512 + ((kk & 7) * 32 + (c & 31)) * 2; }
__device__ __forceinline__ int v_rd_base(int lane) { return ((lane & 3) << 3) | (((lane >> 2) & 3) << 6) | (((lane >> 4) & 1) << 5) | (((lane >> 5) & 1) << 8); }
constexpr int v_rd_off(int d0, int ks, int half) { return d0 * 512 + ks * 4096 + half * 2048; }
template <int OFF> __device__ __forceinline__ s16x4 tr_read(int vb) {
  s16x4 r; asm volatile("ds_read_b64_tr_b16 %0, %1 offset:%2" : "=&v"(r) : "v"(vb), "i"(OFF) : "memory"); return r;
}
template <int D0> __device__ __forceinline__ void pv_one(f32x16& od, int vb, bf16x8 pa0, bf16x8 pa1, bf16x8 pa2, bf16x8 pa3) {
  const s16x4 l0 = tr_read<v_rd_off(D0, 0, 0)>(vb), h0 = tr_read<v_rd_off(D0, 0, 1)>(vb), l1 = tr_read<v_rd_off(D0, 1, 0)>(vb), h1 = tr_read<v_rd_off(D0, 1, 1)>(vb);
  const s16x4 l2 = tr_read<v_rd_off(D0, 2, 0)>(vb), h2 = tr_read<v_rd_off(D0, 2, 1)>(vb), l3 = tr_read<v_rd_off(D0, 3, 0)>(vb), h3 = tr_read<v_rd_off(D0, 3, 1)>(vb);
  asm volatile("s_waitcnt lgkmcnt(0)" ::: "memory"); SBAR();
#define PK(L, H) (bf16x8){L[0], L[1], L[2], L[3], H[0], H[1], H[2], H[3]}
  od = __builtin_amdgcn_mfma_f32_32x32x16_bf16(pa0, PK(l0, h0), od, 0, 0, 0);
  od = __builtin_amdgcn_mfma_f32_32x32x16_bf16(pa1, PK(l1, h1), od, 0, 0, 0);
  od = __builtin_amdgcn_mfma_f32_32x32x16_bf16(pa2, PK(l2, h2), od, 0, 0, 0);
  od = __builtin_amdgcn_mfma_f32_32x32x16_bf16(pa3, PK(l3, h3), od, 0, 0, 0);
#undef PK
}
__device__ __forceinline__ void pv_d0(f32x16* o, int vb, bf16x8 pa0, bf16x8 pa1, bf16x8 pa2, bf16x8 pa3) {
  pv_one<0>(o[0], vb, pa0, pa1, pa2, pa3); pv_one<1>(o[1], vb, pa0, pa1, pa2, pa3); pv_one<2>(o[2], vb, pa0, pa1, pa2, pa3); pv_one<3>(o[3], vb, pa0, pa1, pa2, pa3);
}
__device__ __forceinline__ int t5_bucket(int rel) {
  const int n = rel < 0 ? -rel : rel;
  const int large = 8 + (n >= 12) + (n >= 16) + (n >= 23) + (n >= 32) + (n >= 46) + (n >= 64) + (n >= 91);
  return (rel > 0 ? 16 : 0) + (n < 8 ? n : large);
}
__device__ __forceinline__ float rope_inv(int i) { return __builtin_amdgcn_exp2f((float)i * (-13.287712379549449f / 32.f)); }
__device__ __forceinline__ void sincos_rev(float ang, float& s, float& c) {
  float rev = ang * 0.15915494309189535f; rev = rev - __builtin_rintf(rev);
  s = __builtin_amdgcn_sinf(rev); c = __builtin_amdgcn_cosf(rev);
}

template <bool WIN>
__device__ __forceinline__ void attn_unit(const bf16* __restrict__ Zq, const bf16* __restrict__ Kh, const bf16* __restrict__ Vh, bf16* __restrict__ Ob, int NT,
                                          int relk0, float sinkv, const float* __restrict__ relb, char* lds) {
  int tid_ = threadIdx.x; asm volatile("" : "+v"(tid_));
  const int tid = tid_, wid = tid >> 6, lane = tid & 63, r32 = lane & 31, hi = lane >> 5;
  char* V_lds = lds; char* K_lds = lds + 2 * SHM_V;
  float* ws = (float*)(lds + OFF_WS) + wid * 64; float* li_l = ws; float* al_l = ws + 32;
  float* tab = (float*)(lds + OFF_TAB);
  __syncthreads();
  if constexpr (WIN) {
    for (int i = tid; i < 768; i += 512) { const int rel = i - 384; const int n = rel < 0 ? -rel : rel;
      tab[i] = (n <= 128) ? relb[t5_bucket(rel) * 8] * (1.0f / SCALE) : MASKV; }
  }
  float m_reg = -1e30f, l_reg = 0; f32x16 o[4] = {}; bf16x8 qr[8];
  {
    const bf16* Qw = Zq + (long)(wid * QBLK + r32) * LDZ + hi * 8;
#pragma unroll
    for (int d0 = 0; d0 < 8; ++d0) qr[d0] = *reinterpret_cast<const bf16x8*>(Qw + d0 * 16);
  }
  const int sr = tid >> 4, sc = (tid & 15) * 8, vst0 = v_st(sr, sc), vst1 = v_st(32 + sr, sc);
  const int vb0 = (int)(uintptr_t)V_lds + v_rd_base(lane);
  struct { bf16x8 vs0, vs1, ks0, ks1; } sr_[SDEPTH];
#define LD8(p) (*reinterpret_cast<const bf16x8*>(p))
#define SLOAD(i, k0) do { sr_[i].vs0 = LD8(&Vh[(long)((k0) + sr) * LDZ + sc]); sr_[i].vs1 = LD8(&Vh[(long)((k0) + 32 + sr) * LDZ + sc]); \
    sr_[i].ks0 = LD8(&Kh[(long)((k0) + sr) * LDZ + sc]); sr_[i].ks1 = LD8(&Kh[(long)((k0) + 32 + sr) * LDZ + sc]); } while (0)
#define SWRITE(b, i) do { *(bf16x8*)(V_lds + (b) * SHM_V + vst0) = sr_[i].vs0;          \
    *(bf16x8*)(V_lds + (b) * SHM_V + vst1) = sr_[i].vs1; int kc = sc * 2;               \
    *(bf16x8*)(K_lds + (b) * SHM_K + KSWZ(sr, kc)) = sr_[i].ks0;                       \
    *(bf16x8*)(K_lds + (b) * SHM_K + KSWZ(32 + sr, kc)) = sr_[i].ks1; } while (0)
#define SWAIT() do { if constexpr (SDEPTH == 2) asm volatile("s_waitcnt vmcnt(4)" ::: "memory"); else asm volatile("s_waitcnt vmcnt(0)" ::: "memory"); } while (0)
#define RESC(a) do { if (__any((a) < 1.f)) { if (hi == 0) al_l[r32] = (a); asm volatile("s_waitcnt lgkmcnt(0)" ::: "memory"); \
    _Pragma("unroll") for (int d = 0; d < 4; ++d) _Pragma("unroll") for (int r = 0; r < 16; ++r) o[d][r] *= al_l[crow(r, hi)]; } } while (0)
#define BIAS(P0, P1, t) do { if constexpr (WIN) { const float* tp = tab + (384 + relk0 + 64 * (t) - (wid * QBLK + r32) + 4 * hi); \
    _Pragma("unroll") for (int r = 0; r < 16; ++r) { P0[r] += tp[(r & 3) + 8 * (r >> 2)]; P1[r] += tp[32 + (r & 3) + 8 * (r >> 2)]; } } } while (0)
  f32x16 pA0, pA1, pB0, pB1; float mnA, mnB, alA, alB; bf16x8 pa0, pa1, pa2, pa3;
  constexpr int SE = 0, SO = SDEPTH - 1;
  SLOAD(SE, 0); asm volatile("s_waitcnt vmcnt(0)" ::: "memory"); SWRITE(0, SE); __syncthreads();
  qkt(pA0, pA1, K_lds, qr, r32, hi); BIAS(pA0, pA1, 0); partialSM(pA0, pA1, m_reg, mnA, alA);
  SLOAD(SO, KVBLK); if constexpr (SDEPTH == 2) { if (2 < NT) SLOAD(SE, 2 * KVBLK); }
  SWAIT(); SWRITE(1, SO); __syncthreads();
  for (int j = 1; j + 1 < NT; j += 2) {
    SBAR(); qkt(pB0, pB1, K_lds + SHM_K, qr, r32, hi);
    finishSM(pA0, pA1, alA, l_reg, pa0, pa1, pa2, pa3); SBAR();
    SLOAD(SO, (j + SDEPTH) * KVBLK); SBAR();
    pv_d0(o, vb0, pa0, pa1, pa2, pa3); BIAS(pB0, pB1, j); partialSM(pB0, pB1, m_reg, mnB, alB);
    __syncthreads(); SWAIT(); SWRITE(0, SE);
    RESC(alB); __syncthreads();
    SBAR(); qkt(pA0, pA1, K_lds, qr, r32, hi);
    finishSM(pB0, pB1, alB, l_reg, pa0, pa1, pa2, pa3); SBAR();
    if (SDEPTH == 1 || j + 3 < NT) SLOAD(SE, (j + 1 + SDEPTH) * KVBLK); SBAR();
    pv_d0(o, vb0 + SHM_V, pa0, pa1, pa2, pa3); BIAS(pA0, pA1, j + 1); partialSM(pA0, pA1, m_reg, mnA, alA);
    __syncthreads(); SWAIT(); SWRITE(1, SO);
    RESC(alA); __syncthreads();
  }
  SBAR(); qkt(pB0, pB1, K_lds + SHM_K, qr, r32, hi);
  finishSM(pA0, pA1, alA, l_reg, pa0, pa1, pa2, pa3); SBAR();
  pv_d0(o, vb0, pa0, pa1, pa2, pa3); BIAS(pB0, pB1, NT - 1); partialSM(pB0, pB1, m_reg, mnB, alB);
  __syncthreads(); RESC(alB);
  finishSM(pB0, pB1, alB, l_reg, pa0, pa1, pa2, pa3); SBAR();
  pv_d0(o, vb0 + SHM_V, pa0, pa1, pa2, pa3);
  if constexpr (WIN) { constexpr float C = SCALE * 1.4426950408889634f; l_reg += __builtin_amdgcn_exp2f(fminf(sinkv * 1.4426950408889634f - m_reg * C, 120.f)); }
  if (hi == 0) li_l[r32] = l_reg; asm volatile("s_waitcnt lgkmcnt(0)" ::: "memory");
  float rli[16];
#pragma unroll
  for (int r = 0; r < 16; ++r) rli[r] = __builtin_amdgcn_rcpf(li_l[crow(r, hi)]);
  bf16* Ow = Ob + (long)(wid * QBLK) * LDO;
#pragma unroll
  for (int r = 0; r < 16; ++r) { const int orow = crow(r, hi);
#pragma unroll
    for (int d0 = 0; d0 < 4; ++d0) { const float v = o[d0][r] * rli[r]; Ow[(long)orow * LDO + d0 * 32 + r32] = (bf16)(cvtpk(v, v) & 0xffffu); } }
#undef LD8
#undef SLOAD
#undef SWRITE
#undef SWAIT
#undef RESC
#undef BIAS
}
#undef KSWZ
}

constexpr int NWAVES = 8;
constexpr int NB = 4, SEQ = 4096, DM = 2048, M = NB * SEQ, DIN = 3072, NE = 16, CAP = 512, DE = 2048, RE = NE * NB * CAP;
constexpr int N_PHASES = 12;
constexpr size_t MiB = 1u << 20;
constexpr size_t WS_CTL = 0, CTL_ZERO_BYTES = 1 * MiB;
constexpr size_t WS_MOD = 256 * 1024;
constexpr size_t WS_WIN = 2 * MiB, WS_WOUT = 14 * MiB, WS_WGU = 24 * MiB, WS_WDN = 280 * MiB;
constexpr size_t WS_H = 408 * MiB, WS_Z = 472 * MiB, WS_O = 568 * MiB, WS_XG = 472 * MiB, WS_ACT = 632 * MiB, WS_Y = 472 * MiB;
constexpr size_t WS_AFF = 760 * MiB, WS_IDX = 761 * MiB, WS_GVR = 761 * MiB + 128 * 1024, WS_INV = 762 * MiB, WS_END = 763 * MiB;
constexpr int CW_BAR = 4096;
constexpr int RING_OFF = 0, RING_BYTES = 131072;
constexpr int LDSCTL_OFF = RING_BYTES, MISC_OFF = LDSCTL_OFF + 320;
constexpr int LDS_BYTES = 147456;

#define GAS __attribute__((address_space(1)))
#define LAS __attribute__((address_space(3)))
typedef unsigned short bf16;
typedef unsigned v4u __attribute__((ext_vector_type(4)));
typedef unsigned v2u __attribute__((ext_vector_type(2)));
typedef float f32x4 __attribute__((ext_vector_type(4)));
typedef float f32x2 __attribute__((ext_vector_type(2)));
typedef GAS unsigned gu32;
#define RLX_AGENT __ATOMIC_RELAXED, __HIP_MEMORY_SCOPE_AGENT
#define LDS_WAIT() asm volatile("s_waitcnt lgkmcnt(0)" ::: "memory")
#define VM_WAIT() asm volatile("s_waitcnt vmcnt(0)" ::: "memory")
__device__ __forceinline__ unsigned f2bf(float f) { unsigned u = __builtin_bit_cast(unsigned, f); return (u + 0x7fffu + ((u >> 16) & 1u)) >> 16; }
__device__ __forceinline__ unsigned pk2(float lo, float hi) { return f2bf(lo) | (f2bf(hi) << 16); }
__device__ __forceinline__ float bf_lo(unsigned w) { return __builtin_bit_cast(float, w << 16); }
__device__ __forceinline__ float bf_hi(unsigned w) { return __builtin_bit_cast(float, w & 0xffff0000u); }

#define XB_TMO      128
#define XB_XCNT(j)  (256  + 64 * (j))
#define XB_XSUB(j)  (1280 + 64 * (j))
#define XB_XGEN(j)  (2304 + 64 * (j))
#define XB_TOP      3328
#define XB_TOPGEN   3392
#define XCD_BAR_WORDS 3456
#define XB_SPIN_CAP (1u << 18)
__device__ __forceinline__ unsigned xb_ld(unsigned* p)              { return __hip_atomic_load(p, __ATOMIC_RELAXED, __HIP_MEMORY_SCOPE_AGENT); }
__device__ __forceinline__ unsigned xb_add(unsigned* p, unsigned v) { return __hip_atomic_fetch_add(p, v, __ATOMIC_RELAXED, __HIP_MEMORY_SCOPE_AGENT); }
__device__ __forceinline__ unsigned xb_xcc_id() { return (unsigned)__builtin_amdgcn_s_getreg((3 << 11) | 20) & 0xFu; }
#define XB_SPIN(cond, bar) do { unsigned _sp = 0; while (cond) { __builtin_amdgcn_s_sleep(1); \
    if ((++_sp & 255u) == 0u) { if (xb_ld(&(bar)[XB_TMO])) break; if (_sp > XB_SPIN_CAP) { atomicAdd(&(bar)[XB_TMO], 1u); break; } } } } while (0)
struct XcdBarrier { unsigned* bar; unsigned x; volatile LAS unsigned* st; };
__device__ __forceinline__ XcdBarrier xcd_barrier_post(unsigned* bar, volatile LAS unsigned* st) {
    XcdBarrier b; b.bar = bar; b.x = xb_xcc_id(); b.st = st;
    if (threadIdx.x == 0) (void)xb_add(&bar[XB_XCNT(b.x)], 1u);
    return b;
}
__device__ __forceinline__ void xcd_barrier_complete(unsigned* bar, unsigned x, unsigned& nloc, unsigned& nx) {
    const unsigned G = gridDim.x * gridDim.y * gridDim.z;
    unsigned sum, cnt, mine, sp = 0u;
    for (;;) {
        sum = 0u; cnt = 0u; mine = 0u;
#pragma unroll
        for (unsigned j = 0; j < 16; ++j) { const unsigned c = xb_ld(&bar[XB_XCNT(j)]); sum += c; cnt += (c > 0u) ? 1u : 0u; mine = (j == x) ? c : mine; }
        if (sum == G) break;
        __builtin_amdgcn_s_sleep(1);
        if ((++sp & 255u) == 0u) { if (xb_ld(&bar[XB_TMO])) break; if (sp > XB_SPIN_CAP) { atomicAdd(&bar[XB_TMO], 1u); break; } }
    }
    nloc = mine > 0u ? mine : 1u; nx = cnt > 0u ? cnt : 1u;
}
__device__ __forceinline__ void xcd_barrier(const XcdBarrier& b) {
    asm volatile("s_waitcnt vmcnt(0)" ::: "memory");
    __syncthreads();
    if (threadIdx.x == 0) {
        unsigned* bar = b.bar;
        __builtin_amdgcn_s_waitcnt(0);
        unsigned nloc = b.st[0], nx = b.st[1];
        if (nloc == 0u) { xcd_barrier_complete(bar, b.x, nloc, nx); b.st[0] = nloc; b.st[1] = nx; }
        const unsigned old = xb_add(&bar[XB_XSUB(b.x)], 1u);
        const unsigned gen = old / nloc;
        if (old + 1u == (gen + 1u) * nloc) {
            __builtin_amdgcn_fence(__ATOMIC_RELEASE, "agent");
            asm volatile("s_waitcnt vmcnt(0)" ::: "memory");
            const unsigned og = xb_add(&bar[XB_TOP], 1u);
            const unsigned tg = og / nx;
            if (og + 1u == (tg + 1u) * nx) xb_add(&bar[XB_TOPGEN], 1u);
            else XB_SPIN(xb_ld(&bar[XB_TOPGEN]) == tg, bar);
            __builtin_amdgcn_fence(__ATOMIC_ACQUIRE, "agent");
            xb_add(&bar[XB_XGEN(b.x)], 1u);
            asm volatile("s_waitcnt vmcnt(0)" ::: "memory");
        } else {
            XB_SPIN(xb_ld(&bar[XB_XGEN(b.x)]) == gen, bar);
            __builtin_amdgcn_fence(__ATOMIC_ACQUIRE, "agent");
            asm volatile("s_waitcnt vmcnt(0)" ::: "memory");
        }
    }
    __syncthreads();
}

struct Frame {
    LAS unsigned char* lds;
    volatile LAS unsigned* MISC;
    int tid, lane, wave, vcu, G;
};
__device__ __forceinline__ float wave_sum(float v) {
#pragma unroll
    for (int o = 1; o < 64; o <<= 1) v += __shfl_xor(v, o);
    return v;
}
__device__ __forceinline__ float wave_max(float v) {
#pragma unroll
    for (int o = 1; o < 64; o <<= 1) v = fmaxf(v, __shfl_xor(v, o));
    return v;
}
__device__ __forceinline__ void transpose_item(const float* W, int N, int K, bf16* WT, int dst_row0, int k0, int n0, LAS float* scr, int lane) {
    float v[32];
#pragma unroll
    for (int i = 0; i < 32; ++i) { const int kk = 2 * i + (lane >> 5); v[i] = W[(size_t)(k0 + kk) * N + n0 + (lane & 31)]; }
#pragma unroll
    for (int i = 0; i < 32; ++i) { const int kk = 2 * i + (lane >> 5); scr[kk * 33 + (lane & 31)] = v[i]; }
    LDS_WAIT(); asm volatile("" ::: "memory");
    const int c = lane & 7;
#pragma unroll
    for (int j = 0; j < 4; ++j) { const int n = (lane >> 3) + 8 * j; const LAS float* s = scr + (8 * c) * 33 + n;
        v4u o; o.x = pk2(s[0 * 33], s[1 * 33]); o.y = pk2(s[2 * 33], s[3 * 33]); o.z = pk2(s[4 * 33], s[5 * 33]); o.w = pk2(s[6 * 33], s[7 * 33]);
        *(GAS v4u*)(WT + (size_t)(dst_row0 + n) * K + k0 + 8 * c) = o; }
    LDS_WAIT(); asm volatile("" ::: "memory");
}

struct Args { const float* in[18]; float* out; unsigned char* ws; int ph_lo, ph_hi; };

__global__ void __launch_bounds__(NWAVES * 64, 2) fwd_kernel(Args args) {
    extern __shared__ __attribute__((aligned(16))) unsigned char lds[];
    Frame F;
    F.lds = (LAS unsigned char*)lds;
    F.MISC = (volatile LAS unsigned*)(F.lds + MISC_OFF);
    F.tid = threadIdx.x; F.lane = F.tid & 63; F.wave = __builtin_amdgcn_readfirstlane(F.tid >> 6);
    F.G = gridDim.x; { const int bx = blockIdx.x; F.vcu = (F.G % 8 == 0) ? (bx % 8) * (F.G / 8) + bx / 8 : bx; }
#define PHASE_PTRS() const unsigned long long* kap = (const unsigned long long*)__builtin_amdgcn_kernarg_segment_ptr(); asm volatile("" : "+s"(kap)); \
    unsigned char* const ws = (unsigned char*)kap[19]; (void)ws
#define KIN(i) ((const float*)kap[i])
#define KOUT ((float*)kap[18])
#define P_MOD ((float*)(ws + WS_MOD))
#define P_WIN_T ((bf16*)(ws + WS_WIN))
#define P_WOUT_T ((bf16*)(ws + WS_WOUT))
#define P_WGU_T ((bf16*)(ws + WS_WGU))
#define P_WDN_T ((bf16*)(ws + WS_WDN))
#define P_HB ((bf16*)(ws + WS_H))
#define P_ZB ((bf16*)(ws + WS_Z))
#define P_OB ((bf16*)(ws + WS_O))
#define P_XG ((bf16*)(ws + WS_XG))
#define P_ACT ((bf16*)(ws + WS_ACT))
#define P_YB ((bf16*)(ws + WS_Y))
#define P_AFF ((float*)(ws + WS_AFF))
#define P_IDX ((int*)(ws + WS_IDX))
#define P_GVR ((float*)(ws + WS_GVR))
#define P_INV ((int*)(ws + WS_INV))
    gu32* ctl = (gu32*)(args.ws + WS_CTL);
    for (int u = F.tid; u < (LDS_BYTES - LDSCTL_OFF) / 4; u += NWAVES * 64) ((LAS unsigned*)(F.lds + LDSCTL_OFF))[u] = 0u;
    __syncthreads();
    const int lo = args.ph_lo, hi = args.ph_hi;
    XcdBarrier bar; bar.bar = (unsigned*)(ctl + CW_BAR); bar.x = 0; bar.st = nullptr;
    if (hi - lo > 1) bar = xcd_barrier_post((unsigned*)(ctl + CW_BAR), F.MISC + 8);
#ifndef PH_MASK
#define PH_MASK 0xFFF
#endif
#define IN(k) (((PH_MASK >> (k)) & 1) && lo <= (k) && (k) < hi)
#define BOTH(k) (IN(k) && IN((k) + 1))
#define GRID_BAR() xcd_barrier(bar)
    const int gw = F.vcu * NWAVES + F.wave, NGW = F.G * NWAVES;

    if (IN(0)) {
        PHASE_PTRS(); const float* cvec = KIN(1); const float* w_ada = KIN(2); const float* b_ada = KIN(3); const float* w_in = KIN(5); const float* w_out = KIN(12);
        const float* w_gate = KIN(15); const float* w_up = KIN(16); const float* w_down = KIN(17); float* MOD = P_MOD; bf16* WIN_T = P_WIN_T; bf16* WOUT_T = P_WOUT_T; bf16* WGU_T = P_WGU_T; bf16* WDN_T = P_WDN_T;
        for (int it = gw; it < 1536; it += NGW) {
            const int cg = it % 48, kc = it / 48, k0 = kc * 64, col0 = cg * 256 + F.lane * 4;
            float sc[4];
#pragma unroll
            for (int b = 0; b < 4; ++b) { const float v = cvec[b * DM + k0 + F.lane]; sc[b] = v / (1.f + __expf(-v)); }
            f32x4 acc[4];
#pragma unroll
            for (int b = 0; b < 4; ++b) acc[b] = (f32x4){0.f, 0.f, 0.f, 0.f};
#pragma unroll 16
            for (int kk = 0; kk < 64; ++kk) { const f32x4 w = *(const f32x4*)(w_ada + (size_t)(k0 + kk) * 12288 + col0);
#pragma unroll
                for (int b = 0; b < 4; ++b) { const float s = __builtin_bit_cast(float, __builtin_amdgcn_readlane(__builtin_bit_cast(int, sc[b]), kk)); acc[b] += w * s; } }
            if (kc == 0) { const f32x4 bb = *(const f32x4*)(b_ada + col0);
#pragma unroll
                for (int b = 0; b < 4; ++b) acc[b] += bb; }
#pragma unroll
            for (int b = 0; b < 4; ++b)
#pragma unroll
                for (int i = 0; i < 4; ++i) atomicAdd(MOD + b * 12288 + col0 + i, acc[b][i]);
        }
        LAS float* scr = (LAS float*)(F.lds + RING_OFF + F.wave * 16384);
        constexpr int I_IN = 32 * 96, I_OUT = 32 * 64, I_E = 32 * 64;
        constexpr int NITEMS = I_IN + I_OUT + 48 * I_E;
        for (int it = gw; it < NITEMS; it += NGW) {
            int r = it;
            if (r < I_IN) { const int kb = r / 96, nb = r % 96; transpose_item(w_in, DIN, DM, WIN_T, 32 * nb, 64 * kb, 32 * nb, scr, F.lane); continue; } r -= I_IN;
            if (r < I_OUT) { const int kb = r / 64, nb = r % 64; transpose_item(w_out, DM, DM, WOUT_T, 32 * nb, 64 * kb, 32 * nb, scr, F.lane); continue; } r -= I_OUT;
            const int mat = r / I_E, q = r % I_E, kb = q / 64, nb = q % 64, n0 = 32 * nb;
            if (mat < 16)      transpose_item(w_gate + (size_t)mat * DM * DE, DE, DM, WGU_T + (size_t)mat * 4096 * DM, (n0 >> 7) * 256 + (n0 & 127), 64 * kb, n0, scr, F.lane);
            else if (mat < 32) transpose_item(w_up + (size_t)(mat - 16) * DM * DE, DE, DM, WGU_T + (size_t)(mat - 16) * 4096 * DM, (n0 >> 7) * 256 + 128 + (n0 & 127), 64 * kb, n0, scr, F.lane);
            else               transpose_item(w_down + (size_t)(mat - 32) * DE * DM, DM, DE, WDN_T + (size_t)(mat - 32) * DM * DE, n0, 64 * kb, n0, scr, F.lane);
        }
        if (BOTH(0)) GRID_BAR();
    }

    if (IN(1)) {
        PHASE_PTRS(); const float* x = KIN(0); const float* g_norm1 = KIN(4); const float* MOD = P_MOD; bf16* HB = P_HB;
        for (int m = gw; m < M; m += NGW) {
            const int b = m >> 12; const float* modb = MOD + b * 12288;
            const GAS f32x4* xr = (const GAS f32x4*)(x + (size_t)m * DM) + F.lane;
            f32x4 v[8]; float s = 0.f;
#pragma unroll
            for (int j = 0; j < 8; ++j) { v[j] = xr[64 * j]; s += (v[j].x * v[j].x + v[j].y * v[j].y) + (v[j].z * v[j].z + v[j].w * v[j].w); }
            const float rstd = 1.0f / sqrtf(wave_sum(s) * (1.f / DM) + 1e-6f);
            GAS v2u* o8 = (GAS v2u*)(HB + (size_t)m * DM) + F.lane;
#pragma unroll
            for (int j = 0; j < 8; ++j) { const int c0 = 256 * j + 4 * F.lane;
                const f32x4 g = *(const f32x4*)(g_norm1 + c0), sh = *(const f32x4*)(modb + c0), scl = *(const f32x4*)(modb + 2048 + c0);
                const f32x4 h = v[j] * rstd * g * (scl + 1.0f) + sh;
                v2u w; w.x = pk2(h.x, h.y); w.y = pk2(h.z, h.w); o8[64 * j] = w; }
        }
        if (BOTH(1)) GRID_BAR();
    }

    if (IN(2)) {
        PHASE_PTRS(); bf16* HB = P_HB; bf16* WIN_T = P_WIN_T; bf16* ZB = P_ZB;
        pg8::Gemm g{HB, WIN_T, M, DIN, DM}; pg8::StaticOrder S; S.init(M, DIN, F.G, (int)blockIdx.x);
        pg8::EpiZ E{ZB, DIN};
        pg8::gemm_phase<pg8::EpiZ, pg8::StaticOrder, true, true>(F.lds + RING_OFF, g, S, E);
        if (BOTH(2)) GRID_BAR();
    }

    if (IN(3)) {
        PHASE_PTRS(); const float* qn_a = KIN(6); const float* kn_a = KIN(7); const float* qn_b = KIN(8); const float* kn_b = KIN(9); bf16* ZB = P_ZB;
        for (int m = gw; m < M; m += NGW) {
            const int s = m & (SEQ - 1);
            const int a = F.lane >> 5, half = (F.lane >> 4) & 1, i0 = 2 * (F.lane & 15);
            const float pp = (float)(a ? (s & 63) : (s >> 6));
            float s0, c0, s1, c1; att::sincos_rev(pp * att::rope_inv(i0), s0, c0); att::sincos_rev(pp * att::rope_inv(i0 + 1), s1, c1);
            if (half == 0) { s0 = -s0; s1 = -s1; }
            GAS unsigned* zrow = (GAS unsigned*)(ZB + (size_t)m * DIN) + F.lane;
#pragma unroll 4
            for (int hh = 0; hh < 20; ++hh) {
                const int col = (hh < 10) ? hh * 128 : (1536 + (hh - 10) * 128);
                const bool isA = hh < 10; const bool isK = (hh == 8 || hh == 9 || hh >= 18);
                const float* kw = isA ? (isK ? kn_a : qn_a) : (isK ? kn_b : qn_b);
                GAS unsigned* p = zrow + (col >> 1);
                const unsigned w = *p; const float x0 = bf_lo(w), x1 = bf_hi(w);
                const float ss = wave_sum(x0 * x0 + x1 * x1);
                const float rstd = 1.0f / sqrtf(ss * (1.f / 128.f) + 1e-6f);
                const f32x2 kv = *(const f32x2*)(kw + 2 * F.lane);
                float y0 = x0 * rstd * kv.x, y1 = x1 * rstd * kv.y;
                if (isA) { const float py0 = __shfl_xor(y0, 16), py1 = __shfl_xor(y1, 16); y0 = y0 * c0 + py0 * s0; y1 = y1 * c1 + py1 * s1; }
                *p = pk2(y0, y1);
            }
        }
        if (BOTH(3)) GRID_BAR();
    }

    if (IN(4)) {
        PHASE_PTRS(); const float* sink_b = KIN(10); const float* rel_bias = KIN(11); bf16* ZB = P_ZB; bf16* OB = P_OB;
        for (int i = 0; ; ++i) {
            const int w = i * F.G + (int)blockIdx.x; if (w >= 512) break;
            const int combo = w & 7, local = w >> 3, b = combo >> 1, kvh = combo & 1, g = local >> 4, qblk = local & 15, h = kvh * 4 + g;
            const int q0 = qblk * 256; const size_t rowq = (size_t)b * SEQ + q0;
            int ntA = SEQ / 64; asm volatile("" : "+s"(ntA));
            att::attn_unit<false>(ZB + rowq * DIN + h * 128, ZB + (size_t)b * SEQ * DIN + 1024 + kvh * 128, ZB + (size_t)b * SEQ * DIN + 1280 + kvh * 128,
                                  OB + rowq * DM + h * 128, ntA, 0, 0.f, nullptr, (char*)lds + RING_OFF);
        }
        for (int i = 0; ; ++i) {
            const int w = i * F.G + (int)blockIdx.x; if (w >= 512) break;
            const int combo = w & 7, local = w >> 3, b = combo >> 1, kvh = combo & 1, g = local >> 4, qblk = local & 15, h = kvh * 4 + g;
            const int q0 = qblk * 256; const size_t rowq = (size_t)b * SEQ + q0;
            const int ks = (q0 - 128 < 0) ? 0 : q0 - 128, ke = (q0 + 384 > SEQ) ? SEQ : q0 + 384;
            const size_t rowk = (size_t)b * SEQ + ks;
            att::attn_unit<true>(ZB + rowq * DIN + 1536 + h * 128, ZB + rowk * DIN + 2560 + kvh * 128, ZB + rowk * DIN + 2816 + kvh * 128,
                                 OB + rowq * DM + 1024 + h * 128, (ke - ks) / 64, ks - q0, sink_b[h], rel_bias + h, (char*)lds + RING_OFF);
        }
        __syncthreads();
        if (BOTH(4)) GRID_BAR();
    }

    if (IN(5)) {
        PHASE_PTRS(); const float* x = KIN(0); float* out = KOUT; const float* MOD = P_MOD; bf16* OB = P_OB; bf16* WOUT_T = P_WOUT_T;
        pg8::Gemm g{OB, WOUT_T, M, DM, DM}; pg8::StaticOrder S; S.init(M, DM, F.G, (int)blockIdx.x);
        pg8::EpiX1 E{x, out, MOD + 4096};
        pg8::gemm_phase<pg8::EpiX1, pg8::StaticOrder, true, true>(F.lds + RING_OFF, g, S, E);
        if (BOTH(5)) GRID_BAR();
    }

    if (IN(6)) {
        PHASE_PTRS(); const float* g_norm2 = KIN(13); const float* w_router = KIN(14); float* out = KOUT; const float* MOD = P_MOD; bf16* HB = P_HB; float* AFF = P_AFF;
        LAS f32x4* wr = (LAS f32x4*)(F.lds + RING_OFF);
        for (int gidx = F.tid; gidx < 8192; gidx += NWAVES * 64) { const int k = gidx >> 2, q = gidx & 3, j = k >> 8, ln = (k & 255) >> 2, i = k & 3;
            wr[((j * 4 + i) * 4 + q) * 64 + ln] = *(const f32x4*)(w_router + (size_t)gidx * 4); }
        __syncthreads();
        for (int m = gw; m < M; m += NGW) {
            const int b = m >> 12, s = m & (SEQ - 1); const float* modb = MOD + b * 12288;
            const GAS f32x4* xr = (const GAS f32x4*)(out + (size_t)m * DM) + F.lane;
            f32x4 v[8]; float sq = 0.f;
#pragma unroll
            for (int j = 0; j < 8; ++j) { v[j] = xr[64 * j]; sq += (v[j].x * v[j].x + v[j].y * v[j].y) + (v[j].z * v[j].z + v[j].w * v[j].w); }
            const float rstd = 1.0f / sqrtf(wave_sum(sq) * (1.f / DM) + 1e-6f);
            GAS v2u* o8 = (GAS v2u*)(HB + (size_t)m * DM) + F.lane;
            float lg[16];
#pragma unroll
            for (int e = 0; e < 16; ++e) lg[e] = 0.f;
#pragma unroll
            for (int j = 0; j < 8; ++j) { const int c0 = 256 * j + 4 * F.lane;
                const f32x4 g = *(const f32x4*)(g_norm2 + c0), sh = *(const f32x4*)(modb + 6144 + c0), scl = *(const f32x4*)(modb + 8192 + c0);
                const f32x4 h = v[j] * rstd * g * (scl + 1.0f) + sh;
                v2u w; w.x = pk2(h.x, h.y); w.y = pk2(h.z, h.w); o8[64 * j] = w;
#pragma unroll
                for (int i = 0; i < 4; ++i)
#pragma unroll
                    for (int q = 0; q < 4; ++q) { const f32x4 wv = wr[((j * 4 + i) * 4 + q) * 64 + F.lane];
                        lg[4 * q + 0] = fmaf(h[i], wv.x, lg[4 * q + 0]); lg[4 * q + 1] = fmaf(h[i], wv.y, lg[4 * q + 1]);
                        lg[4 * q + 2] = fmaf(h[i], wv.z, lg[4 * q + 2]); lg[4 * q + 3] = fmaf(h[i], wv.w, lg[4 * q + 3]); }
                asm volatile("" ::: "memory"); }
            float mx = -1e30f;
#pragma unroll
            for (int e = 0; e < 16; ++e) { lg[e] = wave_sum(lg[e]); mx = fmaxf(mx, lg[e]); }
            float den = 0.f, mine = 0.f;
#pragma unroll
            for (int e = 0; e < 16; ++e) { const float p = __expf(lg[e] - mx); den += p; if (e == (F.lane & 15)) mine = p; }
            if (F.lane < 16) AFF[((size_t)b * NE + F.lane) * SEQ + s] = mine / den;
        }
        __syncthreads();
        if (BOTH(6)) GRID_BAR();
    }

    if (IN(7)) {
        PHASE_PTRS(); const float* AFF = P_AFF; int* IDX = P_IDX; float* GVR = P_GVR; int* INV = P_INV;
        LAS unsigned* cnts = (LAS unsigned*)(F.lds + RING_OFF);
        for (int p = (int)blockIdx.x; p < NB * NE; p += F.G) {
            const int b = p >> 4, e = p & 15; const float* af = AFF + (size_t)p * SEQ;
            const int s0 = F.tid * 8;
            const f32x4 a0 = *(const f32x4*)(af + s0), a1 = *(const f32x4*)(af + s0 + 4);
            float av[8] = {a0.x, a0.y, a0.z, a0.w, a1.x, a1.y, a1.z, a1.w};
            unsigned key[8];
#pragma unroll
            for (int j = 0; j < 8; ++j) key[j] = __builtin_bit_cast(unsigned, av[j]);
            unsigned prefix = 0u;
            __syncthreads();
            for (int bit = 30; bit >= 0; --bit) {
                const unsigned cand = prefix | (1u << bit);
                unsigned c = 0;
#pragma unroll
                for (int j = 0; j < 8; ++j) c += (unsigned)__builtin_popcountll(__ballot(key[j] >= cand));
                if (F.lane == 0) cnts[(bit & 1) * 8 + F.wave] = c;
                __syncthreads();
                unsigned tot = 0;
#pragma unroll
                for (int w = 0; w < 8; ++w) tot += cnts[(bit & 1) * 8 + w];
                if (tot >= (unsigned)CAP) prefix = cand;
            }
            const unsigned T = prefix;
            unsigned cg = 0, ce = 0;
#pragma unroll
            for (int j = 0; j < 8; ++j) { cg += key[j] > T; ce += key[j] == T; }
            unsigned pk = cg | (ce << 16), inc = pk;
#pragma unroll
            for (int o = 1; o < 64; o <<= 1) { const unsigned t = __shfl_up(inc, o); if (F.lane >= o) inc += t; }
            __syncthreads();
            if (F.lane == 63) cnts[16 + F.wave] = inc;
            __syncthreads();
            unsigned base = 0, total = 0;
#pragma unroll
            for (int w = 0; w < 8; ++w) { const unsigned t = cnts[16 + w]; if (w < F.wave) base += t; total += t; }
            const unsigned excl = base + inc - pk;
            unsigned rg = excl & 0xffffu, re = excl >> 16;
            const unsigned need = (unsigned)CAP - (total & 0xffffu);
#pragma unroll
            for (int j = 0; j < 8; ++j) {
                const int s = s0 + j; int slot = -1;
                if (key[j] > T) { slot = (int)(rg + (re < need ? re : need)); ++rg; }
                else if (key[j] == T) { if (re < need) slot = (int)(rg + re); ++re; }
                INV[((size_t)b * SEQ + s) * NE + e] = slot;
                if (slot >= 0) { IDX[p * CAP + slot] = s; GVR[e * (NB * CAP) + b * CAP + slot] = av[j]; }
            }
        }
        __syncthreads();
        if (BOTH(7)) GRID_BAR();
    }

    if (IN(8)) {
        PHASE_PTRS(); const int* IDX = P_IDX; const bf16* HB = P_HB; bf16* XG = P_XG;
        for (int r = gw; r < RE; r += NGW) {
            const int e = r >> 11, bb = (r >> 9) & 3, slot = r & 511;
            const int s = IDX[(bb * NE + e) * CAP + slot];
            const GAS v4u* src = (const GAS v4u*)(HB + ((size_t)bb * SEQ + s) * DM) + F.lane;
            GAS v4u* dst = (GAS v4u*)(XG + (size_t)r * DM) + F.lane;
            v4u t[4];
#pragma unroll
            for (int j = 0; j < 4; ++j) t[j] = src[64 * j];
#pragma unroll
            for (int j = 0; j < 4; ++j) dst[64 * j] = t[j];
        }
        if (BOTH(8)) GRID_BAR();
    }

    if (IN(9)) {
        PHASE_PTRS(); bf16* XG = P_XG; bf16* WGU_T = P_WGU_T; bf16* ACT = P_ACT;
        pg8::Gemm g{XG, WGU_T, RE, 2 * DE, DM}; pg8::OrderGU S{F.G, (int)blockIdx.x};
        pg8::EpiSwiGLU E{ACT};
        pg8::gemm_phase<pg8::EpiSwiGLU, pg8::OrderGU, true, true>(F.lds + RING_OFF, g, S, E);
        if (BOTH(9)) GRID_BAR();
    }

    if (IN(10)) {
        PHASE_PTRS(); bf16* ACT = P_ACT; bf16* WDN_T = P_WDN_T; bf16* YB = P_YB; const float* GVR = P_GVR;
        pg8::Gemm g{ACT, WDN_T, RE, DM, DE}; pg8::OrderDN S{F.G, (int)blockIdx.x};
        pg8::EpiDown E{YB, GVR};
        pg8::gemm_phase<pg8::EpiDown, pg8::OrderDN, true, true>(F.lds + RING_OFF, g, S, E);
        if (BOTH(10)) GRID_BAR();
    }

    if (IN(11)) {
        PHASE_PTRS(); float* out = KOUT; const float* MOD = P_MOD; const bf16* YB = P_YB; const int* INV = P_INV;
        for (int t = gw; t < M; t += NGW) {
            const int b = t >> 12; const float* gt2 = MOD + b * 12288 + 10240;
            const int inv = INV[(size_t)t * NE + (F.lane & 15)];
            unsigned mask = (unsigned)(__ballot(inv >= 0) & 0xffffull);
            GAS f32x4* xr = (GAS f32x4*)(out + (size_t)t * DM) + F.lane;
            f32x4 v[8], acc[8];
#pragma unroll
            for (int j = 0; j < 8; ++j) { v[j] = xr[64 * j]; acc[j] = (f32x4){0.f, 0.f, 0.f, 0.f}; }
            while (mask) {
                const int e = __builtin_ctz(mask); mask &= mask - 1;
                const int slot = __builtin_amdgcn_readlane(inv, e);
                const GAS v2u* yr = (const GAS v2u*)(YB + ((size_t)e * (NB * CAP) + b * CAP + slot) * DM) + F.lane;
#pragma unroll
                for (int j = 0; j < 8; ++j) { const v2u w = yr[64 * j]; acc[j].x += bf_lo(w.x); acc[j].y += bf_hi(w.x); acc[j].z += bf_lo(w.y); acc[j].w += bf_hi(w.y); }
            }
#pragma unroll
            for (int j = 0; j < 8; ++j) { const f32x4 g = *(const f32x4*)(gt2 + 256 * j + 4 * F.lane); xr[64 * j] = v[j] + g * acc[j]; }
        }
    }
#undef IN
#undef BOTH
#undef GRID_BAR
}

extern "C" void kernel_launch(void* const* d_in, const int* in_sizes, int n_in, void* d_out, int out_size, void* d_ws, size_t ws_size, hipStream_t stream) {
    static int grid = 0;
    if (grid == 0) {
        if (n_in != 18 || in_sizes[0] != M * DM || out_size != M * DM || ws_size < WS_END) { fprintf(stderr, "kernel_launch: shape/workspace mismatch (n_in %d, in0 %d, out %d, ws %zu)\n", n_in, n_in > 0 ? in_sizes[0] : -1, out_size, ws_size); grid = -1; return; }
        int dev = 0, cus = 0, per_cu = 0;
        if (hipGetDevice(&dev) != hipSuccess || hipDeviceGetAttribute(&cus, hipDeviceAttributeMultiprocessorCount, dev) != hipSuccess) { grid = -1; return; }
        if (hipFuncSetAttribute((const void*)fwd_kernel, hipFuncAttributeMaxDynamicSharedMemorySize, LDS_BYTES) != hipSuccess) { fprintf(stderr, "kernel_launch: hipFuncSetAttribute failed\n"); grid = -1; return; }
        if (hipOccupancyMaxActiveBlocksPerMultiprocessor(&per_cu, (const void*)fwd_kernel, NWAVES * 64, LDS_BYTES) != hipSuccess || per_cu < 1)
            fprintf(stderr, "kernel_launch: note: occupancy query reports %d workgroups per CU\n", per_cu);
        (void)hipGetLastError();
        grid = cus;
    }
    if (grid < 0) return;
    if (hipMemsetAsync((char*)d_ws + WS_CTL, 0, CTL_ZERO_BYTES, stream) != hipSuccess) return;
    Args a{};
    for (int i = 0; i < 18; ++i) a.in[i] = (const float*)d_in[i];
    a.out = (float*)d_out; a.ws = (unsigned char*)d_ws;
#if MK_PER_PHASE
    for (int p = 0; p < N_PHASES; ++p) { a.ph_lo = p; a.ph_hi = p + 1; hipLaunchKernelGGL(fwd_kernel, dim3(grid), dim3(NWAVES * 64), LDS_BYTES, stream, a); }
#else
    a.ph_lo = 0; a.ph_hi = N_PHASES; hipLaunchKernelGGL(fwd_kernel, dim3(grid), dim3(NWAVES * 64), LDS_BYTES, stream, a);
#endif
    const hipError_t le = hipPeekAtLastError();
    if (le != hipSuccess) fprintf(stderr, "kernel_launch: launch failed: %s\n", hipGetErrorName(le));
}
```

```cpp
#include <hip/hip_runtime.h>
#include <hip/hip_bf16.h>
#include <cstdio>
#include <cstdint>

#ifndef MK_PER_PHASE
#define MK_PER_PHASE 0
#endif

namespace pg8 {
#define PG8_LAS __attribute__((address_space(3)))
typedef unsigned short bf16_t;
typedef short bf16x8 __attribute__((ext_vector_type(8)));
typedef float f32x4 __attribute__((ext_vector_type(4)));
typedef unsigned u32x4 __attribute__((ext_vector_type(4)));
constexpr int BM = 256, BK = 64, HALF = 128, HTB = HALF * BK * 2, STAGE_BYTES = 8 * HTB, NXCD = 8, WGM = 8;

__host__ __device__ __forceinline__ int lds_byte(int r, int c) { const int st = (r >> 4) * 2 + (c >> 5), rr = r & 15, cc = c & 31, ob = rr * 64 + cc * 2; return st * 1024 + (ob ^ (((ob >> 9) & 1) << 5)); }
__host__ __device__ __forceinline__ void stage_rc(int b, int& R, int& C) { const int st = b / 1024, sb = b % 1024, swz = sb ^ (((sb >> 9) & 1) << 5); R = (st >> 1) * 16 + swz / 64; C = (st & 1) * 32 + (swz % 64) / 2; }
__host__ __device__ __forceinline__ int perm32(int rho) { const int n = rho >> 4, i = rho & 15; return 8 * (i >> 2) + 4 * n + (i & 3); }

struct Unit { int pm, pn; };
struct Gemm { const bf16_t* A; const bf16_t* Bt; int M, N, K; };

struct StaticOrder {
    int nM, nN, nwg, G, c;
    __host__ __device__ void init(int M, int N, int G_, int c_) { nM = M / BM; nN = N / BM; nwg = nM * nN; G = G_; c = c_; }
    __host__ __device__ bool next(int i, Unit& u) const {
        const long L = (long)i * G + c; if (L >= nwg) return false;
        int wgid = (int)L; { const int q = nwg / NXCD, r = nwg % NXCD, xcd = wgid % NXCD, off = wgid / NXCD; wgid = (xcd < r ? xcd * (q + 1) : r * (q + 1) + (xcd - r) * q) + off; }
        const int nig = WGM * nN, gid = wgid / nig, fm = gid * WGM, gsz = (nM - fm) < WGM ? (nM - fm) : WGM;
        u.pm = fm + ((wgid % nig) % gsz); u.pn = (wgid % nig) / gsz; return true;
    }
    __device__ __forceinline__ void a_ready(const Unit&) const {}
    __device__ __forceinline__ void done(const Unit&) const {}
};
struct OrderGU {
    int G, c;
    __device__ bool next(int i, Unit& u) const { const int L = i * G + c; if (L >= 2048) return false; const int e = L >> 7, j = L & 127, x = j & 7, jj = j >> 3;
        u.pm = e * 8 + (x >> 2) * 4 + (jj >> 2); u.pn = e * 16 + (x & 3) * 4 + (jj & 3); return true; }
    __device__ __forceinline__ void a_ready(const Unit&) const {}
    __device__ __forceinline__ void done(const Unit&) const {}
};
struct OrderDN {
    int G, c;
    __device__ bool next(int i, Unit& u) const { const int L = i * G + c; if (L >= 1024) return false; const int e = L >> 6, j = L & 63, x = j & 7, jj = j >> 3;
        u.pm = e * 8 + (x >> 1) * 2 + (jj >> 2); u.pn = e * 8 + (x & 1) * 4 + (jj & 3); return true; }
    __device__ __forceinline__ void a_ready(const Unit&) const {}
    __device__ __forceinline__ void done(const Unit&) const {}
};

__device__ __forceinline__ unsigned cvt_pk_bf16(float lo, float hi) { unsigned r; asm volatile("v_cvt_pk_bf16_f32 %0, %1, %2" : "=v"(r) : "v"(lo), "v"(hi)); return r; }

struct EpiZ {
    static constexpr bool PERM = true, AFTER_DRAIN = false;
    bf16_t* O; int ldc;
    __device__ __forceinline__ void operator()(const f32x4 (&acc)[2][2][4][2], const Unit& u, int wr, int wc, int fr, int fq) const {
        const int row0 = u.pm * BM + wr * 64 + fr, col0 = u.pn * BM + wc * 32 + 8 * fq;
#pragma unroll
        for (int ai = 0; ai < 2; ++ai)
#pragma unroll
            for (int m = 0; m < 4; ++m) { bf16_t* rowp = O + (size_t)(row0 + ai * HALF + m * 16) * ldc + col0;
#pragma unroll
                for (int bj = 0; bj < 2; ++bj) { const f32x4 v0 = acc[ai][bj][m][0], v1 = acc[ai][bj][m][1];
                    u32x4 w; w.x = cvt_pk_bf16(v0[0], v0[1]); w.y = cvt_pk_bf16(v0[2], v0[3]); w.z = cvt_pk_bf16(v1[0], v1[1]); w.w = cvt_pk_bf16(v1[2], v1[3]);
                    *(u32x4*)(rowp + bj * HALF) = w; } }
    }
};
struct EpiX1 {
    static constexpr bool PERM = true, AFTER_DRAIN = false;
    const float* x; float* out; const float* gate;
    __device__ __forceinline__ void operator()(const f32x4 (&acc)[2][2][4][2], const Unit& u, int wr, int wc, int fr, int fq) const {
        const int row0 = u.pm * BM + wr * 64 + fr, col0 = u.pn * BM + wc * 32 + 8 * fq, b = u.pm >> 4;
        f32x4 gv[2][2];
#pragma unroll
        for (int bj = 0; bj < 2; ++bj)
#pragma unroll
            for (int n = 0; n < 2; ++n) gv[bj][n] = *(const f32x4*)(gate + (size_t)b * 12288 + col0 + bj * HALF + 4 * n);
#pragma unroll
        for (int ai = 0; ai < 2; ++ai)
#pragma unroll
            for (int m = 0; m < 4; ++m) { const size_t ro = (size_t)(row0 + ai * HALF + m * 16) * 2048 + col0;
#pragma unroll
                for (int bj = 0; bj < 2; ++bj)
#pragma unroll
                    for (int n = 0; n < 2; ++n) { const f32x4 xi = *(const f32x4*)(x + ro + bj * HALF + 4 * n);
                        *(f32x4*)(out + ro + bj * HALF + 4 * n) = xi + gv[bj][n] * acc[ai][bj][m][n]; } }
    }
};
struct EpiSwiGLU {
    static constexpr bool PERM = true, AFTER_DRAIN = false;
    unsigned char* O;
    __device__ __forceinline__ void operator()(const f32x4 (&acc)[2][2][4][2], const Unit& u, int wr, int wc, int fr, int fq) const {
        const int row0 = u.pm * BM + wr * 64 + fr, col0 = (u.pn & 15) * HALF + wc * 32 + 8 * fq;
#pragma unroll
        for (int ai = 0; ai < 2; ++ai)
#pragma unroll
            for (int m = 0; m < 4; ++m) { unsigned char* rowp = O + (size_t)(row0 + ai * HALF + m * 16) * 2048 + col0;
                float r[8];
#pragma unroll
                for (int n = 0; n < 2; ++n)
#pragma unroll
                    for (int i = 0; i < 4; ++i) { const float a = acc[ai][0][m][n][i] * (1.f / 256.f), uu = acc[ai][1][m][n][i] * (1.f / 256.f);
                        const float sg = __builtin_amdgcn_rcpf(1.f + __builtin_amdgcn_exp2f(-1.4426950408889634f * a));
                        r[n * 4 + i] = __builtin_fminf(__builtin_fmaxf(a * sg * uu, -448.f), 448.f); }
                int lo = __builtin_amdgcn_cvt_pk_fp8_f32(r[0], r[1], 0, false); lo = __builtin_amdgcn_cvt_pk_fp8_f32(r[2], r[3], lo, true);
                int hi = __builtin_amdgcn_cvt_pk_fp8_f32(r[4], r[5], 0, false); hi = __builtin_amdgcn_cvt_pk_fp8_f32(r[6], r[7], hi, true);
                typedef unsigned u32x2 __attribute__((ext_vector_type(2)));
                *(u32x2*)rowp = (u32x2){(unsigned)lo, (unsigned)hi}; }
    }
};
struct EpiDown {
    static constexpr bool PERM = true, AFTER_DRAIN = false;
    bf16_t* O; const float* gvr;
    __device__ __forceinline__ void operator()(const f32x4 (&acc)[2][2][4][2], const Unit& u, int wr, int wc, int fr, int fq) const {
        const int row0 = u.pm * BM + wr * 64 + fr, col0 = (u.pn & 7) * BM + wc * 32 + 8 * fq;
#pragma unroll
        for (int ai = 0; ai < 2; ++ai)
#pragma unroll
            for (int m = 0; m < 4; ++m) { const int row = row0 + ai * HALF + m * 16; const float g = gvr[row] * (1.f / 256.f); bf16_t* rowp = O + (size_t)row * 2048 + col0;
#pragma unroll
                for (int bj = 0; bj < 2; ++bj) { const f32x4 v0 = acc[ai][bj][m][0] * g, v1 = acc[ai][bj][m][1] * g;
                    u32x4 w; w.x = cvt_pk_bf16(v0[0], v0[1]); w.y = cvt_pk_bf16(v0[2], v0[3]); w.z = cvt_pk_bf16(v1[0], v1[1]); w.w = cvt_pk_bf16(v1[2], v1[3]);
                    *(u32x4*)(rowp + bj * HALF) = w; } }
    }
};

typedef int v4i_t __attribute__((ext_vector_type(4)));
typedef int v8i_t __attribute__((ext_vector_type(8)));
template <class Epi, class Sched, bool ALIGN_EPI = false, bool SP2 = false, bool FP8 = false, bool GATHER = false>
__device__ __forceinline__ void gemm_phase(PG8_LAS unsigned char* lds, const Gemm g, const Sched& S, const Epi& E, const PG8_LAS int* rowmap = nullptr) {
    int tid_ = threadIdx.x; asm volatile("" : "+v"(tid_));
    const int tid = tid_ & 511, wid = __builtin_amdgcn_readfirstlane(tid >> 6), lane = tid & 63, wr = wid >> 2, wc = wid & 3, fr = lane & 15, fq = lane >> 4;
    constexpr int ES = FP8 ? 1 : 2, BKE = FP8 ? 128 : 64;
    const int K = g.K, nt = K / BKE;
    const unsigned Kb = (unsigned)K * ES;
    unsigned voffB[2];
#pragma unroll
    for (int i = 0; i < 2; ++i) { int R, C; stage_rc(tid * 16 + i * 8192, R, C); const int Rb = Epi::PERM ? ((R & ~31) + perm32(R & 31)) : R;
        voffB[i] = (unsigned)Rb * Kb + (unsigned)C * 2u; }
    const size_t kstep = (size_t)128;
    const size_t hstep = (size_t)HALF * Kb;
    const size_t tstep = 2 * hstep;
    const unsigned ldsw = (unsigned)wid * 1024u;
    const int aoff = lds_byte(wr * 64 + fr, fq * 8), boff = lds_byte(wc * 32 + fr, fq * 8);
#define PG8_SA(b, h) (((b) * 2 + (h)) * HTB)
#define PG8_SB(b, h) ((4 + (b) * 2 + (h)) * HTB)
#define PG8_STAGE(bufoff, gbase, voff) do { _Pragma("unroll") for (int _i = 0; _i < 2; ++_i) \
        __builtin_amdgcn_global_load_lds((const unsigned*)((const char*)(gbase) + (voff)[_i]), (PG8_LAS unsigned*)(lds + (bufoff) + ldsw + _i * 8192), 16, 0, 0); } while (0)
#define PG8_LDA(dst, b, h) do { _Pragma("unroll") for (int m = 0; m < 4; ++m) _Pragma("unroll") for (int k = 0; k < 2; ++k) dst[m][k] = *(const PG8_LAS bf16x8*)(lds + PG8_SA(b, h) + aoff + m * 2048 + k * 1024); } while (0)
#define PG8_LDB(dst, b, h) do { _Pragma("unroll") for (int n = 0; n < 2; ++n) _Pragma("unroll") for (int k = 0; k < 2; ++k) dst[n][k] = *(const PG8_LAS bf16x8*)(lds + PG8_SB(b, h) + boff + n * 2048 + k * 1024); } while (0)
#define PG8_CAT(X) __builtin_shufflevector(__builtin_bit_cast(v4i_t, X[0]), __builtin_bit_cast(v4i_t, X[1]), 0, 1, 2, 3, 4, 5, 6, 7)
#define PG8_MMA(ai, bj, At, Bt) do { __builtin_amdgcn_s_setprio(1); _Pragma("unroll") for (int m = 0; m < 4; ++m) _Pragma("unroll") for (int n = 0; n < 2; ++n) { \
        if constexpr (FP8) acc[ai][bj][m][n] = __builtin_amdgcn_mfma_scale_f32_16x16x128_f8f6f4(PG8_CAT(Bt[n]), PG8_CAT(At[m]), acc[ai][bj][m][n], 0, 0, 0, 0x7F7F7F7F, 0, 0x7F7F7F7F); \
        else { _Pragma("unroll") for (int k = 0; k < 2; ++k) acc[ai][bj][m][n] = __builtin_amdgcn_mfma_f32_16x16x32_bf16(Bt[n][k], At[m][k], acc[ai][bj][m][n], 0, 0, 0); } } \
        __builtin_amdgcn_s_setprio(0); } while (0)
#define PG8_WAIT_V(n) asm volatile("s_waitcnt vmcnt(" #n ")" ::: "memory")
#define PG8_WAIT_L(n) asm volatile("s_waitcnt lgkmcnt(" #n ")" ::: "memory")
#define PG8_BAR __builtin_amdgcn_s_barrier()
#define PG8_SCHED __builtin_amdgcn_sched_barrier(0)
#define PG8_AOFFS(dst, unit, uidx) do { _Pragma("unroll") for (int i = 0; i < 2; ++i) { int R_, C_; stage_rc(tid * 16 + i * 8192, R_, C_); _Pragma("unroll") for (int h = 0; h < 2; ++h) { \
        unsigned row; if constexpr (GATHER) row = (unsigned)rowmap[(uidx) * 256 + h * HALF + R_]; else row = (unsigned)((unit).pm * BM + h * HALF + R_); \
        dst[h][i] = row * Kb + (unsigned)C_ * 2u; } } } while (0)
    Unit cur, nxt; int ui = 0;
    if (!S.next(0, cur)) return;
    f32x4 acc[2][2][4][2];
#pragma unroll
    for (int a = 0; a < 2; ++a)
#pragma unroll
        for (int b = 0; b < 2; ++b)
#pragma unroll
            for (int m = 0; m < 4; ++m)
#pragma unroll
                for (int n = 0; n < 2; ++n) acc[a][b][m][n] = (f32x4){0.f, 0.f, 0.f, 0.f};
    bf16x8 At[4][2], B0[2][2], B1[2][2];
    unsigned vA[2][2];
    PG8_AOFFS(vA, cur, 0);
    const char* const gA = (const char*)g.A;
    const char* cB = (const char*)g.Bt + (size_t)cur.pn * tstep;
    S.a_ready(cur);
    if constexpr (SP2) {
        PG8_STAGE(PG8_SB(0, 0), cB, voffB); PG8_STAGE(PG8_SB(0, 1), cB + hstep, voffB); PG8_STAGE(PG8_SA(0, 0), gA, vA[0]); PG8_STAGE(PG8_SA(0, 1), gA, vA[1]);
        if (wr == 1) PG8_BAR;
        PG8_WAIT_V(2); PG8_BAR;
        PG8_STAGE(PG8_SB(1, 0), cB + kstep, voffB); PG8_STAGE(PG8_SA(1, 0), gA + kstep, vA[0]); PG8_STAGE(PG8_SB(1, 1), cB + hstep + kstep, voffB);
        PG8_WAIT_V(6); PG8_BAR;
    } else {
        PG8_STAGE(PG8_SB(0, 0), cB, voffB); PG8_STAGE(PG8_SA(0, 0), gA, vA[0]); PG8_STAGE(PG8_SB(0, 1), cB + hstep, voffB); PG8_STAGE(PG8_SA(0, 1), gA, vA[1]);
        if (wr == 1) PG8_BAR;
        PG8_WAIT_V(4); PG8_BAR;
        PG8_STAGE(PG8_SB(1, 0), cB + kstep, voffB); PG8_STAGE(PG8_SA(1, 0), gA + kstep, vA[0]); PG8_STAGE(PG8_SB(1, 1), cB + hstep + kstep, voffB);
        PG8_WAIT_V(6); PG8_BAR;
    }
    for (;;) {
        const bool has_next = S.next(ui + 1, nxt);
        const char* nB = has_next ? (const char*)g.Bt + (size_t)nxt.pn * tstep : cB;
        for (int t = 0; t < nt; t += 2) {
            const bool last = (t == nt - 2);
            const char* a1 = gA + (size_t)(t + 1) * kstep;
            const char* a2 = last ? gA : gA + (size_t)(t + 2) * kstep; const char* b2 = last ? nB : cB + (size_t)(t + 2) * kstep;
            const char* a3 = a2 + kstep; const char* b3 = b2 + kstep;
            if (last && has_next) S.a_ready(nxt);
            if constexpr (SP2) {
            PG8_LDB(B0, 0, 0); PG8_LDB(B1, 0, 1); PG8_SCHED; PG8_LDA(At, 0, 0); PG8_STAGE(PG8_SA(1, 1), a1, vA[1]);
            if (last && has_next) { PG8_AOFFS(vA, nxt, ui + 1); }
            PG8_WAIT_V(8); PG8_WAIT_L(0); PG8_BAR; PG8_MMA(0, 0, At, B0); PG8_MMA(0, 1, At, B1); PG8_BAR; PG8_SCHED;
            PG8_LDA(At, 0, 1); PG8_STAGE(PG8_SB(0, 0), b2, voffB); PG8_STAGE(PG8_SB(0, 1), b2 + hstep, voffB); PG8_STAGE(PG8_SA(0, 0), a2, vA[0]);
            PG8_WAIT_V(8); PG8_WAIT_L(0); PG8_BAR; PG8_MMA(1, 0, At, B0); PG8_MMA(1, 1, At, B1); PG8_BAR; PG8_SCHED;
            PG8_LDB(B0, 1, 0); PG8_LDB(B1, 1, 1); PG8_SCHED; PG8_LDA(At, 1, 0); PG8_STAGE(PG8_SA(0, 1), a2, vA[1]);
            PG8_WAIT_V(8); PG8_WAIT_L(0); PG8_BAR; PG8_MMA(0, 0, At, B0); PG8_MMA(0, 1, At, B1); PG8_BAR; PG8_SCHED;
            PG8_LDA(At, 1, 1); PG8_STAGE(PG8_SB(1, 0), b3, voffB); PG8_STAGE(PG8_SB(1, 1), b3 + hstep, voffB); PG8_STAGE(PG8_SA(1, 0), a3, vA[0]);
            PG8_WAIT_V(8); PG8_WAIT_L(0); PG8_BAR; PG8_MMA(1, 0, At, B0); PG8_MMA(1, 1, At, B1); PG8_BAR; PG8_SCHED;
            } else {
            PG8_LDB(B0, 0, 0); PG8_SCHED; PG8_LDA(At, 0, 0); PG8_STAGE(PG8_SA(1, 1), a1, vA[1]);
            if (last && has_next) { PG8_AOFFS(vA, nxt, ui + 1); }
            PG8_WAIT_L(8); PG8_BAR; PG8_WAIT_L(0); PG8_MMA(0, 0, At, B0); PG8_BAR; PG8_SCHED;
            PG8_LDB(B1, 0, 1); PG8_STAGE(PG8_SB(0, 0), b2, voffB);
            PG8_BAR; PG8_WAIT_L(0); PG8_MMA(0, 1, At, B1); PG8_BAR;
            PG8_LDA(At, 0, 1); PG8_STAGE(PG8_SA(0, 0), a2, vA[0]);
            PG8_BAR; PG8_WAIT_L(0); PG8_MMA(1, 0, At, B0); PG8_BAR; PG8_SCHED;
            PG8_STAGE(PG8_SB(0, 1), b2 + hstep, voffB);
            PG8_WAIT_V(6); PG8_BAR; PG8_MMA(1, 1, At, B1); PG8_BAR;
            PG8_LDB(B0, 1, 0); PG8_SCHED; PG8_LDA(At, 1, 0); PG8_STAGE(PG8_SA(0, 1), a2, vA[1]);
            PG8_WAIT_L(8); PG8_BAR; PG8_WAIT_L(0); PG8_MMA(0, 0, At, B0); PG8_BAR; PG8_SCHED;
            PG8_LDB(B1, 1, 1); PG8_STAGE(PG8_SB(1, 0), b3, voffB);
            PG8_BAR; PG8_WAIT_L(0); PG8_MMA(0, 1, At, B1); PG8_BAR;
            PG8_LDA(At, 1, 1); PG8_STAGE(PG8_SA(1, 0), a3, vA[0]);
            PG8_BAR; PG8_WAIT_L(0); PG8_MMA(1, 0, At, B0); PG8_BAR; PG8_SCHED;
            PG8_STAGE(PG8_SB(1, 1), b3 + hstep, voffB);
            PG8_WAIT_V(6); PG8_BAR; PG8_MMA(1, 1, At, B1); PG8_BAR;
            }
        }
        if constexpr (ALIGN_EPI) { if (wr == 0) PG8_BAR; }
        if constexpr (!Epi::AFTER_DRAIN) { E(acc, cur, wr, wc, fr, fq); S.done(cur); }
        if (!has_next) break;
#pragma unroll
        for (int a = 0; a < 2; ++a)
#pragma unroll
            for (int b = 0; b < 2; ++b)
#pragma unroll
                for (int m = 0; m < 4; ++m)
#pragma unroll
                    for (int n = 0; n < 2; ++n) acc[a][b][m][n] = (f32x4){0.f, 0.f, 0.f, 0.f};
        cur = nxt; cB = nB; ++ui;
        if constexpr (ALIGN_EPI) { if (wr == 1) PG8_BAR; }
    }
    PG8_WAIT_V(0);
    if constexpr (!ALIGN_EPI) { if (wr == 0) PG8_BAR; }
    PG8_BAR;
#undef PG8_SA
#undef PG8_SB
#undef PG8_STAGE
#undef PG8_LDA
#undef PG8_LDB
#undef PG8_CAT
#undef PG8_MMA
#undef PG8_WAIT_V
#undef PG8_WAIT_L
#undef PG8_BAR
#undef PG8_SCHED
#undef PG8_AOFFS
}
}

namespace att {
using bf16 = unsigned short;
using bf16x8 = __attribute__((ext_vector_type(8))) short;
using s16x4  = __attribute__((ext_vector_type(4))) short;
using f32x16 = __attribute__((ext_vector_type(16))) float;
using u32x4  = __attribute__((ext_vector_type(4))) unsigned;
constexpr int D = 128, NW = 8, QBLK = 32, KVBLK = 64;
constexpr float SCALE = 0.088388347648318440f;
constexpr float THR = 8.f;
#ifndef ATT_SDEPTH
#define ATT_SDEPTH 2
#endif
constexpr int SDEPTH = ATT_SDEPTH;
constexpr int LDZ = 3072, LDO = 2048;
constexpr int SHM_V = KVBLK * D * 2, SHM_K = KVBLK * D * 2;
constexpr int OFF_WS = 2 * SHM_V + 2 * SHM_K, OFF_TAB = OFF_WS + NW * 64 * 4, SHM_ATTN = OFF_TAB + 768 * 4;
constexpr float MASKV = -1e37f;
#define KSWZ(row, colB) ((row) * 256 + ((colB) ^ (((row) & 7) << 4)))
#define SBAR() __builtin_amdgcn_sched_barrier(0)
__device__ __forceinline__ int crow(int r, int hi) { return (r & 3) + 8 * (r >> 2) + 4 * hi; }
__device__ __forceinline__ unsigned cvtpk(float lo, float hi) { unsigned r; asm volatile("v_cvt_pk_bf16_f32 %0, %1, %2" : "=v"(r) : "v"(lo), "v"(hi)); return r; }
__device__ __forceinline__ float bf2f(unsigned short h) { return __builtin_bit_cast(float, (unsigned)h << 16); }

__device__ __forceinline__ void partialSM(f32x16& p0, f32x16& p1, float& m_reg, float& mn, float& alpha) {
  constexpr float C = SCALE * 1.4426950408889634f;
  float pmax = p0[0];
#pragma unroll
  for (int r = 1; r < 16; ++r) pmax = fmaxf(pmax, p0[r]);
#pragma unroll
  for (int r = 0; r < 16; ++r) pmax = fmaxf(pmax, p1[r]);
  { auto rr = __builtin_amdgcn_permlane32_swap(__float_as_uint(pmax), __float_as_uint(pmax), false, false);
    pmax = fmaxf(__uint_as_float(rr[0]), __uint_as_float(rr[1])); }
  if (__builtin_expect(__all(pmax - m_reg <= THR / SCALE), 1)) { mn = m_reg; alpha = 1.f; }
  else { mn = fmaxf(m_reg, pmax); alpha = __builtin_amdgcn_exp2f((m_reg - mn) * C); m_reg = mn; }
  float mnC = -mn * C;
#pragma unroll
  for (int r = 0; r < 16; ++r) p0[r] = fmaf(p0[r], C, mnC);
#pragma unroll
  for (int r = 0; r < 16; ++r) p1[r] = fmaf(p1[r], C, mnC);
#pragma unroll
  for (int r = 0; r < 16; ++r) p0[r] = __builtin_amdgcn_exp2f(p0[r]);
}
__device__ __forceinline__ void finishSM(f32x16& p0, f32x16& p1, float alpha, float& l_reg, bf16x8& pa0, bf16x8& pa1, bf16x8& pa2, bf16x8& pa3) {
#pragma unroll
  for (int r = 0; r < 16; ++r) p1[r] = __builtin_amdgcn_exp2f(p1[r]);
  float ps = 0;
#pragma unroll
  for (int r = 0; r < 16; ++r) ps += p0[r];
#pragma unroll
  for (int r = 0; r < 16; ++r) ps += p1[r];
  { auto rr = __builtin_amdgcn_permlane32_swap(__float_as_uint(ps), __float_as_uint(ps), false, false);
    ps = __uint_as_float(rr[0]) + __uint_as_float(rr[1]); }
  l_reg = l_reg * alpha + ps;
#define PK4(P, BASE, OUT) do { unsigned a0 = cvtpk(P[BASE + 0], P[BASE + 1]), a1 = cvtpk(P[BASE + 2], P[BASE + 3]);   \
    unsigned b0 = cvtpk(P[BASE + 4], P[BASE + 5]), b1 = cvtpk(P[BASE + 6], P[BASE + 7]);                              \
    auto r0 = __builtin_amdgcn_permlane32_swap(a0, b0, false, false); auto r1 = __builtin_amdgcn_permlane32_swap(a1, b1, false, false); \
    u32x4 w = {r0[0], r1[0], r0[1], r1[1]}; OUT = *reinterpret_cast<bf16x8*>(&w); } while (0)
  PK4(p0, 0, pa0); PK4(p0, 8, pa1); PK4(p1, 0, pa2); PK4(p1, 8, pa3);
#undef PK4
}
__device__ __forceinline__ void qkt(f32x16& p0, f32x16& p1, const char* Ks, const bf16x8* qr, int r32, int hi) {
  p0 = f32x16{}; p1 = f32x16{};
#pragma unroll
  for (int d0 = 0; d0 < 8; ++d0) { int cb = (d0 * 16 + hi * 8) * 2;
    bf16x8 b0 = *reinterpret_cast<const bf16x8*>(Ks + KSWZ(r32, cb));
    bf16x8 b1 = *reinterpret_cast<const bf16x8*>(Ks + KSWZ(32 + r32, cb));
    p0 = __builtin_amdgcn_mfma_f32_32x32x16_bf16(b0, qr[d0], p0, 0, 0, 0);
    p1 = __builtin_amdgcn_mfma_f32_32x32x16_bf16(b1, qr[d0], p1, 0, 0, 0); }
}
__device__ __forceinline__ int v_st(int k, int c) { const int kk = (k & ~0xC) | ((k & 4) << 1) | ((k & 8) >> 1); return ((kk >> 3) * 4 + (c >> 5)) * 512 + ((kk & 7) * 32 + (c & 31)) * 2; }
__device__ __forceinline__ int v_rd_base(int lane) { return ((lane & 3) << 3) | (((lane >> 2) & 3) << 6) | (((lane >> 4) & 1) << 5) | (((lane >> 5) & 1) << 8); }
constexpr int v_rd_off(int d0, int ks, int half) { return d0 * 512 + ks * 4096 + half * 2048; }
template <int OFF> __device__ __forceinline__ s16x4 tr_read(int vb) {
  s16x4 r; asm volatile("ds_read_b64_tr_b16 %0, %1 offset:%2" : "=&v"(r) : "v"(vb), "i"(OFF) : "memory"); return r;
}
template <int D0> __device__ __forceinline__ void pv_one(f32x16& od, int vb, bf16x8 pa0, bf16x8 pa1, bf16x8 pa2, bf16x8 pa3) {
  const s16x4 l0 = tr_read<v_rd_off(D0, 0, 0)>(vb), h0 = tr_read<v_rd_off(D0, 0, 1)>(vb), l1 = tr_read<v_rd_off(D0, 1, 0)>(vb), h1 = tr_read<v_rd_off(D0, 1, 1)>(vb);
  const s16x4 l2 = tr_read<v_rd_off(D0, 2, 0)>(vb), h2 = tr_read<v_rd_off(D0, 2, 1)>(vb), l3 = tr_read<v_rd_off(D0, 3, 0)>(vb), h3 = tr_read<v_rd_off(D0, 3, 1)>(vb);
  asm volatile("s_waitcnt lgkmcnt(0)" ::: "memory"); SBAR();
#define PK(L, H) (bf16x8){L[0], L[1], L[2], L[3], H[0], H[1], H[2], H[3]}
  od = __builtin_amdgcn_mfma_f32_32x32x16_bf16(pa0, PK(l0, h0), od, 0, 0, 0);
  od = __builtin_amdgcn_mfma_f32_32x32x16_bf16(pa1, PK(l1, h1), od, 0, 0, 0);
  od = __builtin_amdgcn_mfma_f32_32x32x16_bf16(pa2, PK(l2, h2), od, 0, 0, 0);
  od = __builtin_amdgcn_mfma_f32_32x32x16_bf16(pa3, PK(l3, h3), od, 0, 0, 0);
#undef PK
}
__device__ __forceinline__ void pv_d0(f32x16* o, int vb, bf16x8 pa0, bf16x8 pa1, bf16x8 pa2, bf16x8 pa3) {
  pv_one<0>(o[0], vb, pa0, pa1, pa2, pa3); pv_one<1>(o[1], vb, pa0, pa1, pa2, pa3); pv_one<2>(o[2], vb, pa0, pa1, pa2, pa3); pv_one<3>(o[3], vb, pa0, pa1, pa2, pa3);
}
__device__ __forceinline__ int t5_bucket(int rel) {
  const int n = rel < 0 ? -rel : rel;
  const int large = 8 + (n >= 12) + (n >= 16) + (n >= 23) + (n >= 32) + (n >= 46) + (n >= 64) + (n >= 91);
  return (rel > 0 ? 16 : 0) + (n < 8 ? n : large);
}
__device__ __forceinline__ float rope_inv(int i) { return __builtin_amdgcn_exp2f((float)i * (-13.287712379549449f / 32.f)); }
__device__ __forceinline__ void sincos_rev(float ang, float& s, float& c) {
  float rev = ang * 0.15915494309189535f; rev = rev - __builtin_rintf(rev);
  s = __builtin_amdgcn_sinf(rev); c = __builtin_amdgcn_cosf(rev);
}

template <bool WIN>
__device__ __forceinline__ void attn_unit(const bf16* __restrict__ Zq, const bf16* __restrict__ Kh, const bf16* __restrict__ Vh, bf16* __restrict__ Ob, int NT,
                                          int relk0, float sinkv, const float* __restrict__ relb, char* lds) {
  int tid_ = threadIdx.x; asm volatile("" : "+v"(tid_));
  const int tid = tid_ & 511, wid = tid >> 6, lane = tid & 63, r32 = lane & 31, hi = lane >> 5;
  char* V_lds = lds; char* K_lds = lds + 2 * SHM_V;
  float* ws = (float*)(lds + OFF_WS) + wid * 64; float* li_l = ws; float* al_l = ws + 32;
  float* tab = (float*)(lds + OFF_TAB);
  __syncthreads();
  if constexpr (WIN) {
    for (int i = tid; i < 768; i += 512) { const int rel = i - 384; const int n = rel < 0 ? -rel : rel;
      tab[i] = (n <= 128) ? relb[t5_bucket(rel) * 8] * (1.0f / SCALE) : MASKV; }
  }
  float m_reg = -1e30f, l_reg = 0; f32x16 o[4] = {}; bf16x8 qr[8];
  {
    const bf16* Qw = Zq + (long)(wid * QBLK + r32) * LDZ + hi * 8;
#pragma unroll
    for (int d0 = 0; d0 < 8; ++d0) qr[d0] = *reinterpret_cast<const bf16x8*>(Qw + d0 * 16);
  }
  const int sr = tid >> 4, sc = (tid & 15) * 8, vst0 = v_st(sr, sc), vst1 = v_st(32 + sr, sc);
  const int vb0 = (int)(uintptr_t)V_lds + v_rd_base(lane);
  struct { bf16x8 vs0, vs1, ks0, ks1; } sr_[SDEPTH];
#define LD8(p) (*reinterpret_cast<const bf16x8*>(p))
#define SLOAD(i, k0) do { sr_[i].vs0 = LD8(&Vh[(long)((k0) + sr) * LDZ + sc]); sr_[i].vs1 = LD8(&Vh[(long)((k0) + 32 + sr) * LDZ + sc]); \
    sr_[i].ks0 = LD8(&Kh[(long)((k0) + sr) * LDZ + sc]); sr_[i].ks1 = LD8(&Kh[(long)((k0) + 32 + sr) * LDZ + sc]); } while (0)
#define SWRITE(b, i) do { *(bf16x8*)(V_lds + (b) * SHM_V + vst0) = sr_[i].vs0;          \
    *(bf16x8*)(V_lds + (b) * SHM_V + vst1) = sr_[i].vs1; int kc = sc * 2;               \
    *(bf16x8*)(K_lds + (b) * SHM_K + KSWZ(sr, kc)) = sr_[i].ks0;                       \
    *(bf16x8*)(K_lds + (b) * SHM_K + KSWZ(32 + sr, kc)) = sr_[i].ks1; } while (0)
#define SWAIT() do { if constexpr (SDEPTH == 2) asm volatile("s_waitcnt vmcnt(4)" ::: "memory"); else asm volatile("s_waitcnt vmcnt(0)" ::: "memory"); } while (0)
#define RESC(a) do { if (__any((a) < 1.f)) { if (hi == 0) al_l[r32] = (a); asm volatile("s_waitcnt lgkmcnt(0)" ::: "memory"); \
    _Pragma("unroll") for (int d = 0; d < 4; ++d) _Pragma("unroll") for (int r = 0; r < 16; ++r) o[d][r] *= al_l[crow(r, hi)]; } } while (0)
#define BIAS(P0, P1, t) do { if constexpr (WIN) { const float* tp = tab + (384 + relk0 + 64 * (t) - (wid * QBLK + r32) + 4 * hi); \
    _Pragma("unroll") for (int r = 0; r < 16; ++r) { P0[r] += tp[(r & 3) + 8 * (r >> 2)]; P1[r] += tp[32 + (r & 3) + 8 * (r >> 2)]; } } } while (0)
  f32x16 pA0, pA1, pB0, pB1; float mnA, mnB, alA, alB; bf16x8 pa0, pa1, pa2, pa3;
  constexpr int SE = 0, SO = SDEPTH - 1;
  SLOAD(SE, 0); asm volatile("s_waitcnt vmcnt(0)" ::: "memory"); SWRITE(0, SE); __syncthreads();
  qkt(pA0, pA1, K_lds, qr, r32, hi); BIAS(pA0, pA1, 0); partialSM(pA0, pA1, m_reg, mnA, alA);
  SLOAD(SO, KVBLK); if constexpr (SDEPTH == 2) { if (2 < NT) SLOAD(SE, 2 * KVBLK); }
  SWAIT(); SWRITE(1, SO); __syncthreads();
  for (int j = 1; j + 1 < NT; j += 2) {
    SBAR(); qkt(pB0, pB1, K_lds + SHM_K, qr, r32, hi);
    finishSM(pA0, pA1, alA, l_reg, pa0, pa1, pa2, pa3); SBAR();
    SLOAD(SO, (j + SDEPTH) * KVBLK); SBAR();
    pv_d0(o, vb0, pa0, pa1, pa2, pa3); BIAS(pB0, pB1, j); partialSM(pB0, pB1, m_reg, mnB, alB);
    __syncthreads(); SWAIT(); SWRITE(0, SE);
    RESC(alB); __syncthreads();
    SBAR(); qkt(pA0, pA1, K_lds, qr, r32, hi);
    finishSM(pB0, pB1, alB, l_reg, pa0, pa1, pa2, pa3); SBAR();
    if (SDEPTH == 1 || j + 3 < NT) SLOAD(SE, (j + 1 + SDEPTH) * KVBLK); SBAR();
    pv_d0(o, vb0 + SHM_V, pa0, pa1, pa2, pa3); BIAS(pA0, pA1, j + 1); partialSM(pA0, pA1, m_reg, mnA, alA);
    __syncthreads(); SWAIT(); SWRITE(1, SO);
    RESC(alA); __syncthreads();
  }
  SBAR(); qkt(pB0, pB1, K_lds + SHM_K, qr, r32, hi);
  finishSM(pA0, pA1, alA, l_reg, pa0, pa1, pa2, pa3); SBAR();
  pv_d0(o, vb0, pa0, pa1, pa2, pa3); BIAS(pB0, pB1, NT - 1); partialSM(pB0, pB1, m_reg, mnB, alB);
  __syncthreads(); RESC(alB);
  finishSM(pB0, pB1, alB, l_reg, pa0, pa1, pa2, pa3); SBAR();
  pv_d0(o, vb0 + SHM_V, pa0, pa1, pa2, pa3);
  if constexpr (WIN) { constexpr float C = SCALE * 1.4426950408889634f; l_reg += __builtin_amdgcn_exp2f(fminf(sinkv * 1.4426950408889634f - m_reg * C, 120.f)); }
  if (hi == 0) li_l[r32] = l_reg; asm volatile("s_waitcnt lgkmcnt(0)" ::: "memory");
  float rli[16];
#pragma unroll
  for (int r = 0; r < 16; ++r) rli[r] = __builtin_amdgcn_rcpf(li_l[crow(r, hi)]);
  bf16* Ow = Ob + (long)(wid * QBLK) * LDO;
#pragma unroll
  for (int r = 0; r < 16; ++r) { const int orow = crow(r, hi);
#pragma unroll
    for (int d0 = 0; d0 < 4; ++d0) { const float v = o[d0][r] * rli[r]; Ow[(long)orow * LDO + d0 * 32 + r32] = (bf16)(cvtpk(v, v) & 0xffffu); } }
#undef LD8
#undef SLOAD
#undef SWRITE
#undef SWAIT
#undef RESC
#undef BIAS
}
#undef KSWZ
}

constexpr int NWAVES = 8;
constexpr int NB = 4, SEQ = 4096, DM = 2048, M = NB * SEQ, DIN = 3072, NE = 16, CAP = 512, DE = 2048, RE = NE * NB * CAP;
constexpr int N_PHASES = 11;
constexpr float WSCALE = 256.f, WSCALE_INV = 1.f / 256.f;
constexpr size_t MiB = 1u << 20;
constexpr size_t WS_CTL = 0, CTL_ZERO_BYTES = 1 * MiB;
constexpr size_t WS_MOD = 256 * 1024;
constexpr size_t WS_WIN = 2 * MiB, WS_WOUT = 14 * MiB;
constexpr size_t WS_WGU = 24 * MiB, WS_WDN = 152 * MiB;
constexpr size_t WS_H = 216 * MiB;
constexpr size_t WS_Z = 280 * MiB, WS_O = 376 * MiB;
constexpr size_t WS_ACT = 440 * MiB;
constexpr size_t WS_Y = 280 * MiB;
constexpr size_t WS_AFF = 504 * MiB, WS_IDX = 505 * MiB, WS_GVR = 505 * MiB + 128 * 1024, WS_RMAP = 505 * MiB + 256 * 1024, WS_INV = 506 * MiB, WS_END = 507 * MiB;
constexpr int CW_BAR = 4096;
constexpr int RING_OFF = 0, RING_BYTES = 131072;
constexpr int LDSCTL_OFF = RING_BYTES, MISC_OFF = LDSCTL_OFF + 320, RMAP_OFF = LDSCTL_OFF + 1024;
constexpr int LDS_BYTES = 147456;

#define GAS __attribute__((address_space(1)))
#define LAS __attribute__((address_space(3)))
typedef unsigned short bf16;
typedef unsigned v4u __attribute__((ext_vector_type(4)));
typedef unsigned v2u __attribute__((ext_vector_type(2)));
typedef float f32x4 __attribute__((ext_vector_type(4)));
typedef float f32x2 __attribute__((ext_vector_type(2)));
typedef GAS unsigned gu32;
#define RLX_AGENT __ATOMIC_RELAXED, __HIP_MEMORY_SCOPE_AGENT
#define LDS_WAIT() asm volatile("s_waitcnt lgkmcnt(0)" ::: "memory")
#define VM_WAIT() asm volatile("s_waitcnt vmcnt(0)" ::: "memory")
__device__ __forceinline__ unsigned f2bf(float f) { unsigned u = __builtin_bit_cast(unsigned, f); return (u + 0x7fffu + ((u >> 16) & 1u)) >> 16; }
__device__ __forceinline__ unsigned pk2(float lo, float hi) { return f2bf(lo) | (f2bf(hi) << 16); }
__device__ __forceinline__ float bf_lo(unsigned w) { return __builtin_bit_cast(float, w << 16); }
__device__ __forceinline__ float bf_hi(unsigned w) { return __builtin_bit_cast(float, w & 0xffff0000u); }

__device__ __forceinline__ unsigned pk4_fp8(float a, float b, float c, float d) {
    int v = __builtin_amdgcn_cvt_pk_fp8_f32(a, b, 0, false); v = __builtin_amdgcn_cvt_pk_fp8_f32(c, d, v, true); return (unsigned)v; }
#define XB_TMO      128
#define XB_XCNT(j)  (256  + 64 * (j))
#define XB_XSUB(j)  (1280 + 64 * (j))
#define XB_XGEN(j)  (2304 + 64 * (j))
#define XB_TOP      3328
#define XB_TOPGEN   3392
#define XCD_BAR_WORDS 3456
#define XB_SPIN_CAP (1u << 18)
__device__ __forceinline__ unsigned xb_ld(unsigned* p)              { return __hip_atomic_load(p, __ATOMIC_RELAXED, __HIP_MEMORY_SCOPE_AGENT); }
__device__ __forceinline__ unsigned xb_add(unsigned* p, unsigned v) { return __hip_atomic_fetch_add(p, v, __ATOMIC_RELAXED, __HIP_MEMORY_SCOPE_AGENT); }
__device__ __forceinline__ unsigned xb_xcc_id() { return (unsigned)__builtin_amdgcn_s_getreg((3 << 11) | 20) & 0xFu; }
#define XB_SPIN(cond, bar) do { unsigned _sp = 0; while (cond) { __builtin_amdgcn_s_sleep(1); \
    if ((++_sp & 255u) == 0u) { if (xb_ld(&(bar)[XB_TMO])) break; if (_sp > XB_SPIN_CAP) { atomicAdd(&(bar)[XB_TMO], 1u); break; } } } } while (0)
struct XcdBarrier { unsigned* bar; unsigned x; volatile LAS unsigned* st; };
__device__ __forceinline__ XcdBarrier xcd_barrier_post(unsigned* bar, volatile LAS unsigned* st) {
    XcdBarrier b; b.bar = bar; b.x = xb_xcc_id(); b.st = st;
    if (threadIdx.x == 0) (void)xb_add(&bar[XB_XCNT(b.x)], 1u);
    return b;
}
__device__ __forceinline__ void xcd_barrier_complete(unsigned* bar, unsigned x, unsigned& nloc, unsigned& nx, volatile LAS unsigned* bst) {
    const unsigned G = bst[2];
    unsigned sum, cnt, mine, sp = 0u;
    for (;;) {
        sum = 0u; cnt = 0u; mine = 0u;
#pragma unroll
        for (unsigned j = 0; j < 16; ++j) { const unsigned c = xb_ld(&bar[XB_XCNT(j)]); sum += c; cnt += (c > 0u) ? 1u : 0u; mine = (j == x) ? c : mine; }
        if (sum == G) break;
        __builtin_amdgcn_s_sleep(1);
        if ((++sp & 255u) == 0u) { if (xb_ld(&bar[XB_TMO])) break; if (sp > XB_SPIN_CAP) { atomicAdd(&bar[XB_TMO], 1u); break; } }
    }
    nloc = mine > 0u ? mine : 1u; nx = cnt > 0u ? cnt : 1u;
}
__device__ __forceinline__ void xcd_barrier(const XcdBarrier& b) {
    asm volatile("s_waitcnt vmcnt(0)" ::: "memory");
    __syncthreads();
    int tid0_ = threadIdx.x; asm volatile("" : "+v"(tid0_));
    if (tid0_ == 0) {
        unsigned* bar = b.bar;
        __builtin_amdgcn_s_waitcnt(0);
        unsigned nloc = b.st[0], nx = b.st[1];
        if (nloc == 0u) { xcd_barrier_complete(bar, b.x, nloc, nx, b.st); b.st[0] = nloc; b.st[1] = nx; }
        const unsigned old = xb_add(&bar[XB_XSUB(b.x)], 1u);
        const unsigned gen = old / nloc;
        if (old + 1u == (gen + 1u) * nloc) {
            __builtin_amdgcn_fence(__ATOMIC_RELEASE, "agent");
            asm volatile("s_waitcnt vmcnt(0)" ::: "memory");
            const unsigned og = xb_add(&bar[XB_TOP], 1u);
            const unsigned tg = og / nx;
            if (og + 1u == (tg + 1u) * nx) xb_add(&bar[XB_TOPGEN], 1u);
            else XB_SPIN(xb_ld(&bar[XB_TOPGEN]) == tg, bar);
            __builtin_amdgcn_fence(__ATOMIC_ACQUIRE, "agent");
            xb_add(&bar[XB_XGEN(b.x)], 1u);
            asm volatile("s_waitcnt vmcnt(0)" ::: "memory");
        } else {
            XB_SPIN(xb_ld(&bar[XB_XGEN(b.x)]) == gen, bar);
            __builtin_amdgcn_fence(__ATOMIC_ACQUIRE, "agent");
            asm volatile("s_waitcnt vmcnt(0)" ::: "memory");
        }
    }
    __syncthreads();
}

struct Frame {
    LAS unsigned char* lds;
    volatile LAS unsigned* MISC;
    int tid, lane, wave, vcu, G;
};
__device__ __forceinline__ float wave_sum(float v) {
#pragma unroll
    for (int o = 1; o < 64; o <<= 1) v += __shfl_xor(v, o);
    return v;
}
__device__ __forceinline__ float wave_max(float v) {
#pragma unroll
    for (int o = 1; o < 64; o <<= 1) v = fmaxf(v, __shfl_xor(v, o));
    return v;
}
__device__ __forceinline__ void transpose_item(const float* W, int N, int K, bf16* WT, int dst_row0, int k0, int n0, LAS float* scr, int lane) {
    float v[32];
#pragma unroll
    for (int i = 0; i < 32; ++i) { const int kk = 2 * i + (lane >> 5); v[i] = W[(size_t)(k0 + kk) * N + n0 + (lane & 31)]; }
#pragma unroll
    for (int i = 0; i < 32; ++i) { const int kk = 2 * i + (lane >> 5); scr[kk * 33 + (lane & 31)] = v[i]; }
    LDS_WAIT(); asm volatile("" ::: "memory");
    const int c = lane & 7;
#pragma unroll
    for (int j = 0; j < 4; ++j) { const int n = (lane >> 3) + 8 * j; const LAS float* s = scr + (8 * c) * 33 + n;
        v4u o; o.x = pk2(s[0 * 33], s[1 * 33]); o.y = pk2(s[2 * 33], s[3 * 33]); o.z = pk2(s[4 * 33], s[5 * 33]); o.w = pk2(s[6 * 33], s[7 * 33]);
        *(GAS v4u*)(WT + (size_t)(dst_row0 + n) * K + k0 + 8 * c) = o; }
    LDS_WAIT(); asm volatile("" ::: "memory");
}

__device__ __forceinline__ void transpose_item_fp8(const float* W, int N, int K, unsigned char* WT, int dst_row0, int k0, int n0, LAS float* scr, int lane) {
    float v[32];
#pragma unroll
    for (int i = 0; i < 32; ++i) { const int kk = 2 * i + (lane >> 5); v[i] = W[(size_t)(k0 + kk) * N + n0 + (lane & 31)]; }
#pragma unroll
    for (int i = 0; i < 32; ++i) { const int kk = 2 * i + (lane >> 5); scr[kk * 33 + (lane & 31)] = v[i] * WSCALE; }
    LDS_WAIT(); asm volatile("" ::: "memory");
    const int c = lane & 7;
#pragma unroll
    for (int j = 0; j < 4; ++j) { const int n = (lane >> 3) + 8 * j; const LAS float* s = scr + (8 * c) * 33 + n;
        v2u o; o.x = pk4_fp8(s[0 * 33], s[1 * 33], s[2 * 33], s[3 * 33]); o.y = pk4_fp8(s[4 * 33], s[5 * 33], s[6 * 33], s[7 * 33]);
        *(GAS v2u*)(WT + (size_t)(dst_row0 + n) * K + k0 + 8 * c) = o; }
    LDS_WAIT(); asm volatile("" ::: "memory");
}

struct Args { const float* in[18]; float* out; unsigned char* ws; int ph_lo, ph_hi; };

__global__ void __launch_bounds__(NWAVES * 64, 2) fwd_kernel(Args args) {
    extern __shared__ __attribute__((aligned(16))) unsigned char lds[];
    Frame F;
    F.lds = (LAS unsigned char*)lds;
    F.MISC = (volatile LAS unsigned*)(F.lds + MISC_OFF);
    F.tid = threadIdx.x; F.lane = F.tid & 63; F.wave = __builtin_amdgcn_readfirstlane(F.tid >> 6);
    F.G = gridDim.x; { const int bx = blockIdx.x; F.vcu = (F.G % 8 == 0) ? (bx % 8) * (F.G / 8) + bx / 8 : bx; }
#define PHASE_PTRS() const __attribute__((address_space(4))) unsigned long long* kap = (const __attribute__((address_space(4))) unsigned long long*)__builtin_amdgcn_kernarg_segment_ptr(); asm volatile("" : "+s"(kap)); \
    unsigned char* const ws = (unsigned char*)kap[19]; (void)ws
#define KIN(i) ((const float*)kap[i])
#define KOUT ((float*)kap[18])
#define P_MOD ((float*)(ws + WS_MOD))
#define P_WIN_T ((bf16*)(ws + WS_WIN))
#define P_WOUT_T ((bf16*)(ws + WS_WOUT))
#define P_WGU_T ((bf16*)(ws + WS_WGU))
#define P_WDN_T ((bf16*)(ws + WS_WDN))
#define P_HB ((bf16*)(ws + WS_H))
#define P_ZB ((bf16*)(ws + WS_Z))
#define P_OB ((bf16*)(ws + WS_O))
#define P_ACT ((unsigned char*)(ws + WS_ACT))
#define P_YB ((bf16*)(ws + WS_Y))
#define P_AFF ((float*)(ws + WS_AFF))
#define P_IDX ((int*)(ws + WS_IDX))
#define P_GVR ((float*)(ws + WS_GVR))
#define P_INV ((int*)(ws + WS_INV))
#define P_RMAP ((int*)(ws + WS_RMAP))
    gu32* ctl = (gu32*)(args.ws + WS_CTL);
    for (int u = F.tid; u < (LDS_BYTES - LDSCTL_OFF) / 4; u += NWAVES * 64) ((LAS unsigned*)(F.lds + LDSCTL_OFF))[u] = 0u;
    if (F.tid == 0) F.MISC[10] = (unsigned)F.G;
    __syncthreads();
    const int lo = args.ph_lo, hi = args.ph_hi;
    XcdBarrier bar; bar.bar = (unsigned*)(ctl + CW_BAR); bar.x = 0; bar.st = nullptr;
    if (hi - lo > 1) bar = xcd_barrier_post((unsigned*)(ctl + CW_BAR), F.MISC + 8);
#ifndef PH_MASK
#define PH_MASK 0xFFF
#endif
#define IN(k) (((PH_MASK >> (k)) & 1) && lo <= (k) && (k) < hi)
#define BOTH(k) (IN(k) && IN((k) + 1))
#define GRID_BAR() xcd_barrier(bar)
    const int gw = F.vcu * NWAVES + F.wave, NGW = F.G * NWAVES;

    if (IN(0)) {
        { PHASE_PTRS(); const float* cvec = KIN(1); const float* w_ada = KIN(2); const float* b_ada = KIN(3); float* MOD = P_MOD;
        for (int it = gw; it < 1536; it += NGW) {
            const int cg = it % 48, kc = it / 48, k0 = kc * 64, col0 = cg * 256 + F.lane * 4;
            float sc[4];
#pragma unroll
            for (int b = 0; b < 4; ++b) { const float v = cvec[b * DM + k0 + F.lane]; sc[b] = v / (1.f + __expf(-v)); }
            f32x4 acc[4];
#pragma unroll
            for (int b = 0; b < 4; ++b) acc[b] = (f32x4){0.f, 0.f, 0.f, 0.f};
#pragma unroll 8
            for (int kk = 0; kk < 64; ++kk) { const f32x4 w = *(const f32x4*)(w_ada + (size_t)(k0 + kk) * 12288 + col0);
#pragma unroll
                for (int b = 0; b < 4; ++b) { const float s = __builtin_bit_cast(float, __builtin_amdgcn_readlane(__builtin_bit_cast(int, sc[b]), kk)); acc[b] += w * s; } }
            if (kc == 0) { const f32x4 bb = *(const f32x4*)(b_ada + col0);
#pragma unroll
                for (int b = 0; b < 4; ++b) acc[b] += bb; }
#pragma unroll
            for (int b = 0; b < 4; ++b)
#pragma unroll
                for (int i = 0; i < 4; ++i) atomicAdd(MOD + b * 12288 + col0 + i, acc[b][i]);
        }
        }
        { PHASE_PTRS();
        LAS float* scr = (LAS float*)(F.lds + RING_OFF + F.wave * 16384);
        constexpr int I_IN = 32 * 96, I_OUT = 32 * 64, I_E = 16 * 64;
        constexpr int NITEMS = I_IN + I_OUT + 48 * I_E;
        for (int it = gw; it < NITEMS; it += NGW) {
            int r = it;
            if (r < I_IN) { const int kb = r / 96, nb = r % 96; transpose_item(KIN(5), DIN, DM, P_WIN_T, 32 * nb, 64 * kb, 32 * nb, scr, F.lane); continue; } r -= I_IN;
            if (r < I_OUT) { const int kb = r / 64, nb = r % 64; transpose_item(KIN(12), DM, DM, P_WOUT_T, 32 * nb, 64 * kb, 32 * nb, scr, F.lane); continue; } r -= I_OUT;
            const int mat = r / I_E, q = r % I_E, kb = q / 64, nb = q % 64, n0 = 32 * nb;
            const float* W; unsigned char* WT; int drow;
            unsigned char* const WGU_T = (unsigned char*)P_WGU_T; unsigned char* const WDN_T = (unsigned char*)P_WDN_T;
            if (mat < 16)      { W = KIN(15) + (size_t)mat * DM * DE;        WT = WGU_T + (size_t)mat * 4096 * DM;        drow = (n0 >> 7) * 256 + (n0 & 127); }
            else if (mat < 32) { W = KIN(16) + (size_t)(mat - 16) * DM * DE;   WT = WGU_T + (size_t)(mat - 16) * 4096 * DM; drow = (n0 >> 7) * 256 + 128 + (n0 & 127); }
            else               { W = KIN(17) + (size_t)(mat - 32) * DE * DM; WT = WDN_T + (size_t)(mat - 32) * DM * DE;   drow = n0; }
            transpose_item_fp8(W, 2048, 2048, WT, drow, 128 * kb, n0, scr, F.lane);
            transpose_item_fp8(W, 2048, 2048, WT, drow, 128 * kb + 64, n0, scr, F.lane);
        }
        }
        if (BOTH(0)) GRID_BAR();
    }

    if (IN(1)) {
        PHASE_PTRS(); const float* x = KIN(0); const float* g_norm1 = KIN(4); const float* MOD = P_MOD; bf16* HB = P_HB;
        for (int m = gw; m < M; m += NGW) {
            const int b = m >> 12; const float* modb = MOD + b * 12288;
            const GAS f32x4* xr = (const GAS f32x4*)(x + (size_t)m * DM) + F.lane;
            f32x4 v[8]; float s = 0.f;
#pragma unroll
            for (int j = 0; j < 8; ++j) { v[j] = xr[64 * j]; s += (v[j].x * v[j].x + v[j].y * v[j].y) + (v[j].z * v[j].z + v[j].w * v[j].w); }
            const float rstd = 1.0f / sqrtf(wave_sum(s) * (1.f / DM) + 1e-6f);
            GAS v2u* o8 = (GAS v2u*)(HB + (size_t)m * DM) + F.lane;
#pragma unroll
            for (int j = 0; j < 8; ++j) { const int c0 = 256 * j + 4 * F.lane;
                const f32x4 g = *(const f32x4*)(g_norm1 + c0), sh = *(const f32x4*)(modb + c0), scl = *(const f32x4*)(modb + 2048 + c0);
                const f32x4 h = v[j] * rstd * g * (scl + 1.0f) + sh;
                v2u w; w.x = pk2(h.x, h.y); w.y = pk2(h.z, h.w); o8[64 * j] = w; }
        }
        if (BOTH(1)) GRID_BAR();
    }

    if (IN(2)) {
        PHASE_PTRS(); bf16* HB = P_HB; bf16* WIN_T = P_WIN_T; bf16* ZB = P_ZB;
        pg8::Gemm g{HB, WIN_T, M, DIN, DM}; pg8::StaticOrder S; S.init(M, DIN, F.G, (int)blockIdx.x);
        pg8::EpiZ E{ZB, DIN};
        pg8::gemm_phase<pg8::EpiZ, pg8::StaticOrder, true, true>(F.lds + RING_OFF, g, S, E);
        if (BOTH(2)) GRID_BAR();
    }

    if (IN(3)) {
        PHASE_PTRS(); const float* qn_a = KIN(6); const float* kn_a = KIN(7); const float* qn_b = KIN(8); const float* kn_b = KIN(9); bf16* ZB = P_ZB;
        for (int m = gw; m < M; m += NGW) {
            const int s = m & (SEQ - 1);
            const int a = F.lane >> 5, half = (F.lane >> 4) & 1, i0 = 2 * (F.lane & 15);
            const float pp = (float)(a ? (s & 63) : (s >> 6));
            float s0, c0, s1, c1; att::sincos_rev(pp * att::rope_inv(i0), s0, c0); att::sincos_rev(pp * att::rope_inv(i0 + 1), s1, c1);
            if (half == 0) { s0 = -s0; s1 = -s1; }
            GAS unsigned* zrow = (GAS unsigned*)(ZB + (size_t)m * DIN) + F.lane;
#pragma unroll 4
            for (int hh = 0; hh < 20; ++hh) {
                const int col = (hh < 10) ? hh * 128 : (1536 + (hh - 10) * 128);
                const bool isA = hh < 10; const bool isK = (hh == 8 || hh == 9 || hh >= 18);
                const float* kw = isA ? (isK ? kn_a : qn_a) : (isK ? kn_b : qn_b);
                GAS unsigned* p = zrow + (col >> 1);
                const unsigned w = *p; const float x0 = bf_lo(w), x1 = bf_hi(w);
                const float ss = wave_sum(x0 * x0 + x1 * x1);
                const float rstd = 1.0f / sqrtf(ss * (1.f / 128.f) + 1e-6f);
                const f32x2 kv = *(const f32x2*)(kw + 2 * F.lane);
                float y0 = x0 * rstd * kv.x, y1 = x1 * rstd * kv.y;
                if (isA) { const float py0 = __shfl_xor(y0, 16), py1 = __shfl_xor(y1, 16); y0 = y0 * c0 + py0 * s0; y1 = y1 * c1 + py1 * s1; }
                *p = pk2(y0, y1);
            }
        }
        if (BOTH(3)) GRID_BAR();
    }

    if (IN(4)) {
        PHASE_PTRS(); const float* sink_b = KIN(10); const float* rel_bias = KIN(11); bf16* ZB = P_ZB; bf16* OB = P_OB;
        for (int i = 0; ; ++i) {
            const int w = i * F.G + (int)blockIdx.x; if (w >= 512) break;
            const int combo = w & 7, local = w >> 3, b = combo >> 1, kvh = combo & 1, g = local >> 4, qblk = local & 15, h = kvh * 4 + g;
            const int q0 = qblk * 256; const size_t rowq = (size_t)b * SEQ + q0;
            int ntA = SEQ / 64; asm volatile("" : "+s"(ntA));
            att::attn_unit<false>(ZB + rowq * DIN + h * 128, ZB + (size_t)b * SEQ * DIN + 1024 + kvh * 128, ZB + (size_t)b * SEQ * DIN + 1280 + kvh * 128,
                                  OB + rowq * DM + h * 128, ntA, 0, 0.f, nullptr, (char*)lds + RING_OFF);
        }
        for (int i = 0; ; ++i) {
            const int w = i * F.G + (int)blockIdx.x; if (w >= 512) break;
            const int combo = w & 7, local = w >> 3, b = combo >> 1, kvh = combo & 1, g = local >> 4, qblk = local & 15, h = kvh * 4 + g;
            const int q0 = qblk * 256; const size_t rowq = (size_t)b * SEQ + q0;
            const int ks = (q0 - 128 < 0) ? 0 : q0 - 128, ke = (q0 + 384 > SEQ) ? SEQ : q0 + 384;
            const size_t rowk = (size_t)b * SEQ + ks;
            att::attn_unit<true>(ZB + rowq * DIN + 1536 + h * 128, ZB + rowk * DIN + 2560 + kvh * 128, ZB + rowk * DIN + 2816 + kvh * 128,
                                 OB + rowq * DM + 1024 + h * 128, (ke - ks) / 64, ks - q0, sink_b[h], rel_bias + h, (char*)lds + RING_OFF);
        }
        __syncthreads();
        if (BOTH(4)) GRID_BAR();
    }

    if (IN(5)) {
        PHASE_PTRS(); const float* x = KIN(0); float* out = KOUT; const float* MOD = P_MOD; bf16* OB = P_OB; bf16* WOUT_T = P_WOUT_T;
        pg8::Gemm g{OB, WOUT_T, M, DM, DM}; pg8::StaticOrder S; S.init(M, DM, F.G, (int)blockIdx.x);
        pg8::EpiX1 E{x, out, MOD + 4096};
        pg8::gemm_phase<pg8::EpiX1, pg8::StaticOrder, true, true>(F.lds + RING_OFF, g, S, E);
        if (BOTH(5)) GRID_BAR();
    }

    if (IN(6)) {
        PHASE_PTRS(); const float* g_norm2 = KIN(13); const float* w_router = KIN(14); float* out = KOUT; const float* MOD = P_MOD; bf16* HB = P_HB; float* AFF = P_AFF;
        LAS f32x4* wr = (LAS f32x4*)(F.lds + RING_OFF);
        for (int gidx = F.tid; gidx < 8192; gidx += NWAVES * 64) { const int k = gidx >> 2, q = gidx & 3, j = k >> 8, ln = (k & 255) >> 2, i = k & 3;
            wr[((j * 4 + i) * 4 + q) * 64 + ln] = *(const f32x4*)(w_router + (size_t)gidx * 4); }
        __syncthreads();
        for (int m = gw; m < M; m += NGW) {
            const int b = m >> 12, s = m & (SEQ - 1); const float* modb = MOD + b * 12288;
            const GAS f32x4* xr = (const GAS f32x4*)(out + (size_t)m * DM) + F.lane;
            f32x4 v[8]; float sq = 0.f;
#pragma unroll
            for (int j = 0; j < 8; ++j) { v[j] = xr[64 * j]; sq += (v[j].x * v[j].x + v[j].y * v[j].y) + (v[j].z * v[j].z + v[j].w * v[j].w); }
            const float rstd = 1.0f / sqrtf(wave_sum(sq) * (1.f / DM) + 1e-6f);
            GAS unsigned* o4 = (GAS unsigned*)((unsigned char*)HB + (size_t)m * DM) + F.lane;
            float lg[16];
#pragma unroll
            for (int e = 0; e < 16; ++e) lg[e] = 0.f;
#pragma unroll
            for (int j = 0; j < 8; ++j) { const int c0 = 256 * j + 4 * F.lane;
                const f32x4 g = *(const f32x4*)(g_norm2 + c0), sh = *(const f32x4*)(modb + 6144 + c0), scl = *(const f32x4*)(modb + 8192 + c0);
                const f32x4 h = v[j] * rstd * g * (scl + 1.0f) + sh;
                o4[64 * j] = pk4_fp8(h.x, h.y, h.z, h.w);
#pragma unroll
                for (int i = 0; i < 4; ++i)
#pragma unroll
                    for (int q = 0; q < 4; ++q) { const f32x4 wv = wr[((j * 4 + i) * 4 + q) * 64 + F.lane];
                        lg[4 * q + 0] = fmaf(h[i], wv.x, lg[4 * q + 0]); lg[4 * q + 1] = fmaf(h[i], wv.y, lg[4 * q + 1]);
                        lg[4 * q + 2] = fmaf(h[i], wv.z, lg[4 * q + 2]); lg[4 * q + 3] = fmaf(h[i], wv.w, lg[4 * q + 3]); }
                asm volatile("" ::: "memory"); }
            float mx = -1e30f;
#pragma unroll
            for (int e = 0; e < 16; ++e) { lg[e] = wave_sum(lg[e]); mx = fmaxf(mx, lg[e]); }
            float den = 0.f, mine = 0.f;
#pragma unroll
            for (int e = 0; e < 16; ++e) { const float p = __expf(lg[e] - mx); den += p; if (e == (F.lane & 15)) mine = p; }
            if (F.lane < 16) AFF[((size_t)b * NE + F.lane) * SEQ + s] = mine / den;
        }
        __syncthreads();
        if (BOTH(6)) GRID_BAR();
    }

    if (IN(7)) {
        PHASE_PTRS(); const float* AFF = P_AFF; int* IDX = P_IDX; float* GVR = P_GVR; int* INV = P_INV; int* RMAP = P_RMAP;
        LAS unsigned* cnts = (LAS unsigned*)(F.lds + RING_OFF);
        for (int p = (int)blockIdx.x; p < NB * NE; p += F.G) {
            const int b = p >> 4, e = p & 15; const float* af = AFF + (size_t)p * SEQ;
            const int s0 = F.tid * 8;
            const f32x4 a0 = *(const f32x4*)(af + s0), a1 = *(const f32x4*)(af + s0 + 4);
            float av[8] = {a0.x, a0.y, a0.z, a0.w, a1.x, a1.y, a1.z, a1.w};
            unsigned key[8];
#pragma unroll
            for (int j = 0; j < 8; ++j) key[j] = __builtin_bit_cast(unsigned, av[j]);
            unsigned prefix = 0u;
            __syncthreads();
            for (int bit = 30; bit >= 0; --bit) {
                const unsigned cand = prefix | (1u << bit);
                unsigned c = 0;
#pragma unroll
                for (int j = 0; j < 8; ++j) c += (unsigned)__builtin_popcountll(__ballot(key[j] >= cand));
                if (F.lane == 0) cnts[(bit & 1) * 8 + F.wave] = c;
                __syncthreads();
                unsigned tot = 0;
#pragma unroll
                for (int w = 0; w < 8; ++w) tot += cnts[(bit & 1) * 8 + w];
                if (tot >= (unsigned)CAP) prefix = cand;
            }
            const unsigned T = prefix;
            unsigned cg = 0, ce = 0;
#pragma unroll
            for (int j = 0; j < 8; ++j) { cg += key[j] > T; ce += key[j] == T; }
            unsigned pk = cg | (ce << 16), inc = pk;
#pragma unroll
            for (int o = 1; o < 64; o <<= 1) { const unsigned t = __shfl_up(inc, o); if (F.lane >= o) inc += t; }
            __syncthreads();
            if (F.lane == 63) cnts[16 + F.wave] = inc;
            __syncthreads();
            unsigned base = 0, total = 0;
#pragma unroll
            for (int w = 0; w < 8; ++w) { const unsigned t = cnts[16 + w]; if (w < F.wave) base += t; total += t; }
            const unsigned excl = base + inc - pk;
            unsigned rg = excl & 0xffffu, re = excl >> 16;
            const unsigned need = (unsigned)CAP - (total & 0xffffu);
#pragma unroll
            for (int j = 0; j < 8; ++j) {
                const int s = s0 + j; int slot = -1;
                if (key[j] > T) { slot = (int)(rg + (re < need ? re : need)); ++rg; }
                else if (key[j] == T) { if (re < need) slot = (int)(rg + re); ++re; }
                INV[((size_t)b * SEQ + s) * NE + e] = slot;
                if (slot >= 0) { IDX[p * CAP + slot] = s; GVR[e * (NB * CAP) + b * CAP + slot] = av[j]; RMAP[e * (NB * CAP) + b * CAP + slot] = b * SEQ + s; }
            }
        }
        __syncthreads();
        if (BOTH(7)) GRID_BAR();
    }

    if (IN(8)) {
        PHASE_PTRS(); const unsigned char* H8 = (const unsigned char*)P_HB; const unsigned char* WGU_T = (const unsigned char*)P_WGU_T; unsigned char* ACT = (unsigned char*)P_ACT; const int* RMAP = P_RMAP;
        pg8::OrderGU S{F.G, (int)blockIdx.x};
        LAS int* rm = (LAS int*)(F.lds + RMAP_OFF);
        { pg8::Unit u; for (int i = (F.tid >> 8); i < 8; i += 2) { if (S.next(i, u)) rm[i * 256 + (F.tid & 255)] = RMAP[u.pm * 256 + (F.tid & 255)]; } }
        __syncthreads();
        pg8::Gemm g{(const pg8::bf16_t*)H8, (const pg8::bf16_t*)WGU_T, RE, 2 * DE, DM};
        pg8::EpiSwiGLU E{ACT};
        pg8::gemm_phase<pg8::EpiSwiGLU, pg8::OrderGU, true, true, true, true>(F.lds + RING_OFF, g, S, E, rm);
        if (BOTH(8)) GRID_BAR();
    }

    if (IN(9)) {
        PHASE_PTRS(); const unsigned char* ACT = (const unsigned char*)P_ACT; const unsigned char* WDN_T = (const unsigned char*)P_WDN_T; bf16* YB = P_YB; const float* GVR = P_GVR;
        pg8::Gemm g{(const pg8::bf16_t*)ACT, (const pg8::bf16_t*)WDN_T, RE, DM, DE}; pg8::OrderDN S{F.G, (int)blockIdx.x};
        pg8::EpiDown E{YB, GVR};
        pg8::gemm_phase<pg8::EpiDown, pg8::OrderDN, true, true, true, false>(F.lds + RING_OFF, g, S, E);
        if (BOTH(9)) GRID_BAR();
    }

    if (IN(10)) {
        PHASE_PTRS(); float* out = KOUT; const float* MOD = P_MOD; const bf16* YB = P_YB; const int* INV = P_INV;
        for (int t = gw; t < M; t += NGW) {
            const int b = t >> 12; const float* gt2 = MOD + b * 12288 + 10240;
            const int inv = INV[(size_t)t * NE + (F.lane & 15)];
            unsigned mask = (unsigned)(__ballot(inv >= 0) & 0xffffull);
            GAS f32x4* xr = (GAS f32x4*)(out + (size_t)t * DM) + F.lane;
            f32x4 v[8], acc[8];
#pragma unroll
            for (int j = 0; j < 8; ++j) { v[j] = xr[64 * j]; acc[j] = (f32x4){0.f, 0.f, 0.f, 0.f}; }
            while (mask) {
                const int e = __builtin_ctz(mask); mask &= mask - 1;
                const int slot = __builtin_amdgcn_readlane(inv, e);
                const GAS v2u* yr = (const GAS v2u*)(YB + ((size_t)e * (NB * CAP) + b * CAP + slot) * DM) + F.lane;
#pragma unroll
                for (int j = 0; j < 8; ++j) { const v2u w = yr[64 * j]; acc[j].x += bf_lo(w.x); acc[j].y += bf_hi(w.x); acc[j].z += bf_lo(w.y); acc[j].w += bf_hi(w.y); }
            }
#pragma unroll
            for (int j = 0; j < 8; ++j) { const f32x4 g = *(const f32x4*)(gt2 + 256 * j + 4 * F.lane); xr[64 * j] = v[j] + g * acc[j]; }
        }
    }
#undef IN
#undef BOTH
#undef GRID_BAR
}

extern "C" void kernel_launch(void* const* d_in, const int* in_sizes, int n_in, void* d_out, int out_size, void* d_ws, size_t ws_size, hipStream_t stream) {
    static int grid = 0;
    if (grid == 0) {
        if (n_in != 18 || in_sizes[0] != M * DM || out_size != M * DM || ws_size < WS_END) { fprintf(stderr, "kernel_launch: shape/workspace mismatch (n_in %d, in0 %d, out %d, ws %zu)\n", n_in, n_in > 0 ? in_sizes[0] : -1, out_size, ws_size); grid = -1; return; }
        int dev = 0, cus = 0, per_cu = 0;
        if (hipGetDevice(&dev) != hipSuccess || hipDeviceGetAttribute(&cus, hipDeviceAttributeMultiprocessorCount, dev) != hipSuccess) { grid = -1; return; }
        if (hipFuncSetAttribute((const void*)fwd_kernel, hipFuncAttributeMaxDynamicSharedMemorySize, LDS_BYTES) != hipSuccess) { fprintf(stderr, "kernel_launch: hipFuncSetAttribute failed\n"); grid = -1; return; }
        if (hipOccupancyMaxActiveBlocksPerMultiprocessor(&per_cu, (const void*)fwd_kernel, NWAVES * 64, LDS_BYTES) != hipSuccess || per_cu < 1)
            fprintf(stderr, "kernel_launch: note: occupancy query reports %d workgroups per CU\n", per_cu);
        (void)hipGetLastError();
        grid = cus;
    }
    if (grid < 0) return;
    if (hipMemsetAsync((char*)d_ws + WS_CTL, 0, CTL_ZERO_BYTES, stream) != hipSuccess) return;
    Args a{};
    for (int i = 0; i < 18; ++i) a.in[i] = (const float*)d_in[i];
    a.out = (float*)d_out; a.ws = (unsigned char*)d_ws;
#if MK_PER_PHASE
    for (int p = 0; p < N_PHASES; ++p) { a.ph_lo = p; a.ph_hi = p + 1; hipLaunchKernelGGL(fwd_kernel, dim3(grid), dim3(NWAVES * 64), LDS_BYTES, stream, a); }
#else
    a.ph_lo = 0; a.ph_hi = N_PHASES; hipLaunchKernelGGL(fwd_kernel, dim3(grid), dim3(NWAVES * 64), LDS_BYTES, stream, a);
#endif
    const hipError_t le = hipPeekAtLastError();
    if (le != hipSuccess) fprintf(stderr, "kernel_launch: launch failed: %s\n", hipGetErrorName(le));
}
```

```cpp
#include <hip/hip_runtime.h>
#include <hip/hip_bf16.h>
#include <cstdio>
#include <cstdint>

#ifndef MK_PER_PHASE
#define MK_PER_PHASE 0
#endif

namespace pg8 {
#define PG8_LAS __attribute__((address_space(3)))
typedef unsigned short bf16_t;
typedef short bf16x8 __attribute__((ext_vector_type(8)));
typedef float f32x4 __attribute__((ext_vector_type(4)));
typedef unsigned u32x4 __attribute__((ext_vector_type(4)));
constexpr int BM = 256, BK = 64, HALF = 128, HTB = HALF * BK * 2, STAGE_BYTES = 8 * HTB, NXCD = 8, WGM = 8;

__host__ __device__ __forceinline__ int lds_byte(int r, int c) { const int st = (r >> 4) * 2 + (c >> 5), rr = r & 15, cc = c & 31, ob = rr * 64 + cc * 2; return st * 1024 + (ob ^ (((ob >> 9) & 1) << 5)); }
__host__ __device__ __forceinline__ void stage_rc(int b, int& R, int& C) { const int st = b / 1024, sb = b % 1024, swz = sb ^ (((sb >> 9) & 1) << 5); R = (st >> 1) * 16 + swz / 64; C = (st & 1) * 32 + (swz % 64) / 2; }
__host__ __device__ __forceinline__ int perm32(int rho) { const int n = rho >> 4, i = rho & 15; return 8 * (i >> 2) + 4 * n + (i & 3); }

struct Unit { int pm, pn; };
struct Gemm { const bf16_t* A; const bf16_t* Bt; int M, N, K; };

struct StaticOrder {
    int nM, nN, nwg, G, c;
    __host__ __device__ void init(int M, int N, int G_, int c_) { nM = M / BM; nN = N / BM; nwg = nM * nN; G = G_; c = c_; }
    __host__ __device__ __forceinline__ bool next(int i, Unit& u) const {
        const long L = (long)i * G + c; if (L >= nwg) return false;
        int wgid = (int)L; { const int q = nwg / NXCD, r = nwg % NXCD, xcd = wgid % NXCD, off = wgid / NXCD; wgid = (xcd < r ? xcd * (q + 1) : r * (q + 1) + (xcd - r) * q) + off; }
        const int nig = WGM * nN, gid = wgid / nig, fm = gid * WGM, gsz = (nM - fm) < WGM ? (nM - fm) : WGM;
        u.pm = fm + ((wgid % nig) % gsz); u.pn = (wgid % nig) / gsz; return true;
    }
    __device__ __forceinline__ void a_ready(const Unit&) const {}
    __device__ __forceinline__ void done(const Unit&) const {}
};
struct OrderGU {
    int G, c;
    __device__ __forceinline__ bool next(int i, Unit& u) const { const int L = i * G + c; if (L >= 2048) return false; const int e = L >> 7, j = L & 127, x = j & 7, jj = j >> 3;
        u.pm = e * 8 + (x >> 2) * 4 + (jj >> 2); u.pn = e * 16 + (x & 3) * 4 + (jj & 3); return true; }
    __device__ __forceinline__ void a_ready(const Unit&) const {}
    __device__ __forceinline__ void done(const Unit&) const {}
};
struct OrderDN {
    int G, c;
    __device__ __forceinline__ bool next(int i, Unit& u) const { const int L = i * G + c; if (L >= 1024) return false; const int rnd = L >> 8, cc = L & 255, x = cc & 7, jj = cc >> 3;
        const int e = rnd * 4 + (x >> 1); u.pm = e * 8 + (x & 1) * 4 + (jj & 3); u.pn = e * 8 + (jj >> 2); return true; }
    __device__ __forceinline__ void a_ready(const Unit&) const {}
    __device__ __forceinline__ void done(const Unit&) const {}
};

__device__ __forceinline__ unsigned cvt_pk_bf16(float lo, float hi) { unsigned r; asm volatile("v_cvt_pk_bf16_f32 %0, %1, %2" : "=v"(r) : "v"(lo), "v"(hi)); return r; }

struct EpiQKV {
    static constexpr bool PERM = true, AFTER_DRAIN = false;
    static __device__ __forceinline__ int bperm(int R) { const int s = R & 127, wc = s >> 5, n = (s >> 4) & 1, i = s & 15; return (R & ~127) + 64 * (wc >> 1) + 32 * n + 16 * (wc & 1) + i; }
    bf16_t* Z; const float* qkw; PG8_LAS float* xch;
    __device__ __forceinline__ void operator()(const f32x4 (&acc)[2][2][4][2], const Unit& u, int wr, int wc, int fr, int fq) const {
        typedef unsigned u32x2 __attribute__((ext_vector_type(2)));
        const int pn = u.pn, row0 = u.pm * BM + wr * 64 + fr;
        const int hc = 64 * (wc >> 1) + 16 * (wc & 1) + 4 * fq;
        const int type = (pn == 5 || pn == 11) ? 0 : (pn < 5 ? 2 : 1);
        bf16_t* zc = Z + (size_t)pn * BM + hc;
        if (type == 0) {
#pragma unroll
            for (int ai = 0; ai < 2; ++ai)
#pragma unroll
                for (int m = 0; m < 4; ++m) { bf16_t* rowp = zc + (size_t)(row0 + ai * HALF + m * 16) * 3072;
#pragma unroll
                    for (int bj = 0; bj < 2; ++bj)
#pragma unroll
                        for (int n = 0; n < 2; ++n) { const f32x4 v = acc[ai][bj][m][n]; *(u32x2*)(rowp + bj * HALF + 32 * n) = (u32x2){cvt_pk_bf16(v[0], v[1]), cvt_pk_bf16(v[2], v[3])}; } }
            return;
        }
        PG8_LAS float* xw = xch + (size_t)(wr * 128 + fr) * 8 + wc;
#pragma unroll
        for (int ai = 0; ai < 2; ++ai)
#pragma unroll
            for (int m = 0; m < 4; ++m)
#pragma unroll
                for (int bj = 0; bj < 2; ++bj) { const f32x4 a0 = acc[ai][bj][m][0], a1 = acc[ai][bj][m][1];
                    float p = (a0[0] * a0[0] + a0[1] * a0[1]) + (a0[2] * a0[2] + a0[3] * a0[3]) + (a1[0] * a1[0] + a1[1] * a1[1]) + (a1[2] * a1[2] + a1[3] * a1[3]);
                    { auto r_ = __builtin_amdgcn_permlane16_swap(__float_as_uint(p), __float_as_uint(p), false, false); p = __uint_as_float(r_[0]) + __uint_as_float(r_[1]); }
                    { auto r_ = __builtin_amdgcn_permlane32_swap(__float_as_uint(p), __float_as_uint(p), false, false); p = __uint_as_float(r_[0]) + __uint_as_float(r_[1]); }
                    if (fq == 0) xw[(size_t)(ai * 64 + m * 16) * 8 + bj * 4] = p; }
        asm volatile("s_waitcnt lgkmcnt(0)" ::: "memory");
        __builtin_amdgcn_s_barrier();
        const float* wv = qkw + 128 * ((pn < 4) ? 0 : (pn == 4 ? 1 : (pn < 10 ? 2 : 3)));
        const f32x4 w1 = *(const f32x4*)(wv + hc), w2 = *(const f32x4*)(wv + hc + 32);
        float inv[4];
#pragma unroll
        for (int r = 0; r < 4; ++r) inv[r] = __builtin_amdgcn_exp2f((float)(16 * (wc & 1) + 4 * fq + r) * (-13.287712379549449f / 32.f));
        const PG8_LAS f32x4* xr = (const PG8_LAS f32x4*)(xch + (size_t)(wr * 128 + fr) * 8);
#pragma unroll
        for (int ai = 0; ai < 2; ++ai)
#pragma unroll
            for (int m = 0; m < 4; ++m) {
                const int row = row0 + ai * HALF + m * 16; bf16_t* rowp = zc + (size_t)row * 3072;
                float cs[4], sn[4];
                if (type == 2) { const int sp = row & 4095; const float pp = (float)((wc >> 1) ? (sp & 63) : (sp >> 6));
#pragma unroll
                    for (int r = 0; r < 4; ++r) { float rev = pp * inv[r] * 0.15915494309189535f; rev = rev - __builtin_rintf(rev); sn[r] = __builtin_amdgcn_sinf(rev); cs[r] = __builtin_amdgcn_cosf(rev); } }
#pragma unroll
                for (int bj = 0; bj < 2; ++bj) {
                    const f32x4 q = xr[(size_t)(ai * 64 + m * 16) * 2 + bj];
                    const float rstd = __builtin_amdgcn_rsqf(((q[0] + q[1]) + (q[2] + q[3])) * (1.f / 128.f) + 1e-6f);
                    f32x4 x1 = acc[ai][bj][m][0] * rstd * w1, x2 = acc[ai][bj][m][1] * rstd * w2;
                    if (type == 2) {
#pragma unroll
                        for (int r = 0; r < 4; ++r) { const float a = x1[r], b = x2[r]; x1[r] = a * cs[r] - b * sn[r]; x2[r] = b * cs[r] + a * sn[r]; } }
                    *(u32x2*)(rowp + bj * HALF) = (u32x2){cvt_pk_bf16(x1[0], x1[1]), cvt_pk_bf16(x1[2], x1[3])};
                    *(u32x2*)(rowp + bj * HALF + 32) = (u32x2){cvt_pk_bf16(x2[0], x2[1]), cvt_pk_bf16(x2[2], x2[3])};
                }
            }
    }
};
struct EpiX1 {
    static __device__ __forceinline__ int bperm(int R) { return (R & ~31) + perm32(R & 31); }
    static constexpr bool PERM = true, AFTER_DRAIN = false;
    const float* x; float* out; const float* gate;
    __device__ __forceinline__ void operator()(const f32x4 (&acc)[2][2][4][2], const Unit& u, int wr, int wc, int fr, int fq) const {
        const int row0 = u.pm * BM + wr * 64 + fr, col0 = u.pn * BM + wc * 32 + 8 * fq, b = u.pm >> 4;
        typedef __attribute__((address_space(1))) f32x4 gf4;
        f32x4 gv[2][2];
#pragma unroll
        for (int bj = 0; bj < 2; ++bj)
#pragma unroll
            for (int n = 0; n < 2; ++n) gv[bj][n] = *(const f32x4*)(gate + (size_t)b * 12288 + col0 + bj * HALF + 4 * n);
        asm volatile("s_waitcnt vmcnt(0)" ::: "memory");
#define X1_LOAD(V, ai, mp) do { _Pragma("unroll") for (int mm = 0; mm < 2; ++mm) _Pragma("unroll") for (int bj = 0; bj < 2; ++bj) _Pragma("unroll") for (int n = 0; n < 2; ++n) { \
            const gf4* p_ = (const gf4*)(x + (size_t)(row0 + (ai) * HALF + ((mp) * 2 + mm) * 16) * 2048 + col0 + bj * HALF + 4 * n); \
            asm volatile("global_load_dwordx4 %0, %1, off nt" : "=v"(V[mm][bj][n]) : "v"(p_) : "memory"); } } while (0)
#define X1_WAIT(N) do { asm volatile("s_waitcnt vmcnt(" #N ")" ::: "memory"); __builtin_amdgcn_sched_barrier(0); } while (0)
#define X1_STORE(V, ai, mp) do { _Pragma("unroll") for (int mm = 0; mm < 2; ++mm) _Pragma("unroll") for (int bj = 0; bj < 2; ++bj) _Pragma("unroll") for (int n = 0; n < 2; ++n) \
            *(f32x4*)(out + (size_t)(row0 + (ai) * HALF + ((mp) * 2 + mm) * 16) * 2048 + col0 + bj * HALF + 4 * n) = V[mm][bj][n] + gv[bj][n] * acc[ai][bj][(mp) * 2 + mm][n]; } while (0)
        f32x4 xa[2][2][2], xb[2][2][2];
        X1_LOAD(xa, 0, 0); X1_LOAD(xb, 0, 1);
        X1_WAIT(8);  X1_STORE(xa, 0, 0); X1_LOAD(xa, 1, 0);
        X1_WAIT(16); X1_STORE(xb, 0, 1); X1_LOAD(xb, 1, 1);
        X1_WAIT(16); X1_STORE(xa, 1, 0);
        X1_WAIT(8);  X1_STORE(xb, 1, 1);
#undef X1_LOAD
#undef X1_WAIT
#undef X1_STORE
    }
};
struct EpiSwiGLU {
    static __device__ __forceinline__ int bperm(int R) { return (R & ~31) + perm32(R & 31); }
    static constexpr bool PERM = true, AFTER_DRAIN = false;
    unsigned char* O;
    __device__ __forceinline__ void operator()(const f32x4 (&acc)[2][2][4][2], const Unit& u, int wr, int wc, int fr, int fq) const {
        const int row0 = u.pm * BM + wr * 64 + fr, col0 = (u.pn & 15) * HALF + wc * 32 + 8 * fq;
#pragma unroll
        for (int ai = 0; ai < 2; ++ai)
#pragma unroll
            for (int m = 0; m < 4; ++m) { unsigned char* rowp = O + (size_t)(row0 + ai * HALF + m * 16) * 2048 + col0;
                float r[8];
#pragma unroll
                for (int n = 0; n < 2; ++n)
#pragma unroll
                    for (int i = 0; i < 4; ++i) { const float a = acc[ai][0][m][n][i] * (1.f / 256.f), uu = acc[ai][1][m][n][i] * (1.f / 256.f);
                        const float sg = __builtin_amdgcn_rcpf(1.f + __builtin_amdgcn_exp2f(-1.4426950408889634f * a));
                        r[n * 4 + i] = __builtin_fminf(__builtin_fmaxf(a * sg * uu, -448.f), 448.f); }
                int lo = __builtin_amdgcn_cvt_pk_fp8_f32(r[0], r[1], 0, false); lo = __builtin_amdgcn_cvt_pk_fp8_f32(r[2], r[3], lo, true);
                int hi = __builtin_amdgcn_cvt_pk_fp8_f32(r[4], r[5], 0, false); hi = __builtin_amdgcn_cvt_pk_fp8_f32(r[6], r[7], hi, true);
                typedef unsigned u32x2 __attribute__((ext_vector_type(2)));
                *(u32x2*)rowp = (u32x2){(unsigned)lo, (unsigned)hi}; }
    }
};
struct EpiDown {
    static __device__ __forceinline__ int bperm(int R) { return (R & ~31) + perm32(R & 31); }
    static constexpr bool PERM = true, AFTER_DRAIN = false;
    bf16_t* O; const float* gvr;
    __device__ __forceinline__ void operator()(const f32x4 (&acc)[2][2][4][2], const Unit& u, int wr, int wc, int fr, int fq) const {
        const int row0 = u.pm * BM + wr * 64 + fr, col0 = (u.pn & 7) * BM + wc * 32 + 8 * fq;
#pragma unroll
        for (int ai = 0; ai < 2; ++ai)
#pragma unroll
            for (int m = 0; m < 4; ++m) { const int row = row0 + ai * HALF + m * 16; const float g = (1.f / 256.f); bf16_t* rowp = O + (size_t)row * 2048 + col0;
#pragma unroll
                for (int bj = 0; bj < 2; ++bj) { const f32x4 v0 = acc[ai][bj][m][0] * g, v1 = acc[ai][bj][m][1] * g;
                    u32x4 w; w.x = cvt_pk_bf16(v0[0], v0[1]); w.y = cvt_pk_bf16(v0[2], v0[3]); w.z = cvt_pk_bf16(v1[0], v1[1]); w.w = cvt_pk_bf16(v1[2], v1[3]);
                    *(u32x4*)(rowp + bj * HALF) = w; } }
    }
};

typedef int v4i_t __attribute__((ext_vector_type(4)));
typedef int v8i_t __attribute__((ext_vector_type(8)));
template <class Epi, class Sched, bool ALIGN_EPI = false, bool SP2 = false, bool FP8 = false, bool GATHER = false>
__device__ __forceinline__ void gemm_phase(PG8_LAS unsigned char* lds, const Gemm g, const Sched& S, const Epi& E, const PG8_LAS int* rowmap = nullptr) {
    int tid_ = threadIdx.x; asm volatile("" : "+v"(tid_));
    const int tid = tid_ & 511, wid = __builtin_amdgcn_readfirstlane(tid >> 6), lane = tid & 63, wr = wid >> 2, wc = wid & 3, fr = lane & 15, fq = lane >> 4;
    constexpr int ES = FP8 ? 1 : 2, BKE = FP8 ? 128 : 64;
    const int K = g.K, nt = K / BKE;
    const unsigned Kb = (unsigned)K * ES;
    unsigned voffB[2];
#pragma unroll
    for (int i = 0; i < 2; ++i) { int R, C; stage_rc(tid * 16 + i * 8192, R, C); const int Rb = Epi::bperm(R);
        voffB[i] = (unsigned)Rb * Kb + (unsigned)C * 2u; }
    const size_t kstep = (size_t)128;
    const size_t hstep = (size_t)HALF * Kb;
    const size_t tstep = 2 * hstep;
    const unsigned ldsw = (unsigned)wid * 1024u;
    const int aoff = lds_byte(wr * 64 + fr, fq * 8), boff = lds_byte(wc * 32 + fr, fq * 8);
#define PG8_SA(b, h) (((b) * 2 + (h)) * HTB)
#define PG8_SB(b, h) ((4 + (b) * 2 + (h)) * HTB)
#define PG8_STAGE(bufoff, gbase, voff) do { _Pragma("unroll") for (int _i = 0; _i < 2; ++_i) \
        __builtin_amdgcn_global_load_lds((const unsigned*)((const char*)(gbase) + (voff)[_i]), (PG8_LAS unsigned*)(lds + (bufoff) + ldsw + _i * 8192), 16, 0, 0); } while (0)
#define PG8_LDA(dst, b, h) do { _Pragma("unroll") for (int m = 0; m < 4; ++m) _Pragma("unroll") for (int k = 0; k < 2; ++k) dst[m][k] = *(const PG8_LAS bf16x8*)(lds + PG8_SA(b, h) + aoff + m * 2048 + k * 1024); } while (0)
#define PG8_LDB(dst, b, h) do { _Pragma("unroll") for (int n = 0; n < 2; ++n) _Pragma("unroll") for (int k = 0; k < 2; ++k) dst[n][k] = *(const PG8_LAS bf16x8*)(lds + PG8_SB(b, h) + boff + n * 2048 + k * 1024); } while (0)
#define PG8_CAT(X) __builtin_shufflevector(__builtin_bit_cast(v4i_t, X[0]), __builtin_bit_cast(v4i_t, X[1]), 0, 1, 2, 3, 4, 5, 6, 7)
#define PG8_MMA(ai, bj, At, Bt) do { __builtin_amdgcn_s_setprio(1); _Pragma("unroll") for (int m = 0; m < 4; ++m) _Pragma("unroll") for (int n = 0; n < 2; ++n) { \
        if constexpr (FP8) acc[ai][bj][m][n] = __builtin_amdgcn_mfma_scale_f32_16x16x128_f8f6f4(PG8_CAT(Bt[n]), PG8_CAT(At[m]), acc[ai][bj][m][n], 0, 0, 0, 0x7F7F7F7F, 0, 0x7F7F7F7F); \
        else { _Pragma("unroll") for (int k = 0; k < 2; ++k) acc[ai][bj][m][n] = __builtin_amdgcn_mfma_f32_16x16x32_bf16(Bt[n][k], At[m][k], acc[ai][bj][m][n], 0, 0, 0); } } \
        __builtin_amdgcn_s_setprio(0); } while (0)
#define PG8_WAIT_V(n) asm volatile("s_waitcnt vmcnt(" #n ")" ::: "memory")
#define PG8_WAIT_L(n) asm volatile("s_waitcnt lgkmcnt(" #n ")" ::: "memory")
#define PG8_BAR __builtin_amdgcn_s_barrier()
#define PG8_SCHED __builtin_amdgcn_sched_barrier(0)
#define PG8_AOFFS(dst, unit, uidx) do { _Pragma("unroll") for (int i = 0; i < 2; ++i) { int R_, C_; stage_rc(tid * 16 + i * 8192, R_, C_); _Pragma("unroll") for (int h = 0; h < 2; ++h) { \
        unsigned row; if constexpr (GATHER) row = (unsigned)rowmap[(uidx) * 256 + h * HALF + R_]; else row = (unsigned)((unit).pm * BM + h * HALF + R_); \
        dst[h][i] = row * Kb + (unsigned)C_ * 2u; } } } while (0)
    Unit cur, nxt; int ui = 0;
    if (!S.next(0, cur)) return;
    f32x4 acc[2][2][4][2];
#pragma unroll
    for (int a = 0; a < 2; ++a)
#pragma unroll
        for (int b = 0; b < 2; ++b)
#pragma unroll
            for (int m = 0; m < 4; ++m)
#pragma unroll
                for (int n = 0; n < 2; ++n) acc[a][b][m][n] = (f32x4){0.f, 0.f, 0.f, 0.f};
    bf16x8 At[4][2], B0[2][2], B1[2][2];
    unsigned vA[2][2];
    PG8_AOFFS(vA, cur, 0);
    const char* const gA = (const char*)g.A;
    const char* cB = (const char*)g.Bt + (size_t)cur.pn * tstep;
    S.a_ready(cur);
    if constexpr (SP2) {
        PG8_STAGE(PG8_SB(0, 0), cB, voffB); PG8_STAGE(PG8_SB(0, 1), cB + hstep, voffB); PG8_STAGE(PG8_SA(0, 0), gA, vA[0]); PG8_STAGE(PG8_SA(0, 1), gA, vA[1]);
        if (wr == 1) PG8_BAR;
        PG8_WAIT_V(2); PG8_BAR;
        PG8_STAGE(PG8_SB(1, 0), cB + kstep, voffB); PG8_STAGE(PG8_SA(1, 0), gA + kstep, vA[0]); PG8_STAGE(PG8_SB(1, 1), cB + hstep + kstep, voffB);
        PG8_WAIT_V(6); PG8_BAR;
    } else {
        PG8_STAGE(PG8_SB(0, 0), cB, voffB); PG8_STAGE(PG8_SA(0, 0), gA, vA[0]); PG8_STAGE(PG8_SB(0, 1), cB + hstep, voffB); PG8_STAGE(PG8_SA(0, 1), gA, vA[1]);
        if (wr == 1) PG8_BAR;
        PG8_WAIT_V(4); PG8_BAR;
        PG8_STAGE(PG8_SB(1, 0), cB + kstep, voffB); PG8_STAGE(PG8_SA(1, 0), gA + kstep, vA[0]); PG8_STAGE(PG8_SB(1, 1), cB + hstep + kstep, voffB);
        PG8_WAIT_V(6); PG8_BAR;
    }
    for (;;) {
        const bool has_next = S.next(ui + 1, nxt);
        const char* nB = has_next ? (const char*)g.Bt + (size_t)nxt.pn * tstep : cB;
        for (int t = 0; t < nt; t += 2) {
            const bool last = (t == nt - 2);
            const char* a1 = gA + (size_t)(t + 1) * kstep;
            const char* a2 = last ? gA : gA + (size_t)(t + 2) * kstep; const char* b2 = last ? nB : cB + (size_t)(t + 2) * kstep;
            const char* a3 = a2 + kstep; const char* b3 = b2 + kstep;
            if (last && has_next) S.a_ready(nxt);
            if constexpr (SP2) {
            PG8_LDB(B0, 0, 0); PG8_LDB(B1, 0, 1); PG8_SCHED; PG8_LDA(At, 0, 0); PG8_STAGE(PG8_SA(1, 1), a1, vA[1]);
            if (last && has_next) { PG8_AOFFS(vA, nxt, ui + 1); }
            PG8_WAIT_V(8); PG8_WAIT_L(0); PG8_BAR; PG8_MMA(0, 0, At, B0); PG8_MMA(0, 1, At, B1); PG8_BAR; PG8_SCHED;
            PG8_LDA(At, 0, 1); PG8_STAGE(PG8_SB(0, 0), b2, voffB); PG8_STAGE(PG8_SB(0, 1), b2 + hstep, voffB); PG8_STAGE(PG8_SA(0, 0), a2, vA[0]);
            PG8_WAIT_V(8); PG8_WAIT_L(0); PG8_BAR; PG8_MMA(1, 0, At, B0); PG8_MMA(1, 1, At, B1); PG8_BAR; PG8_SCHED;
            PG8_LDB(B0, 1, 0); PG8_LDB(B1, 1, 1); PG8_SCHED; PG8_LDA(At, 1, 0); PG8_STAGE(PG8_SA(0, 1), a2, vA[1]);
            PG8_WAIT_V(8); PG8_WAIT_L(0); PG8_BAR; PG8_MMA(0, 0, At, B0); PG8_MMA(0, 1, At, B1); PG8_BAR; PG8_SCHED;
            PG8_LDA(At, 1, 1); PG8_STAGE(PG8_SB(1, 0), b3, voffB); PG8_STAGE(PG8_SB(1, 1), b3 + hstep, voffB); PG8_STAGE(PG8_SA(1, 0), a3, vA[0]);
            PG8_WAIT_V(8); PG8_WAIT_L(0); PG8_BAR; PG8_MMA(1, 0, At, B0); PG8_MMA(1, 1, At, B1); PG8_BAR; PG8_SCHED;
            } else {
            PG8_LDB(B0, 0, 0); PG8_SCHED; PG8_LDA(At, 0, 0); PG8_STAGE(PG8_SA(1, 1), a1, vA[1]);
            if (last && has_next) { PG8_AOFFS(vA, nxt, ui + 1); }
            PG8_WAIT_L(8); PG8_BAR; PG8_WAIT_L(0); PG8_MMA(0, 0, At, B0); PG8_BAR; PG8_SCHED;
            PG8_LDB(B1, 0, 1); PG8_STAGE(PG8_SB(0, 0), b2, voffB);
            PG8_BAR; PG8_WAIT_L(0); PG8_MMA(0, 1, At, B1); PG8_BAR;
            PG8_LDA(At, 0, 1); PG8_STAGE(PG8_SA(0, 0), a2, vA[0]);
            PG8_BAR; PG8_WAIT_L(0); PG8_MMA(1, 0, At, B0); PG8_BAR; PG8_SCHED;
            PG8_STAGE(PG8_SB(0, 1), b2 + hstep, voffB);
            PG8_WAIT_V(6); PG8_BAR; PG8_MMA(1, 1, At, B1); PG8_BAR;
            PG8_LDB(B0, 1, 0); PG8_SCHED; PG8_LDA(At, 1, 0); PG8_STAGE(PG8_SA(0, 1), a2, vA[1]);
            PG8_WAIT_L(8); PG8_BAR; PG8_WAIT_L(0); PG8_MMA(0, 0, At, B0); PG8_BAR; PG8_SCHED;
            PG8_LDB(B1, 1, 1); PG8_STAGE(PG8_SB(1, 0), b3, voffB);
            PG8_BAR; PG8_WAIT_L(0); PG8_MMA(0, 1, At, B1); PG8_BAR;
            PG8_LDA(At, 1, 1); PG8_STAGE(PG8_SA(1, 0), a3, vA[0]);
            PG8_BAR; PG8_WAIT_L(0); PG8_MMA(1, 0, At, B0); PG8_BAR; PG8_SCHED;
            PG8_STAGE(PG8_SB(1, 1), b3 + hstep, voffB);
            PG8_WAIT_V(6); PG8_BAR; PG8_MMA(1, 1, At, B1); PG8_BAR;
            }
        }
        if constexpr (ALIGN_EPI) { if (wr == 0) PG8_BAR; }
        if constexpr (!Epi::AFTER_DRAIN) { E(acc, cur, wr, wc, fr, fq); S.done(cur); }
        if (!has_next) break;
#pragma unroll
        for (int a = 0; a < 2; ++a)
#pragma unroll
            for (int b = 0; b < 2; ++b)
#pragma unroll
                for (int m = 0; m < 4; ++m)
#pragma unroll
                    for (int n = 0; n < 2; ++n) acc[a][b][m][n] = (f32x4){0.f, 0.f, 0.f, 0.f};
        cur = nxt; cB = nB; ++ui;
        if constexpr (ALIGN_EPI) { if (wr == 1) PG8_BAR; }
    }
    PG8_WAIT_V(0);
    if constexpr (!ALIGN_EPI) { if (wr == 0) PG8_BAR; }
    PG8_BAR;
#undef PG8_SA
#undef PG8_SB
#undef PG8_STAGE
#undef PG8_LDA
#undef PG8_LDB
#undef PG8_CAT
#undef PG8_MMA
#undef PG8_WAIT_V
#undef PG8_WAIT_L
#undef PG8_BAR
#undef PG8_SCHED
#undef PG8_AOFFS
}
}

namespace att {
using bf16 = unsigned short;
using bf16x8 = __attribute__((ext_vector_type(8))) short;
using s16x4  = __attribute__((ext_vector_type(4))) short;
using f32x16 = __attribute__((ext_vector_type(16))) float;
using u32x4  = __attribute__((ext_vector_type(4))) unsigned;
constexpr int D = 128, NW = 8, QBLK = 32, KVBLK = 64;
constexpr float SCALE = 0.088388347648318440f;
constexpr float THR = 8.f;
#ifndef ATT_SDEPTH
#define ATT_SDEPTH 2
#endif
constexpr int SDEPTH = ATT_SDEPTH;
constexpr int LDZ = 3072, LDO = 2048;
constexpr int SHM_V = KVBLK * D * 2, SHM_K = KVBLK * D * 2;
constexpr int OFF_WS = 2 * SHM_V + 2 * SHM_K, OFF_TAB = OFF_WS + NW * 64 * 4, SHM_ATTN = OFF_TAB + 768 * 4;
constexpr float MASKV = -1e37f;
#define KSWZ(row, colB) ((row) * 256 + ((colB) ^ (((row) & 7) << 4)))
#define SBAR() __builtin_amdgcn_sched_barrier(0)
__device__ __forceinline__ int crow(int r, int hi) { return (r & 3) + 8 * (r >> 2) + 4 * hi; }
__device__ __forceinline__ unsigned cvtpk(float lo, float hi) { unsigned r; asm volatile("v_cvt_pk_bf16_f32 %0, %1, %2" : "=v"(r) : "v"(lo), "v"(hi)); return r; }
__device__ __forceinline__ float bf2f(unsigned short h) { return __builtin_bit_cast(float, (unsigned)h << 16); }

__device__ __forceinline__ void partialSM(f32x16& p0, f32x16& p1, float& m_reg, float& mn, float& alpha) {
  constexpr float C = SCALE * 1.4426950408889634f;
  float pmax = p0[0];
#pragma unroll
  for (int r = 1; r < 16; ++r) pmax = fmaxf(pmax, p0[r]);
#pragma unroll
  for (int r = 0; r < 16; ++r) pmax = fmaxf(pmax, p1[r]);
  { auto rr = __builtin_amdgcn_permlane32_swap(__float_as_uint(pmax), __float_as_uint(pmax), false, false);
    pmax = fmaxf(__uint_as_float(rr[0]), __uint_as_float(rr[1])); }
  if (__builtin_expect(__all(pmax - m_reg <= THR / SCALE), 1)) { mn = m_reg; alpha = 1.f; }
  else { mn = fmaxf(m_reg, pmax); alpha = __builtin_amdgcn_exp2f((m_reg - mn) * C); m_reg = mn; }
  float mnC = -mn * C;
#pragma unroll
  for (int r = 0; r < 16; ++r) p0[r] = fmaf(p0[r], C, mnC);
#pragma unroll
  for (int r = 0; r < 16; ++r) p1[r] = fmaf(p1[r], C, mnC);
#pragma unroll
  for (int r = 0; r < 16; ++r) p0[r] = __builtin_amdgcn_exp2f(p0[r]);
}
__device__ __forceinline__ void finishSM(f32x16& p0, f32x16& p1, float alpha, float& l_reg, bf16x8& pa0, bf16x8& pa1, bf16x8& pa2, bf16x8& pa3) {
#pragma unroll
  for (int r = 0; r < 16; ++r) p1[r] = __builtin_amdgcn_exp2f(p1[r]);
  float ps = 0;
#pragma unroll
  for (int r = 0; r < 16; ++r) ps += p0[r];
#pragma unroll
  for (int r = 0; r < 16; ++r) ps += p1[r];
  { auto rr = __builtin_amdgcn_permlane32_swap(__float_as_uint(ps), __float_as_uint(ps), false, false);
    ps = __uint_as_float(rr[0]) + __uint_as_float(rr[1]); }
  l_reg = l_reg * alpha + ps;
#define PK4(P, BASE, OUT) do { unsigned a0 = cvtpk(P[BASE + 0], P[BASE + 1]), a1 = cvtpk(P[BASE + 2], P[BASE + 3]);   \
    unsigned b0 = cvtpk(P[BASE + 4], P[BASE + 5]), b1 = cvtpk(P[BASE + 6], P[BASE + 7]);                              \
    auto r0 = __builtin_amdgcn_permlane32_swap(a0, b0, false, false); auto r1 = __builtin_amdgcn_permlane32_swap(a1, b1, false, false); \
    u32x4 w = {r0[0], r1[0], r0[1], r1[1]}; OUT = *reinterpret_cast<bf16x8*>(&w); } while (0)
  PK4(p0, 0, pa0); PK4(p0, 8, pa1); PK4(p1, 0, pa2); PK4(p1, 8, pa3);
#undef PK4
}
__device__ __forceinline__ void qkt(f32x16& p0, f32x16& p1, const char* Ks, const bf16x8* qr, int r32, int hi) {
  p0 = f32x16{}; p1 = f32x16{};
#pragma unroll
  for (int d0 = 0; d0 < 8; ++d0) { int cb = (d0 * 16 + hi * 8) * 2;
    bf16x8 b0 = *reinterpret_cast<const bf16x8*>(Ks + KSWZ(r32, cb));
    bf16x8 b1 = *reinterpret_cast<const bf16x8*>(Ks + KSWZ(32 + r32, cb));
    p0 = __builtin_amdgcn_mfma_f32_32x32x16_bf16(b0, qr[d0], p0, 0, 0, 0);
    p1 = __builtin_amdgcn_mfma_f32_32x32x16_bf16(b1, qr[d0], p1, 0, 0, 0); }
}
__device__ __forceinline__ int v_st(int k, int c) { const int kk = (k & ~0xC) | ((k & 4) << 1) | ((k & 8) >> 1); return ((kk >> 3) * 4 + (c >> 5)) * 512 + ((kk & 7) * 32 + (c & 31)) * 2; }
__device__ __forceinline__ int v_rd_base(int lane) { return ((lane & 3) << 3) | (((lane >> 2) & 3) << 6) | (((lane >> 4) & 1) << 5) | (((lane >> 5) & 1) << 8); }
constexpr int v_rd_off(int d0, int ks, int half) { return d0 * 512 + ks * 4096 + half * 2048; }
template <int OFF> __device__ __forceinline__ s16x4 tr_read(int vb) {
  s16x4 r; asm volatile("ds_read_b64_tr_b16 %0, %1 offset:%2" : "=&v"(r) : "v"(vb), "i"(OFF) : "memory"); return r;
}
template <int D0> __device__ __forceinline__ void pv_one(f32x16& od, int vb, bf16x8 pa0, bf16x8 pa1, bf16x8 pa2, bf16x8 pa3) {
  const s16x4 l0 = tr_read<v_rd_off(D0, 0, 0)>(vb), h0 = tr_read<v_rd_off(D0, 0, 1)>(vb), l1 = tr_read<v_rd_off(D0, 1, 0)>(vb), h1 = tr_read<v_rd_off(D0, 1, 1)>(vb);
  const s16x4 l2 = tr_read<v_rd_off(D0, 2, 0)>(vb), h2 = tr_read<v_rd_off(D0, 2, 1)>(vb), l3 = tr_read<v_rd_off(D0, 3, 0)>(vb), h3 = tr_read<v_rd_off(D0, 3, 1)>(vb);
  asm volatile("s_waitcnt lgkmcnt(0)" ::: "memory"); SBAR();
#define PK(L, H) (bf16x8){L[0], L[1], L[2], L[3], H[0], H[1], H[2], H[3]}
  od = __builtin_amdgcn_mfma_f32_32x32x16_bf16(pa0, PK(l0, h0), od, 0, 0, 0);
  od = __builtin_amdgcn_mfma_f32_32x32x16_bf16(pa1, PK(l1, h1), od, 0, 0, 0);
  od = __builtin_amdgcn_mfma_f32_32x32x16_bf16(pa2, PK(l2, h2), od, 0, 0, 0);
  od = __builtin_amdgcn_mfma_f32_32x32x16_bf16(pa3, PK(l3, h3), od, 0, 0, 0);
#undef PK
}
__device__ __forceinline__ void pv_d0(f32x16* o, int vb, bf16x8 pa0, bf16x8 pa1, bf16x8 pa2, bf16x8 pa3) {
  pv_one<0>(o[0], vb, pa0, pa1, pa2, pa3); pv_one<1>(o[1], vb, pa0, pa1, pa2, pa3); pv_one<2>(o[2], vb, pa0, pa1, pa2, pa3); pv_one<3>(o[3], vb, pa0, pa1, pa2, pa3);
}
__device__ __forceinline__ int t5_bucket(int rel) {
  const int n = rel < 0 ? -rel : rel;
  const int large = 8 + (n >= 12) + (n >= 16) + (n >= 23) + (n >= 32) + (n >= 46) + (n >= 64) + (n >= 91);
  return (rel > 0 ? 16 : 0) + (n < 8 ? n : large);
}
__device__ __forceinline__ float rope_inv(int i) { return __builtin_amdgcn_exp2f((float)i * (-13.287712379549449f / 32.f)); }
__device__ __forceinline__ void sincos_rev(float ang, float& s, float& c) {
  float rev = ang * 0.15915494309189535f; rev = rev - __builtin_rintf(rev);
  s = __builtin_amdgcn_sinf(rev); c = __builtin_amdgcn_cosf(rev);
}

template <bool WIN>
__device__ __forceinline__ void attn_unit(const bf16* __restrict__ Zq, const bf16* __restrict__ Kh, const bf16* __restrict__ Vh, bf16* __restrict__ Ob, int NT,
                                          int relk0, float sinkv, const float* __restrict__ relb, char* lds) {
  int tid_ = threadIdx.x; asm volatile("" : "+v"(tid_));
  const int tid = tid_ & 511, wid = tid >> 6, lane = tid & 63, r32 = lane & 31, hi = lane >> 5;
  char* V_lds = lds; char* K_lds = lds + 2 * SHM_V;
  float* ws = (float*)(lds + OFF_WS) + wid * 64; float* li_l = ws; float* al_l = ws + 32;
  float* tab = (float*)(lds + OFF_TAB);
  __syncthreads();
  if constexpr (WIN) {
    for (int i = tid; i < 768; i += 512) { const int rel = i - 384; const int n = rel < 0 ? -rel : rel;
      tab[i] = (n <= 128) ? relb[t5_bucket(rel) * 8] * (1.0f / SCALE) : MASKV; }
  }
  float m_reg = -1e30f, l_reg = 0; f32x16 o[4] = {}; bf16x8 qr[8];
  {
    const bf16* Qw = Zq + (long)(wid * QBLK + r32) * LDZ + hi * 8;
#pragma unroll
    for (int d0 = 0; d0 < 8; ++d0) qr[d0] = *reinterpret_cast<const bf16x8*>(Qw + d0 * 16);
  }
  const int sr = tid >> 4, sc = (tid & 15) * 8, vst0 = v_st(sr, sc), vst1 = v_st(32 + sr, sc);
  const int vb0 = (int)(uintptr_t)V_lds + v_rd_base(lane);
  struct { bf16x8 vs0, vs1, ks0, ks1; } sr_[SDEPTH];
#define LD8(p) (*reinterpret_cast<const bf16x8*>(p))
#define SLOAD(i, k0) do { sr_[i].vs0 = LD8(&Vh[(long)((k0) + sr) * LDZ + sc]); sr_[i].vs1 = LD8(&Vh[(long)((k0) + 32 + sr) * LDZ + sc]); \
    sr_[i].ks0 = LD8(&Kh[(long)((k0) + sr) * LDZ + sc]); sr_[i].ks1 = LD8(&Kh[(long)((k0) + 32 + sr) * LDZ + sc]); } while (0)
#define SWRITE(b, i) do { *(bf16x8*)(V_lds + (b) * SHM_V + vst0) = sr_[i].vs0;          \
    *(bf16x8*)(V_lds + (b) * SHM_V + vst1) = sr_[i].vs1; int kc = sc * 2;               \
    *(bf16x8*)(K_lds + (b) * SHM_K + KSWZ(sr, kc)) = sr_[i].ks0;                       \
    *(bf16x8*)(K_lds + (b) * SHM_K + KSWZ(32 + sr, kc)) = sr_[i].ks1; } while (0)
#define SWAIT() do { if constexpr (SDEPTH == 2) asm volatile("s_waitcnt vmcnt(4)" ::: "memory"); else asm volatile("s_waitcnt vmcnt(0)" ::: "memory"); } while (0)
#define RESC(a) do { if (__any((a) < 1.f)) { if (hi == 0) al_l[r32] = (a); asm volatile("s_waitcnt lgkmcnt(0)" ::: "memory"); \
    _Pragma("unroll") for (int d = 0; d < 4; ++d) _Pragma("unroll") for (int r = 0; r < 16; ++r) o[d][r] *= al_l[crow(r, hi)]; } } while (0)
#define BIAS(P0, P1, t) do { if constexpr (WIN) { const float* tp = tab + (384 + relk0 + 64 * (t) - (wid * QBLK + r32) + 4 * hi); \
    _Pragma("unroll") for (int r = 0; r < 16; ++r) { P0[r] += tp[(r & 3) + 8 * (r >> 2)]; P1[r] += tp[32 + (r & 3) + 8 * (r >> 2)]; } } } while (0)
  f32x16 pA0, pA1, pB0, pB1; float mnA, mnB, alA, alB; bf16x8 pa0, pa1, pa2, pa3;
  constexpr int SE = 0, SO = SDEPTH - 1;
  SLOAD(SE, 0); asm volatile("s_waitcnt vmcnt(0)" ::: "memory"); SWRITE(0, SE); __syncthreads();
  qkt(pA0, pA1, K_lds, qr, r32, hi); BIAS(pA0, pA1, 0); partialSM(pA0, pA1, m_reg, mnA, alA);
  SLOAD(SO, KVBLK); if constexpr (SDEPTH == 2) { if (2 < NT) SLOAD(SE, 2 * KVBLK); }
  SWAIT(); SWRITE(1, SO); __syncthreads();
  for (int j = 1; j + 1 < NT; j += 2) {
    SBAR(); qkt(pB0, pB1, K_lds + SHM_K, qr, r32, hi);
    finishSM(pA0, pA1, alA, l_reg, pa0, pa1, pa2, pa3); SBAR();
    SLOAD(SO, (j + SDEPTH) * KVBLK); SBAR();
    pv_d0(o, vb0, pa0, pa1, pa2, pa3); BIAS(pB0, pB1, j); partialSM(pB0, pB1, m_reg, mnB, alB);
    __syncthreads(); SWAIT(); SWRITE(0, SE);
    RESC(alB); __syncthreads();
    SBAR(); qkt(pA0, pA1, K_lds, qr, r32, hi);
    finishSM(pB0, pB1, alB, l_reg, pa0, pa1, pa2, pa3); SBAR();
    if (SDEPTH == 1 || j + 3 < NT) SLOAD(SE, (j + 1 + SDEPTH) * KVBLK); SBAR();
    pv_d0(o, vb0 + SHM_V, pa0, pa1, pa2, pa3); BIAS(pA0, pA1, j + 1); partialSM(pA0, pA1, m_reg, mnA, alA);
    __syncthreads(); SWAIT(); SWRITE(1, SO);
    RESC(alA); __syncthreads();
  }
  SBAR(); qkt(pB0, pB1, K_lds + SHM_K, qr, r32, hi);
  finishSM(pA0, pA1, alA, l_reg, pa0, pa1, pa2, pa3); SBAR();
  pv_d0(o, vb0, pa0, pa1, pa2, pa3); BIAS(pB0, pB1, NT - 1); partialSM(pB0, pB1, m_reg, mnB, alB);
  __syncthreads(); RESC(alB);
  finishSM(pB0, pB1, alB, l_reg, pa0, pa1, pa2, pa3); SBAR();
  pv_d0(o, vb0 + SHM_V, pa0, pa1, pa2, pa3);
  if constexpr (WIN) { constexpr float C = SCALE * 1.4426950408889634f; l_reg += __builtin_amdgcn_exp2f(fminf(sinkv * 1.4426950408889634f - m_reg * C, 120.f)); }
  if (hi == 0) li_l[r32] = l_reg; asm volatile("s_waitcnt lgkmcnt(0)" ::: "memory");
  float rli[16];
#pragma unroll
  for (int r = 0; r < 16; ++r) rli[r] = __builtin_amdgcn_rcpf(li_l[crow(r, hi)]);
  bf16* Ow = Ob + (long)(wid * QBLK) * LDO;
  const int odd = lane & 1;
#pragma unroll
  for (int r = 0; r < 16; r += 2) { const int orow = crow(r, hi) + odd;
#pragma unroll
    for (int d0 = 0; d0 < 4; ++d0) { const float v0 = o[d0][r] * rli[r], v1 = o[d0][r + 1] * rli[r + 1];
      const float snd = odd ? v0 : v1;
      const float rcv = __builtin_bit_cast(float, __builtin_amdgcn_update_dpp(0, __builtin_bit_cast(int, snd), 0xB1, 0xF, 0xF, true));
      const unsigned w = odd ? cvtpk(rcv, v1) : cvtpk(v0, rcv);
      *(unsigned*)(Ow + (long)orow * LDO + d0 * 32 + (r32 & ~1)) = w; } }
#undef LD8
#undef SLOAD
#undef SWRITE
#undef SWAIT
#undef RESC
#undef BIAS
}
#undef KSWZ
}

constexpr int NWAVES = 8;
constexpr int NB = 4, SEQ = 4096, DM = 2048, M = NB * SEQ, DIN = 3072, NE = 16, CAP = 512, DE = 2048, RE = NE * NB * CAP;
constexpr int N_PHASES = 10;
constexpr float WSCALE = 256.f, WSCALE_INV = 1.f / 256.f;
constexpr size_t MiB = 1u << 20;
constexpr size_t WS_CTL = 0, CTL_ZERO_BYTES = 64 * 1024;
constexpr size_t WS_MOD = 256 * 1024;
constexpr size_t WS_WIN = 2 * MiB, WS_WOUT = 14 * MiB;
constexpr size_t WS_WGU = 24 * MiB, WS_WDN = 152 * MiB;
constexpr size_t WS_H = 216 * MiB;
constexpr size_t WS_Z = 280 * MiB, WS_O = 376 * MiB;
constexpr size_t WS_ACT = 440 * MiB;
constexpr size_t WS_Y = 280 * MiB;
constexpr size_t WS_AFF = 504 * MiB, WS_IDX = 505 * MiB, WS_GVR = 505 * MiB + 128 * 1024, WS_RMAP = 505 * MiB + 256 * 1024, WS_INV = 506 * MiB, WS_PART = 507 * MiB, WS_QKW = 513 * MiB + 512 * 1024, WS_END = 514 * MiB;
constexpr int CW_BAR = 4096;
constexpr int CW_GEMV = 8192;
constexpr int RING_OFF = 0, RING_BYTES = 131072;
constexpr int LDSCTL_OFF = RING_BYTES, MISC_OFF = LDSCTL_OFF + 320, RMAP_OFF = LDSCTL_OFF + 1024;
constexpr int LDS_BYTES = 147456;

#define GAS __attribute__((address_space(1)))
#define LAS __attribute__((address_space(3)))
typedef unsigned short bf16;
typedef unsigned v4u __attribute__((ext_vector_type(4)));
typedef unsigned v2u __attribute__((ext_vector_type(2)));
typedef float f32x4 __attribute__((ext_vector_type(4)));
typedef float f32x2 __attribute__((ext_vector_type(2)));
typedef GAS unsigned gu32;
#define RLX_AGENT __ATOMIC_RELAXED, __HIP_MEMORY_SCOPE_AGENT
#define LDS_WAIT() asm volatile("s_waitcnt lgkmcnt(0)" ::: "memory")
#define VM_WAIT() asm volatile("s_waitcnt vmcnt(0)" ::: "memory")
__device__ __forceinline__ unsigned f2bf(float f) { unsigned u = __builtin_bit_cast(unsigned, f); return (u + 0x7fffu + ((u >> 16) & 1u)) >> 16; }
__device__ __forceinline__ unsigned pk2(float lo, float hi) { return f2bf(lo) | (f2bf(hi) << 16); }
__device__ __forceinline__ float bf_lo(unsigned w) { return __builtin_bit_cast(float, w << 16); }
__device__ __forceinline__ float bf_hi(unsigned w) { return __builtin_bit_cast(float, w & 0xffff0000u); }

__device__ __forceinline__ unsigned pk4_fp8(float a, float b, float c, float d) {
    int v = __builtin_amdgcn_cvt_pk_fp8_f32(a, b, 0, false); v = __builtin_amdgcn_cvt_pk_fp8_f32(c, d, v, true); return (unsigned)v; }
#define XB_TMO      128
#define XB_XCNT(j)  (256  + 64 * (j))
#define XB_XSUB(j)  (1280 + 64 * (j))
#define XB_XGEN(j)  (2304 + 64 * (j))
#define XB_TOP      3328
#define XB_TOPGEN   3392
#define XCD_BAR_WORDS 3456
#define XB_SPIN_CAP (1u << 18)
__device__ __forceinline__ unsigned xb_ld(unsigned* p)              { return __hip_atomic_load(p, __ATOMIC_RELAXED, __HIP_MEMORY_SCOPE_AGENT); }
__device__ __forceinline__ unsigned xb_add(unsigned* p, unsigned v) { return __hip_atomic_fetch_add(p, v, __ATOMIC_RELAXED, __HIP_MEMORY_SCOPE_AGENT); }
__device__ __forceinline__ unsigned xb_xcc_id() { return (unsigned)__builtin_amdgcn_s_getreg((3 << 11) | 20) & 0xFu; }
#define XB_SPIN(cond, bar) do { unsigned _sp = 0; while (cond) { __builtin_amdgcn_s_sleep(1); \
    if ((++_sp & 255u) == 0u) { if (xb_ld(&(bar)[XB_TMO])) break; if (_sp > XB_SPIN_CAP) { atomicAdd(&(bar)[XB_TMO], 1u); break; } } } } while (0)
struct XcdBarrier { unsigned* bar; unsigned x; volatile LAS unsigned* st; };
__device__ __forceinline__ XcdBarrier xcd_barrier_post(unsigned* bar, volatile LAS unsigned* st) {
    XcdBarrier b; b.bar = bar; b.x = xb_xcc_id(); b.st = st;
    if (threadIdx.x == 0) (void)xb_add(&bar[XB_XCNT(b.x)], 1u);
    return b;
}
__device__ __forceinline__ void xcd_barrier_complete(unsigned* bar, unsigned x, unsigned& nloc, unsigned& nx, volatile LAS unsigned* bst) {
    const unsigned G = bst[2];
    unsigned sum, cnt, mine, sp = 0u;
    for (;;) {
        sum = 0u; cnt = 0u; mine = 0u;
#pragma unroll
        for (unsigned j = 0; j < 16; ++j) { const unsigned c = xb_ld(&bar[XB_XCNT(j)]); sum += c; cnt += (c > 0u) ? 1u : 0u; mine = (j == x) ? c : mine; }
        if (sum == G) break;
        __builtin_amdgcn_s_sleep(1);
        if ((++sp & 255u) == 0u) { if (xb_ld(&bar[XB_TMO])) break; if (sp > XB_SPIN_CAP) { atomicAdd(&bar[XB_TMO], 1u); break; } }
    }
    nloc = mine > 0u ? mine : 1u; nx = cnt > 0u ? cnt : 1u;
}
__device__ __forceinline__ void xcd_barrier(const XcdBarrier& b) {
    asm volatile("s_waitcnt vmcnt(0)" ::: "memory");
    __syncthreads();
    int tid0_ = threadIdx.x; asm volatile("" : "+v"(tid0_));
    if (tid0_ == 0) {
        unsigned* bar = b.bar;
        __builtin_amdgcn_s_waitcnt(0);
        unsigned nloc = b.st[0], nx = b.st[1];
        if (nloc == 0u) { xcd_barrier_complete(bar, b.x, nloc, nx, b.st); b.st[0] = nloc; b.st[1] = nx; }
        const unsigned old = xb_add(&bar[XB_XSUB(b.x)], 1u);
        const unsigned gen = old / nloc;
        if (old + 1u == (gen + 1u) * nloc) {
            __builtin_amdgcn_fence(__ATOMIC_RELEASE, "agent");
            asm volatile("s_waitcnt vmcnt(0)" ::: "memory");
            const unsigned og = xb_add(&bar[XB_TOP], 1u);
            const unsigned tg = og / nx;
            if (og + 1u == (tg + 1u) * nx) xb_add(&bar[XB_TOPGEN], 1u);
            else XB_SPIN(xb_ld(&bar[XB_TOPGEN]) == tg, bar);
            __builtin_amdgcn_fence(__ATOMIC_ACQUIRE, "agent");
            xb_add(&bar[XB_XGEN(b.x)], 1u);
            asm volatile("s_waitcnt vmcnt(0)" ::: "memory");
        } else {
            XB_SPIN(xb_ld(&bar[XB_XGEN(b.x)]) == gen, bar);
            __builtin_amdgcn_fence(__ATOMIC_ACQUIRE, "agent");
            asm volatile("s_waitcnt vmcnt(0)" ::: "memory");
        }
    }
    __syncthreads();
}

struct Frame {
    LAS unsigned char* lds;
    volatile LAS unsigned* MISC;
    int tid, lane, wave, vcu, G;
};
__device__ __forceinline__ float wave_sum(float v) {
    v += __builtin_bit_cast(float, __builtin_amdgcn_update_dpp(0, __builtin_bit_cast(int, v), 0xB1, 0xF, 0xF, true));
    v += __builtin_bit_cast(float, __builtin_amdgcn_update_dpp(0, __builtin_bit_cast(int, v), 0x4E, 0xF, 0xF, true));
    v += __builtin_bit_cast(float, __builtin_amdgcn_update_dpp(0, __builtin_bit_cast(int, v), 0x141, 0xF, 0xF, true));
    v += __builtin_bit_cast(float, __builtin_amdgcn_update_dpp(0, __builtin_bit_cast(int, v), 0x140, 0xF, 0xF, true));
    { auto r = __builtin_amdgcn_permlane16_swap(__float_as_uint(v), __float_as_uint(v), false, false); v = __uint_as_float(r[0]) + __uint_as_float(r[1]); }
    { auto r = __builtin_amdgcn_permlane32_swap(__float_as_uint(v), __float_as_uint(v), false, false); v = __uint_as_float(r[0]) + __uint_as_float(r[1]); }
    return v;
}
__device__ __forceinline__ float wave_max(float v) {
#pragma unroll
    for (int o = 1; o < 64; o <<= 1) v = fmaxf(v, __shfl_xor(v, o));
    return v;
}
template <int MODE>
__device__ __forceinline__ void convert_weights(const float* __restrict__ wa, const float* __restrict__ wb, const float* __restrict__ wc, unsigned char* da, unsigned char* db,
                                                LAS float* scr, int gw, int NGW, int lane) {
    constexpr bool EXPERTS = (MODE == 2);
    constexpr int NBW = (MODE == 0) ? 96 : 64;
    constexpr int I_M = 16 * NBW;
    constexpr int NITEMS = EXPERTS ? 48 * I_M : I_M;
    constexpr int NN = (MODE == 0) ? 3072 : 2048;
    constexpr int ES = EXPERTS ? 1 : 2, KB = 2048 * ES;
    const int nitems = (gw < NITEMS) ? ((NITEMS - 1 - gw) / NGW + 1) : 0;
    const float* nsrc = nullptr; unsigned char* dst = nullptr; unsigned char* ndst = nullptr;
#define CVT_DECODE(itx, SRC, DST) do { const int r = gw + (itx) * NGW; \
        if constexpr (!EXPERTS) { const int kb = r / NBW, nb = r % NBW, k0 = 128 * kb, n0 = 32 * nb; SRC = wa + (size_t)k0 * NN + n0; DST = da + ((size_t)n0 * 2048 + k0) * 2; } \
        else { const int mat = r / I_M, q = r % I_M, kb = q / NBW, nb = q % NBW, n0 = 32 * nb, k0 = 128 * kb; \
            if (mat < 16)      { SRC = wa + (size_t)mat * 2048 * 2048 + (size_t)k0 * 2048 + n0;        DST = da + (size_t)mat * 4096 * 2048 + (size_t)((n0 >> 7) * 256 + (n0 & 127)) * 2048 + k0; } \
            else if (mat < 32) { SRC = wb + (size_t)(mat - 16) * 2048 * 2048 + (size_t)k0 * 2048 + n0; DST = da + (size_t)(mat - 16) * 4096 * 2048 + (size_t)((n0 >> 7) * 256 + 128 + (n0 & 127)) * 2048 + k0; } \
            else               { SRC = wc + (size_t)(mat - 32) * 2048 * 2048 + (size_t)k0 * 2048 + n0; DST = db + (size_t)(mat - 32) * 2048 * 2048 + (size_t)n0 * 2048 + k0; } } } while (0)
    const unsigned voff = (unsigned)((lane >> 3) * NN + 4 * (lane & 7)) * 4u;
#define CVT_LOAD(V, SRC, HF) do { _Pragma("unroll") for (int i = 0; i < 8; ++i) { const float* b_ = (SRC) + (size_t)((HF) * 64 + 8 * i) * NN; \
            asm volatile("s_nop 4\n\tglobal_load_dwordx4 %0, %1, %2 nt" : "=v"(V[i]) : "v"(voff), "s"(b_) : "memory"); } } while (0)
#define CVT_WAIT(V, N) asm volatile("s_waitcnt vmcnt(" #N ")" : "+v"(V[0]), "+v"(V[1]), "+v"(V[2]), "+v"(V[3]), "+v"(V[4]), "+v"(V[5]), "+v"(V[6]), "+v"(V[7]) :: "memory")
#define CVT_HALF(V, HF) do { CVT_WAIT(V, 16); \
        _Pragma("unroll") for (int i = 0; i < 8; ++i) { LAS float* w_ = scr + (8 * i + (lane >> 3)) * 33 + 4 * (lane & 7); const f32x4 t_ = V[i] * (EXPERTS ? WSCALE : 1.0f); \
            w_[0] = t_.x; w_[1] = t_.y; w_[2] = t_.z; w_[3] = t_.w; } \
        CVT_LOAD(V, nsrc, HF); \
        LDS_WAIT(); asm volatile("" ::: "memory"); \
        const int c = lane & 7; \
        _Pragma("unroll") for (int j = 0; j < 4; ++j) { const int n = (lane >> 3) + 8 * j; const LAS float* sp = scr + (8 * c) * 33 + n; \
            if constexpr (EXPERTS) { v2u o; o.x = pk4_fp8(sp[0 * 33], sp[1 * 33], sp[2 * 33], sp[3 * 33]); o.y = pk4_fp8(sp[4 * 33], sp[5 * 33], sp[6 * 33], sp[7 * 33]); \
                __builtin_nontemporal_store(o, (GAS v2u*)(dst + (size_t)n * KB + (HF) * 64 + 8 * c)); } \
            else { v4u o; o.x = pk2(sp[0 * 33], sp[1 * 33]); o.y = pk2(sp[2 * 33], sp[3 * 33]); o.z = pk2(sp[4 * 33], sp[5 * 33]); o.w = pk2(sp[6 * 33], sp[7 * 33]); \
                *(GAS v4u*)(dst + (size_t)n * KB + (HF) * 128 + 16 * c) = o; } } \
        LDS_WAIT(); asm volatile("" ::: "memory"); } while (0)
    f32x4 va[8], vb[8];
    if (nitems > 0) {
        const int lastit = nitems - 1;
        { const float* s_; CVT_DECODE(0, s_, dst); CVT_LOAD(va, s_, 0); CVT_LOAD(vb, s_, 1); }
        CVT_WAIT(va, 0); CVT_WAIT(vb, 0);
        for (int it = 0; it < nitems; ++it) {
            const int nx = it + 1 < lastit ? it + 1 : lastit;
            CVT_DECODE(nx, nsrc, ndst);
            CVT_HALF(va, 0);
            CVT_HALF(vb, 1);
            dst = ndst;
        }
        CVT_WAIT(va, 0); CVT_WAIT(vb, 0);
    }
#undef CVT_WAIT
#undef CVT_DECODE
#undef CVT_LOAD
#undef CVT_HALF
}

__device__ __forceinline__ void adaln_gemv(const float* __restrict__ cvec, const float* __restrict__ w_ada, const float* __restrict__ b_ada, float* MOD, float* PART, gu32* ctl,
                                           int cg0, int ncg, int gw, int NGW, int lane) {
    for (int it = gw; it < ncg * 32; it += NGW) {
        const int cg = cg0 + it % ncg, kc = it / ncg, k0 = kc * 64, col0 = cg * 256 + lane * 4;
        float sc[4];
#pragma unroll
        for (int b = 0; b < 4; ++b) { const float v = cvec[b * 2048 + k0 + lane]; sc[b] = v / (1.f + __expf(-v)); }
        f32x4 acc[4];
#pragma unroll
        for (int b = 0; b < 4; ++b) acc[b] = (f32x4){0.f, 0.f, 0.f, 0.f};
#pragma unroll 8
        for (int kk = 0; kk < 64; ++kk) { const f32x4 w = __builtin_nontemporal_load((const GAS f32x4*)(w_ada + (size_t)(k0 + kk) * 12288 + col0));
#pragma unroll
            for (int b = 0; b < 4; ++b) { const float s = __builtin_bit_cast(float, __builtin_amdgcn_readlane(__builtin_bit_cast(int, sc[b]), kk)); acc[b] += w * s; } }
#pragma unroll
        for (int b = 0; b < 4; ++b) {
            GAS unsigned long long* pp = (GAS unsigned long long*)(PART + ((size_t)kc * 4 + b) * 12288 + col0);
            const float ax = acc[b].x, ay = acc[b].y, az = acc[b].z, aw = acc[b].w;
            __hip_atomic_store(pp, ((unsigned long long)__float_as_uint(ay) << 32) | __float_as_uint(ax), RLX_AGENT);
            __hip_atomic_store(pp + 1, ((unsigned long long)__float_as_uint(aw) << 32) | __float_as_uint(az), RLX_AGENT); }
        VM_WAIT();
        unsigned old = 0;
        if (lane == 0) old = __hip_atomic_fetch_add((unsigned*)(ctl + CW_GEMV + cg * 64), 1u, __ATOMIC_RELAXED, __HIP_MEMORY_SCOPE_AGENT);
        old = (unsigned)__builtin_amdgcn_readfirstlane((int)old);
        if (old == 31u) {
            __builtin_amdgcn_fence(__ATOMIC_ACQUIRE, "agent");
            VM_WAIT();
            const f32x4 bb = *(const f32x4*)(b_ada + col0);
            f32x4 tot[4] = {bb, bb, bb, bb};
            for (int k2 = 0; k2 < 32; ++k2) {
#pragma unroll
                for (int b = 0; b < 4; ++b) { const f32x4 p = *(const GAS f32x4*)(PART + ((size_t)k2 * 4 + b) * 12288 + col0); tot[b] += p; } }
#pragma unroll
            for (int b = 0; b < 4; ++b) *(GAS f32x4*)(MOD + b * 12288 + col0) = tot[b];
        }
    }
}

struct Args { const float* in[18]; float* out; unsigned char* ws; int ph_lo, ph_hi; };

__global__ void __launch_bounds__(NWAVES * 64, 2) fwd_kernel(Args args) {
    extern __shared__ __attribute__((aligned(16))) unsigned char lds[];
    Frame F;
    F.lds = (LAS unsigned char*)lds;
    F.MISC = (volatile LAS unsigned*)(F.lds + MISC_OFF);
    F.tid = threadIdx.x; F.lane = F.tid & 63; F.wave = __builtin_amdgcn_readfirstlane(F.tid >> 6);
    F.G = gridDim.x; { const int bx = blockIdx.x; F.vcu = (F.G % 8 == 0) ? (bx % 8) * (F.G / 8) + bx / 8 : bx; }
#define PHASE_PTRS() const __attribute__((address_space(4))) unsigned long long* kap = (const __attribute__((address_space(4))) unsigned long long*)__builtin_amdgcn_kernarg_segment_ptr(); asm volatile("" : "+s"(kap)); \
    unsigned char* const ws = (unsigned char*)(GAS unsigned char*)kap[19]; (void)ws
#define KIN(i) ((const float*)(const GAS float*)kap[i])
#define KOUT ((float*)(GAS float*)kap[18])
#define P_MOD ((float*)(ws + WS_MOD))
#define P_WIN_T ((bf16*)(ws + WS_WIN))
#define P_WOUT_T ((bf16*)(ws + WS_WOUT))
#define P_WGU_T ((bf16*)(ws + WS_WGU))
#define P_WDN_T ((bf16*)(ws + WS_WDN))
#define P_HB ((bf16*)(ws + WS_H))
#define P_ZB ((bf16*)(ws + WS_Z))
#define P_OB ((bf16*)(ws + WS_O))
#define P_ACT ((unsigned char*)(ws + WS_ACT))
#define P_YB ((bf16*)(ws + WS_Y))
#define P_AFF ((float*)(ws + WS_AFF))
#define P_IDX ((int*)(ws + WS_IDX))
#define P_GVR ((float*)(ws + WS_GVR))
#define P_INV ((int*)(ws + WS_INV))
#define P_RMAP ((int*)(ws + WS_RMAP))
    gu32* ctl = (gu32*)(args.ws + WS_CTL);
    for (int u = F.tid; u < (LDS_BYTES - LDSCTL_OFF) / 4; u += NWAVES * 64) ((LAS unsigned*)(F.lds + LDSCTL_OFF))[u] = 0u;
    if (F.tid == 0) F.MISC[10] = (unsigned)F.G;
    __syncthreads();
    const int lo = args.ph_lo, hi = args.ph_hi;
    XcdBarrier bar; bar.bar = (unsigned*)(ctl + CW_BAR); bar.x = 0; bar.st = nullptr;
    if (hi - lo > 1) bar = xcd_barrier_post((unsigned*)(ctl + CW_BAR), F.MISC + 8);
#ifndef PH_MASK
#define PH_MASK 0x3FF
#endif
#define IN(k) (((PH_MASK >> (k)) & 1) && lo <= (k) && (k) < hi)
#define BOTH(k) (IN(k) && IN((k) + 1))
#ifndef DUP_MASK
#define DUP_MASK 0
#endif
#define REP(k) for (int rep_ = 0; rep_ < (((DUP_MASK >> (k)) & 1) ? 2 : 1); ++rep_)
#ifndef TS_A
#define TS_A (-1)
#define TS_B (-1)
#endif
#ifndef TS_F
#define TS_F 8
#endif
#define TS_SLOT(i) do { if (TS_A >= 0 && blockIdx.x == 0 && F.tid == 0) F.MISC[16 + (i)] = (unsigned)__builtin_amdgcn_s_memrealtime(); } while (0)
#define TS_MARK(k) TS_SLOT((k) + 1)
    TS_SLOT(0);
#define GRID_BAR() xcd_barrier(bar)
    const int gw = F.vcu * NWAVES + F.wave, NGW = F.G * NWAVES;

    if (IN(0)) {
        if (blockIdx.x == 0) { PHASE_PTRS(); float* qkw = (float*)(ws + WS_QKW); const int v = F.tid >> 7, j = F.tid & 127;
            qkw[F.tid] = (v == 0 ? KIN(6) : v == 1 ? KIN(7) : v == 2 ? KIN(8) : KIN(9))[j]; }
        constexpr int W_CONV = 1536;
        if (NGW >= W_CONV + 512) {
            if (gw < W_CONV) { PHASE_PTRS();
                convert_weights<0>(KIN(5), nullptr, nullptr, (unsigned char*)P_WIN_T, nullptr, (LAS float*)(F.lds + RING_OFF + F.wave * 16384), gw, W_CONV, F.lane); }
            else { PHASE_PTRS();
                adaln_gemv(KIN(1), KIN(2), KIN(3), P_MOD, (float*)(ws + WS_PART), ctl, 0, 16, gw - W_CONV, NGW - W_CONV, F.lane); }
        } else {
            { PHASE_PTRS(); adaln_gemv(KIN(1), KIN(2), KIN(3), P_MOD, (float*)(ws + WS_PART), ctl, 0, 16, gw, NGW, F.lane); }
            { PHASE_PTRS(); convert_weights<0>(KIN(5), nullptr, nullptr, (unsigned char*)P_WIN_T, nullptr, (LAS float*)(F.lds + RING_OFF + F.wave * 16384), gw, NGW, F.lane); }
        }
        if (BOTH(0)) GRID_BAR();
        TS_MARK(0);
    }

    if (IN(1)) REP(1) {
        PHASE_PTRS(); const float* x = KIN(0); const float* g_norm1 = KIN(4); const float* MOD = P_MOD; bf16* HB = P_HB;
        f32x4 v[8], v1[8], v2[8];
#ifndef P1_NT
#define P1_NT 1
#endif
#ifndef P1_CHUNK
#define P1_CHUNK 0
#endif
#define P1_LOAD(dst, row) do { if ((row) < M) { const GAS f32x4* xr_ = (const GAS f32x4*)(x + (size_t)(row) * DM) + F.lane; _Pragma("unroll") for (int j = 0; j < 8; ++j) dst[j] = P1_NT ? __builtin_nontemporal_load(xr_ + 64 * j) : xr_[64 * j]; } } while (0)
        const bool chunk = P1_CHUNK && (M % F.G == 0) && ((M / F.G) % NWAVES == 0);
        const int mstart = chunk ? F.vcu * (M / F.G) + F.wave : gw, mstep = chunk ? NWAVES : NGW, mend = chunk ? (F.vcu + 1) * (M / F.G) : M;
#define P1_LOADC(dst, row) do { if ((row) < mend) P1_LOAD(dst, row); } while (0)
        P1_LOADC(v1, mstart); P1_LOADC(v2, mstart + mstep);
        for (int m = mstart; m < mend; m += mstep) {
#pragma unroll
            for (int j = 0; j < 8; ++j) { v[j] = v1[j]; v1[j] = v2[j]; }
            P1_LOADC(v2, m + 2 * mstep);
            const int b = m >> 12; const float* modb = MOD + b * 12288;
            float s = 0.f;
#pragma unroll
            for (int j = 0; j < 8; ++j) s += (v[j].x * v[j].x + v[j].y * v[j].y) + (v[j].z * v[j].z + v[j].w * v[j].w);
            const float rstd = 1.0f / sqrtf(wave_sum(s) * (1.f / DM) + 1e-6f);
            GAS v2u* o8 = (GAS v2u*)(HB + (size_t)m * DM) + F.lane;
#pragma unroll
            for (int j = 0; j < 8; ++j) { const int c0 = 256 * j + 4 * F.lane;
                const f32x4 g = *(const f32x4*)(g_norm1 + c0), sh = *(const f32x4*)(modb + c0), scl = *(const f32x4*)(modb + 2048 + c0);
                const f32x4 h = v[j] * rstd * g * (scl + 1.0f) + sh;
                v2u w; w.x = pk2(h.x, h.y); w.y = pk2(h.z, h.w); o8[64 * j] = w; }
        }
#undef P1_LOAD
#undef P1_LOADC
        if (BOTH(1)) GRID_BAR();
        TS_MARK(1);
    }

    if (IN(2)) REP(2) {
        PHASE_PTRS(); bf16* HB = P_HB; bf16* WIN_T = P_WIN_T; bf16* ZB = P_ZB;
        pg8::Gemm g{HB, WIN_T, M, DIN, DM}; pg8::StaticOrder S; S.init(M, DIN, F.G, (int)blockIdx.x);
        pg8::EpiQKV E{ZB, (const float*)(ws + WS_QKW), (LAS float*)(F.lds + RMAP_OFF)};
        pg8::gemm_phase<pg8::EpiQKV, pg8::StaticOrder, true, true>(F.lds + RING_OFF, g, S, E);
        if (BOTH(2)) GRID_BAR();
        TS_MARK(2);
    }

    if (IN(3)) REP(3) {
        const int cgrp = ((int)blockIdx.x >> 3) % 3;
#define P4_AUNIT(i) do { const int w = (i) * F.G + (int)blockIdx.x; if (w < 512) { PHASE_PTRS(); bf16* ZB = P_ZB; bf16* OB = P_OB; \
            const int combo = w & 7, local = w >> 3, b = combo >> 1, kvh = combo & 1, g = local >> 4, qblk = local & 15, h = kvh * 4 + g; \
            const int q0 = qblk * 256; const size_t rowq = (size_t)b * SEQ + q0; \
            int ntA = SEQ / 64; asm volatile("" : "+s"(ntA)); \
            att::attn_unit<false>(ZB + rowq * DIN + h * 128, ZB + (size_t)b * SEQ * DIN + 1024 + kvh * 128, ZB + (size_t)b * SEQ * DIN + 1280 + kvh * 128, \
                                  OB + rowq * DM + h * 128, ntA, 0, 0.f, nullptr, (char*)lds + RING_OFF); } } while (0)
        const int nAu = (512 - (int)blockIdx.x + F.G - 1) / F.G;
        const int nbefore = cgrp < nAu ? cgrp : nAu;
        for (int i = 0; i < nbefore; ++i) P4_AUNIT(i);
        {
            PHASE_PTRS(); __syncthreads();
            adaln_gemv(KIN(1), KIN(2), KIN(3), P_MOD, (float*)(ws + WS_PART), ctl, 16, 32, gw, NGW, F.lane);
            convert_weights<1>(KIN(12), nullptr, nullptr, (unsigned char*)P_WOUT_T, nullptr, (LAS float*)(F.lds + RING_OFF + F.wave * 16384), gw, NGW, F.lane);
            convert_weights<2>(KIN(15), KIN(16), KIN(17), (unsigned char*)P_WGU_T, (unsigned char*)P_WDN_T, (LAS float*)(F.lds + RING_OFF + F.wave * 16384), gw, NGW, F.lane);
        }
        for (int i = nbefore; i < nAu; ++i) P4_AUNIT(i);
#undef P4_AUNIT
        { PHASE_PTRS(); const float* sink_b = KIN(10); const float* rel_bias = KIN(11); bf16* ZB = P_ZB; bf16* OB = P_OB;
        for (int i = 0; ; ++i) {
            const int w = i * F.G + (int)blockIdx.x; if (w >= 512) break;
            const int combo = w & 7, local = w >> 3, b = combo >> 1, kvh = combo & 1, g = local >> 4, qblk = local & 15, h = kvh * 4 + g;
            const int q0 = qblk * 256; const size_t rowq = (size_t)b * SEQ + q0;
            const int ks = (q0 - 128 < 0) ? 0 : q0 - 128, ke = (q0 + 384 > SEQ) ? SEQ : q0 + 384;
            const size_t rowk = (size_t)b * SEQ + ks;
            att::attn_unit<true>(ZB + rowq * DIN + 1536 + h * 128, ZB + rowk * DIN + 2560 + kvh * 128, ZB + rowk * DIN + 2816 + kvh * 128,
                                 OB + rowq * DM + 1024 + h * 128, (ke - ks) / 64, ks - q0, sink_b[h], rel_bias + h, (char*)lds + RING_OFF);
        }
        }
        __syncthreads();
        if (BOTH(3)) GRID_BAR();
        TS_MARK(3);
    }

    if (IN(4)) REP(4) {
        PHASE_PTRS(); const float* x = KIN(0); float* out = KOUT; const float* MOD = P_MOD; bf16* OB = P_OB; bf16* WOUT_T = P_WOUT_T;
        pg8::Gemm g{OB, WOUT_T, M, DM, DM}; pg8::StaticOrder S; S.init(M, DM, F.G, (int)blockIdx.x);
        pg8::EpiX1 E{x, out, MOD + 4096};
        pg8::gemm_phase<pg8::EpiX1, pg8::StaticOrder, true, true>(F.lds + RING_OFF, g, S, E);
        if (BOTH(4)) GRID_BAR();
        TS_MARK(4);
    }

    if (IN(5)) REP(5) {
        PHASE_PTRS(); const float* g_norm2 = KIN(13); const float* w_router = KIN(14); float* out = KOUT; const float* MOD = P_MOD; bf16* HB = P_HB; float* AFF = P_AFF;
        LAS f32x4* wr = (LAS f32x4*)(F.lds + RING_OFF);
        for (int gidx = F.tid; gidx < 8192; gidx += NWAVES * 64) { const int k = gidx >> 2, q = gidx & 3, j = k >> 8, ln = (k & 255) >> 2, i = k & 3;
            wr[((j * 4 + i) * 4 + q) * 64 + ln] = *(const f32x4*)(w_router + (size_t)gidx * 4); }
        __syncthreads();
        if ((F.G & 3) == 0 && (SEQ % (NGW >> 2)) == 0) {
            const int b = F.vcu & 3, r0 = (F.vcu >> 2) * NWAVES + F.wave, rstep = NGW >> 2, nrow = SEQ / rstep;
            const float* modb = MOD + b * 12288;
            LAS f32x4* sal = (LAS f32x4*)(F.lds + RMAP_OFF);
            sal[F.tid] = *(const f32x4*)(modb + 6144 + 4 * F.tid);
            __syncthreads();
            f32x4 ga[8];
#pragma unroll
            for (int j = 0; j < 8; ++j) { const int c0 = 256 * j + 4 * F.lane; const f32x4 g = *(const f32x4*)(g_norm2 + c0), scl = *(const f32x4*)(modb + 8192 + c0); ga[j] = g * (scl + 1.0f); }
            const unsigned voff = (unsigned)F.lane * 16u;
#define P5_LOADA(V, row) do { const float* b_ = out + (size_t)(row) * DM; _Pragma("unroll") for (int j = 0; j < 8; ++j) \
                asm volatile("s_nop 4\n\tglobal_load_dwordx4 %0, %1, %2 nt" : "=v"(V[j]) : "v"(voff), "s"(b_ + 256 * j) : "memory"); } while (0)
#ifndef P5_RB
#define P5_RB 4
#endif
#define P5_WAIT(N) do { asm volatile("s_waitcnt vmcnt(" #N ")" ::: "memory"); __builtin_amdgcn_sched_barrier(0); } while (0)
#define P5_STEP(CUR, NXT, i) do { const int s_ = r0 + (i) * rstep, row_ = b * SEQ + s_, nrow_ = b * SEQ + r0 + (((i) + 1 < nrow) ? (i) + 1 : (i)) * rstep; \
                P5_LOADA(NXT, nrow_); P5_WAIT(17); \
                float sq_ = 0.f; _Pragma("unroll") for (int j = 0; j < 8; ++j) sq_ += (CUR[j].x * CUR[j].x + CUR[j].y * CUR[j].y) + (CUR[j].z * CUR[j].z + CUR[j].w * CUR[j].w); \
                const float rstd_ = 1.0f / sqrtf(wave_sum(sq_) * (1.f / DM) + 1e-6f); \
                GAS unsigned* o4_ = (GAS unsigned*)((unsigned char*)HB + (size_t)row_ * DM) + F.lane; \
                _Pragma("unroll") for (int j = 0; j < 8; ++j) { CUR[j] = CUR[j] * rstd_ * ga[j] + sal[64 * j + F.lane]; o4_[64 * j] = pk4_fp8(CUR[j].x, CUR[j].y, CUR[j].z, CUR[j].w); } \
                f32x2 l2_[8]; _Pragma("unroll") for (int e = 0; e < 8; ++e) l2_[e] = (f32x2){0.f, 0.f}; \
                _Pragma("unroll") for (int j = 0; j < 8; ++j) { _Pragma("unroll") for (int hb = 0; hb < 4 / P5_RB; ++hb) { f32x4 wv_[P5_RB][4]; \
                    _Pragma("unroll") for (int i2 = 0; i2 < P5_RB; ++i2) _Pragma("unroll") for (int q = 0; q < 4; ++q) wv_[i2][q] = wr[((j * 4 + hb * P5_RB + i2) * 4 + q) * 64 + F.lane]; \
                    __builtin_amdgcn_sched_barrier(0); \
                    _Pragma("unroll") for (int i2 = 0; i2 < P5_RB; ++i2) _Pragma("unroll") for (int q = 0; q < 4; ++q) { const f32x4 wv = wv_[i2][q]; \
                        const f32x2 c2_ = {CUR[j][hb * P5_RB + i2], CUR[j][hb * P5_RB + i2]}; \
                        l2_[2 * q + 0] = __builtin_elementwise_fma(c2_, (f32x2){wv.x, wv.y}, l2_[2 * q + 0]); l2_[2 * q + 1] = __builtin_elementwise_fma(c2_, (f32x2){wv.z, wv.w}, l2_[2 * q + 1]); } \
                    __builtin_amdgcn_sched_barrier(0); } } \
                float lg_[16]; _Pragma("unroll") for (int e = 0; e < 8; ++e) { lg_[2 * e] = l2_[e].x; lg_[2 * e + 1] = l2_[e].y; } \
                float mx_ = -1e30f; _Pragma("unroll") for (int e = 0; e < 16; ++e) { lg_[e] = wave_sum(lg_[e]); mx_ = fmaxf(mx_, lg_[e]); } \
                float den_ = 0.f, mine_ = 0.f; _Pragma("unroll") for (int e = 0; e < 16; ++e) { const float p_ = __expf(lg_[e] - mx_); den_ += p_; if (e == (F.lane & 15)) mine_ = p_; } \
                if (F.lane < 16) AFF[((size_t)b * NE + F.lane) * SEQ + s_] = mine_ / den_; } while (0)
            f32x4 va[8], vb[8];
            P5_LOADA(va, b * SEQ + r0); P5_WAIT(0);
            for (int i = 0; i < nrow; i += 2) { P5_STEP(va, vb, i); if (i + 1 < nrow) P5_STEP(vb, va, i + 1); else break; }
            P5_WAIT(0);
#undef P5_LOADA
#undef P5_WAIT
#undef P5_STEP
        } else {
        for (int m = gw; m < M; m += NGW) {
            const int b = m >> 12, s = m & (SEQ - 1); const float* modb = MOD + b * 12288;
            const GAS f32x4* xr = (const GAS f32x4*)(out + (size_t)m * DM) + F.lane;
            f32x4 v[8]; float sq = 0.f;
#pragma unroll
            for (int j = 0; j < 8; ++j) { v[j] = xr[64 * j]; sq += (v[j].x * v[j].x + v[j].y * v[j].y) + (v[j].z * v[j].z + v[j].w * v[j].w); }
            const float rstd = 1.0f / sqrtf(wave_sum(sq) * (1.f / DM) + 1e-6f);
            GAS unsigned* o4 = (GAS unsigned*)((unsigned char*)HB + (size_t)m * DM) + F.lane;
#pragma unroll
            for (int j = 0; j < 8; ++j) { const int c0 = 256 * j + 4 * F.lane;
                const f32x4 g = *(const f32x4*)(g_norm2 + c0), sh = *(const f32x4*)(modb + 6144 + c0), scl = *(const f32x4*)(modb + 8192 + c0);
                v[j] = v[j] * rstd * g * (scl + 1.0f) + sh;
                o4[64 * j] = pk4_fp8(v[j].x, v[j].y, v[j].z, v[j].w); }
            float lg[16];
#pragma unroll
            for (int e = 0; e < 16; ++e) lg[e] = 0.f;
#pragma unroll
            for (int j = 0; j < 8; ++j) {
#pragma unroll
                for (int i = 0; i < 4; ++i)
#pragma unroll
                    for (int q = 0; q < 4; ++q) { const f32x4 wv = wr[((j * 4 + i) * 4 + q) * 64 + F.lane];
                        lg[4 * q + 0] = fmaf(v[j][i], wv.x, lg[4 * q + 0]); lg[4 * q + 1] = fmaf(v[j][i], wv.y, lg[4 * q + 1]);
                        lg[4 * q + 2] = fmaf(v[j][i], wv.z, lg[4 * q + 2]); lg[4 * q + 3] = fmaf(v[j][i], wv.w, lg[4 * q + 3]); }
                __builtin_amdgcn_sched_barrier(0); }
            float mx = -1e30f;
#pragma unroll
            for (int e = 0; e < 16; ++e) { lg[e] = wave_sum(lg[e]); mx = fmaxf(mx, lg[e]); }
            float den = 0.f, mine = 0.f;
#pragma unroll
            for (int e = 0; e < 16; ++e) { const float p = __expf(lg[e] - mx); den += p; if (e == (F.lane & 15)) mine = p; }
            if (F.lane < 16) AFF[((size_t)b * NE + F.lane) * SEQ + s] = mine / den;
        }
        }
        __syncthreads();
        if (BOTH(5)) GRID_BAR();
        TS_MARK(5);
    }

    if (IN(6)) REP(6) {
        PHASE_PTRS(); const float* AFF = P_AFF; int* IDX = P_IDX; float* GVR = P_GVR; int* INV = P_INV; int* RMAP = P_RMAP;
        LAS unsigned* cnts = (LAS unsigned*)(F.lds + RING_OFF);
        for (int p = (int)blockIdx.x; p < NB * NE; p += F.G) {
            const int b = p >> 4, e = p & 15; const float* af = AFF + (size_t)p * SEQ;
            const int s0 = F.tid * 8;
            const f32x4 a0 = *(const f32x4*)(af + s0), a1 = *(const f32x4*)(af + s0 + 4);
            float av[8] = {a0.x, a0.y, a0.z, a0.w, a1.x, a1.y, a1.z, a1.w};
            unsigned key[8];
#pragma unroll
            for (int j = 0; j < 8; ++j) key[j] = __builtin_bit_cast(unsigned, av[j]);
            unsigned prefix = 0u;
            __syncthreads();
            for (int bit = 30; bit >= 0; --bit) {
                const unsigned cand = prefix | (1u << bit);
                unsigned c = 0;
#pragma unroll
                for (int j = 0; j < 8; ++j) c += (unsigned)__builtin_popcountll(__ballot(key[j] >= cand));
                if (F.lane == 0) cnts[(bit & 1) * 8 + F.wave] = c;
                __syncthreads();
                unsigned tot = 0;
#pragma unroll
                for (int w = 0; w < 8; ++w) tot += cnts[(bit & 1) * 8 + w];
                if (tot >= (unsigned)CAP) prefix = cand;
            }
            const unsigned T = prefix;
            unsigned cg = 0, ce = 0;
#pragma unroll
            for (int j = 0; j < 8; ++j) { cg += key[j] > T; ce += key[j] == T; }
            unsigned pk = cg | (ce << 16), inc = pk;
#pragma unroll
            for (int o = 1; o < 64; o <<= 1) { const unsigned t = __shfl_up(inc, o); if (F.lane >= o) inc += t; }
            __syncthreads();
            if (F.lane == 63) cnts[16 + F.wave] = inc;
            __syncthreads();
            unsigned base = 0, total = 0;
#pragma unroll
            for (int w = 0; w < 8; ++w) { const unsigned t = cnts[16 + w]; if (w < F.wave) base += t; total += t; }
            const unsigned excl = base + inc - pk;
            unsigned rg = excl & 0xffffu, re = excl >> 16;
            const unsigned need = (unsigned)CAP - (total & 0xffffu);
#pragma unroll
            for (int j = 0; j < 8; ++j) {
                const int s = s0 + j; int slot = -1;
                if (key[j] > T) { slot = (int)(rg + (re < need ? re : need)); ++rg; }
                else if (key[j] == T) { if (re < need) slot = (int)(rg + re); ++re; }
                INV[((size_t)b * SEQ + s) * NE + e] = slot;
                if (slot >= 0) { IDX[p * CAP + slot] = s; GVR[e * (NB * CAP) + b * CAP + slot] = av[j]; RMAP[e * (NB * CAP) + b * CAP + slot] = b * SEQ + s; }
            }
        }
        __syncthreads();
        if (BOTH(6)) GRID_BAR();
        TS_MARK(6);
    }

    if (IN(7)) REP(7) {
        PHASE_PTRS(); const unsigned char* H8 = (const unsigned char*)P_HB; const unsigned char* WGU_T = (const unsigned char*)P_WGU_T; unsigned char* ACT = (unsigned char*)P_ACT; const int* RMAP = P_RMAP;
        pg8::OrderGU S{F.G, (int)blockIdx.x};
        LAS int* rm = (LAS int*)(F.lds + RMAP_OFF);
        { pg8::Unit u; for (int i = (F.tid >> 8); i < 8; i += 2) { if (S.next(i, u)) rm[i * 256 + (F.tid & 255)] = RMAP[u.pm * 256 + (F.tid & 255)]; } }
        __syncthreads();
        pg8::Gemm g{(const pg8::bf16_t*)H8, (const pg8::bf16_t*)WGU_T, RE, 2 * DE, DM};
        pg8::EpiSwiGLU E{ACT};
        pg8::gemm_phase<pg8::EpiSwiGLU, pg8::OrderGU, true, true, true, true>(F.lds + RING_OFF, g, S, E, rm);
        if (BOTH(7)) GRID_BAR();
        TS_MARK(7);
    }

    if (IN(8)) REP(8) {
        PHASE_PTRS(); const unsigned char* ACT = (const unsigned char*)P_ACT; const unsigned char* WDN_T = (const unsigned char*)P_WDN_T; bf16* YB = P_YB; const float* GVR = P_GVR;
        pg8::Gemm g{(const pg8::bf16_t*)ACT, (const pg8::bf16_t*)WDN_T, RE, DM, DE}; pg8::OrderDN S{F.G, (int)blockIdx.x};
        pg8::EpiDown E{YB, GVR};
        pg8::gemm_phase<pg8::EpiDown, pg8::OrderDN, true, true, true, false>(F.lds + RING_OFF, g, S, E);
        if (BOTH(8)) GRID_BAR();
        TS_MARK(8);
    }

    if (IN(9)) {
        PHASE_PTRS(); float* out = KOUT; const float* MOD = P_MOD; const bf16* YB = P_YB; const int* INV = P_INV; const float* GVR = P_GVR;
        f32x4 v[8], vn[8]; int inv_n = -1;
        if (gw < M) { inv_n = INV[(size_t)gw * NE + (F.lane & 15)]; const GAS f32x4* xr = (const GAS f32x4*)(out + (size_t)gw * DM) + F.lane;
#pragma unroll
            for (int j = 0; j < 8; ++j) vn[j] = __builtin_nontemporal_load(xr + 64 * j); }
        for (int t = gw; t < M; t += NGW) {
            const int b = t >> 12; const float* gt2 = MOD + b * 12288 + 10240;
            const int inv = inv_n;
            f32x4 acc[8];
#pragma unroll
            for (int j = 0; j < 8; ++j) { v[j] = vn[j]; acc[j] = (f32x4){0.f, 0.f, 0.f, 0.f}; }
            if (t + NGW < M) { inv_n = INV[(size_t)(t + NGW) * NE + (F.lane & 15)]; const GAS f32x4* xr = (const GAS f32x4*)(out + (size_t)(t + NGW) * DM) + F.lane;
#pragma unroll
                for (int j = 0; j < 8; ++j) vn[j] = __builtin_nontemporal_load(xr + 64 * j); }
            unsigned mask = (unsigned)(__ballot(inv >= 0) & 0xffffull);
            while (mask) {
                int e_[4]; bool ok_[4];
                e_[0] = __builtin_ctz(mask); ok_[0] = true; mask &= mask - 1;
#pragma unroll
                for (int k = 1; k < 4; ++k) { ok_[k] = (mask != 0u); e_[k] = ok_[k] ? __builtin_ctz(mask | 0x10000u) : e_[0]; mask &= mask - (ok_[k] ? 1u : 0u); }
                v2u w[4][8]; float g[4];
#pragma unroll
                for (int k = 0; k < 4; ++k) {
                    const int slot = __builtin_amdgcn_readlane(inv, e_[k]);
                    const size_t yrow = (size_t)e_[k] * (NB * CAP) + b * CAP + slot;
                    const GAS v2u* yr = (const GAS v2u*)(YB + yrow * DM) + F.lane;
                    const float gk = __hip_atomic_load(GVR + yrow, __ATOMIC_RELAXED, __HIP_MEMORY_SCOPE_AGENT);
                    g[k] = ok_[k] ? gk : 0.f;
#pragma unroll
                    for (int j = 0; j < 8; ++j) w[k][j] = __builtin_nontemporal_load(yr + 64 * j);
                }
#pragma unroll
                for (int k = 0; k < 4; ++k) {
#pragma unroll
                    for (int j = 0; j < 8; ++j) { acc[j].x = fmaf(g[k], bf_lo(w[k][j].x), acc[j].x); acc[j].y = fmaf(g[k], bf_hi(w[k][j].x), acc[j].y); acc[j].z = fmaf(g[k], bf_lo(w[k][j].y), acc[j].z); acc[j].w = fmaf(g[k], bf_hi(w[k][j].y), acc[j].w); }
                }
            }
            GAS f32x4* xw = (GAS f32x4*)(out + (size_t)t * DM) + F.lane;
#pragma unroll
            for (int j = 0; j < 8; ++j) { const f32x4 g = *(const f32x4*)(gt2 + 256 * j + 4 * F.lane); __builtin_nontemporal_store(v[j] + g * acc[j], xw + 64 * j); }
        }
    }
    if (TS_A >= 0 && blockIdx.x == 0) { TS_SLOT(10); __syncthreads(); const unsigned d = F.MISC[16 + (TS_B >= 0 ? TS_B : 0)] - F.MISC[16 + (TS_A >= 0 ? TS_A : 0)];
        const unsigned long long target = __builtin_amdgcn_s_memrealtime() + (unsigned long long)TS_F * d;
        while (__builtin_amdgcn_s_memrealtime() < target) __builtin_amdgcn_s_sleep(20); }
#undef IN
#undef BOTH
#undef GRID_BAR
}

extern "C" void kernel_launch(void* const* d_in, const int* in_sizes, int n_in, void* d_out, int out_size, void* d_ws, size_t ws_size, hipStream_t stream) {
    static int grid = 0;
    if (grid == 0) {
        if (n_in != 18 || in_sizes[0] != M * DM || out_size != M * DM || ws_size < WS_END) { fprintf(stderr, "kernel_launch: shape/workspace mismatch (n_in %d, in0 %d, out %d, ws %zu)\n", n_in, n_in > 0 ? in_sizes[0] : -1, out_size, ws_size); grid = -1; return; }
        int dev = 0, cus = 0, per_cu = 0;
        if (hipGetDevice(&dev) != hipSuccess || hipDeviceGetAttribute(&cus, hipDeviceAttributeMultiprocessorCount, dev) != hipSuccess) { grid = -1; return; }
        if (hipFuncSetAttribute((const void*)fwd_kernel, hipFuncAttributeMaxDynamicSharedMemorySize, LDS_BYTES) != hipSuccess) { fprintf(stderr, "kernel_launch: hipFuncSetAttribute failed\n"); grid = -1; return; }
        if (hipOccupancyMaxActiveBlocksPerMultiprocessor(&per_cu, (const void*)fwd_kernel, NWAVES * 64, LDS_BYTES) != hipSuccess || per_cu < 1)
            fprintf(stderr, "kernel_launch: note: occupancy query reports %d workgroups per CU\n", per_cu);
        (void)hipGetLastError();
        grid = cus;
    }
    if (grid < 0) return;
    if (hipMemsetAsync((char*)d_ws + WS_CTL, 0, CTL_ZERO_BYTES, stream) != hipSuccess) return;
    Args a{};
    for (int i = 0; i < 18; ++i) a.in[i] = (const float*)d_in[i];
    a.out = (float*)d_out; a.ws = (unsigned char*)d_ws;
#if MK_PER_PHASE
    for (int p = 0; p < N_PHASES; ++p) { a.ph_lo = p; a.ph_hi = p + 1; hipLaunchKernelGGL(fwd_kernel, dim3(grid), dim3(NWAVES * 64), LDS_BYTES, stream, a); }
#else
    a.ph_lo = 0; a.ph_hi = N_PHASES; hipLaunchKernelGGL(fwd_kernel, dim3(grid), dim3(NWAVES * 64), LDS_BYTES, stream, a);
#endif
    const hipError_t le = hipPeekAtLastError();
    if (le != hipSuccess) fprintf(stderr, "kernel_launch: launch failed: %s\n", hipGetErrorName(le));
}
```

```cpp
#include <hip/hip_runtime.h>
#include <hip/hip_bf16.h>
#include <cstdio>
#include <cstdint>

#ifndef MK_PER_PHASE
#define MK_PER_PHASE 0
#endif

namespace pg8 {
#define PG8_LAS __attribute__((address_space(3)))
typedef unsigned short bf16_t;
typedef short bf16x8 __attribute__((ext_vector_type(8)));
typedef float f32x4 __attribute__((ext_vector_type(4)));
typedef unsigned u32x4 __attribute__((ext_vector_type(4)));
constexpr int BM = 256, BK = 64, HALF = 128, HTB = HALF * BK * 2, STAGE_BYTES = 8 * HTB, NXCD = 8, WGM = 8;

__host__ __device__ __forceinline__ int lds_byte(int r, int c) { const int st = (r >> 4) * 2 + (c >> 5), rr = r & 15, cc = c & 31, ob = rr * 64 + cc * 2; return st * 1024 + (ob ^ (((ob >> 9) & 1) << 5)); }
__host__ __device__ __forceinline__ void stage_rc(int b, int& R, int& C) { const int st = b / 1024, sb = b % 1024, swz = sb ^ (((sb >> 9) & 1) << 5); R = (st >> 1) * 16 + swz / 64; C = (st & 1) * 32 + (swz % 64) / 2; }
__host__ __device__ __forceinline__ int perm32(int rho) { const int n = rho >> 4, i = rho & 15; return 8 * (i >> 2) + 4 * n + (i & 3); }

struct Unit { int pm, pn; };
struct Gemm { const bf16_t* A; const bf16_t* Bt; int M, N, K; };

struct StaticOrder {
    int nM, nN, nwg, G, c;
    __host__ __device__ void init(int M, int N, int G_, int c_) { nM = M / BM; nN = N / BM; nwg = nM * nN; G = G_; c = c_; }
    __host__ __device__ __forceinline__ bool next(int i, Unit& u) const {
        const long L = (long)i * G + c; if (L >= nwg) return false;
        int wgid = (int)L; { const int q = nwg / NXCD, r = nwg % NXCD, xcd = wgid % NXCD, off = wgid / NXCD; wgid = (xcd < r ? xcd * (q + 1) : r * (q + 1) + (xcd - r) * q) + off; }
        const int nig = WGM * nN, gid = wgid / nig, fm = gid * WGM, gsz = (nM - fm) < WGM ? (nM - fm) : WGM;
        u.pm = fm + ((wgid % nig) % gsz); u.pn = (wgid % nig) / gsz; return true;
    }
    __device__ __forceinline__ void a_ready(const Unit&) const {}
    __device__ __forceinline__ void done(const Unit&) const {}
};
struct OrderGU {
    int G, c;
    __device__ __forceinline__ bool next(int i, Unit& u) const { const int L = i * G + c; if (L >= 2048) return false; const int e = L >> 7, j = L & 127, x = j & 7, jj = j >> 3;
        u.pm = e * 8 + (x >> 2) * 4 + (jj >> 2); u.pn = e * 16 + (x & 3) * 4 + (jj & 3); return true; }
    __device__ __forceinline__ void a_ready(const Unit&) const {}
    __device__ __forceinline__ void done(const Unit&) const {}
};
struct OrderDN {
    int G, c;
    __device__ __forceinline__ bool next(int i, Unit& u) const { const int L = i * G + c; if (L >= 1024) return false; const int rnd = L >> 8, cc = L & 255, x = cc & 7, jj = cc >> 3;
        const int e = rnd * 4 + (x >> 1); u.pm = e * 8 + (x & 1) * 4 + (jj & 3); u.pn = e * 8 + (jj >> 2); return true; }
    __device__ __forceinline__ void a_ready(const Unit&) const {}
    __device__ __forceinline__ void done(const Unit&) const {}
};

__device__ __forceinline__ unsigned cvt_pk_bf16(float lo, float hi) { unsigned r; asm volatile("v_cvt_pk_bf16_f32 %0, %1, %2" : "=v"(r) : "v"(lo), "v"(hi)); return r; }

struct EpiQKV {
    static constexpr bool PERM = true, AFTER_DRAIN = false;
    static __device__ __forceinline__ int bperm(int R) { const int s = R & 127, wc = s >> 5, n = (s >> 4) & 1, i = s & 15; return (R & ~127) + 64 * (wc >> 1) + 32 * n + 16 * (wc & 1) + i; }
    bf16_t* Z; const float* qkw; PG8_LAS float* xch;
    __device__ __forceinline__ void operator()(const f32x4 (&acc)[2][2][4][2], const Unit& u, int wr, int wc, int fr, int fq) const {
        typedef unsigned u32x2 __attribute__((ext_vector_type(2)));
        const int pn = u.pn, row0 = u.pm * BM + wr * 64 + fr;
        const int hc = 64 * (wc >> 1) + 16 * (wc & 1) + 4 * fq;
        const int type = (pn == 5 || pn == 11) ? 0 : (pn < 5 ? 2 : 1);
        bf16_t* zc = Z + (size_t)pn * BM + hc;
        if (type == 0) {
#pragma unroll
            for (int ai = 0; ai < 2; ++ai)
#pragma unroll
                for (int m = 0; m < 4; ++m) { bf16_t* rowp = zc + (size_t)(row0 + ai * HALF + m * 16) * 3072;
#pragma unroll
                    for (int bj = 0; bj < 2; ++bj)
#pragma unroll
                        for (int n = 0; n < 2; ++n) { const f32x4 v = acc[ai][bj][m][n]; *(u32x2*)(rowp + bj * HALF + 32 * n) = (u32x2){cvt_pk_bf16(v[0], v[1]), cvt_pk_bf16(v[2], v[3])}; } }
            return;
        }
        PG8_LAS float* xw = xch + (size_t)(wr * 128 + fr) * 8 + wc;
#pragma unroll
        for (int ai = 0; ai < 2; ++ai)
#pragma unroll
            for (int m = 0; m < 4; ++m)
#pragma unroll
                for (int bj = 0; bj < 2; ++bj) { const f32x4 a0 = acc[ai][bj][m][0], a1 = acc[ai][bj][m][1];
                    float p = (a0[0] * a0[0] + a0[1] * a0[1]) + (a0[2] * a0[2] + a0[3] * a0[3]) + (a1[0] * a1[0] + a1[1] * a1[1]) + (a1[2] * a1[2] + a1[3] * a1[3]);
                    { auto r_ = __builtin_amdgcn_permlane16_swap(__float_as_uint(p), __float_as_uint(p), false, false); p = __uint_as_float(r_[0]) + __uint_as_float(r_[1]); }
                    { auto r_ = __builtin_amdgcn_permlane32_swap(__float_as_uint(p), __float_as_uint(p), false, false); p = __uint_as_float(r_[0]) + __uint_as_float(r_[1]); }
                    if (fq == 0) xw[(size_t)(ai * 64 + m * 16) * 8 + bj * 4] = p; }
        asm volatile("s_waitcnt lgkmcnt(0)" ::: "memory");
        __builtin_amdgcn_s_barrier();
        const float* wv = qkw + 128 * ((pn < 4) ? 0 : (pn == 4 ? 1 : (pn < 10 ? 2 : 3)));
        const f32x4 w1 = *(const f32x4*)(wv + hc), w2 = *(const f32x4*)(wv + hc + 32);
        float inv[4];
#pragma unroll
        for (int r = 0; r < 4; ++r) inv[r] = __builtin_amdgcn_exp2f((float)(16 * (wc & 1) + 4 * fq + r) * (-13.287712379549449f / 32.f));
        const PG8_LAS f32x4* xr = (const PG8_LAS f32x4*)(xch + (size_t)(wr * 128 + fr) * 8);
#pragma unroll
        for (int ai = 0; ai < 2; ++ai)
#pragma unroll
            for (int m = 0; m < 4; ++m) {
                const int row = row0 + ai * HALF + m * 16; bf16_t* rowp = zc + (size_t)row * 3072;
                float cs[4], sn[4];
                if (type == 2) { const int sp = row & 4095; const float pp = (float)((wc >> 1) ? (sp & 63) : (sp >> 6));
#pragma unroll
                    for (int r = 0; r < 4; ++r) { float rev = pp * inv[r] * 0.15915494309189535f; rev = rev - __builtin_rintf(rev); sn[r] = __builtin_amdgcn_sinf(rev); cs[r] = __builtin_amdgcn_cosf(rev); } }
#pragma unroll
                for (int bj = 0; bj < 2; ++bj) {
                    const f32x4 q = xr[(size_t)(ai * 64 + m * 16) * 2 + bj];
                    const float rstd = __builtin_amdgcn_rsqf(((q[0] + q[1]) + (q[2] + q[3])) * (1.f / 128.f) + 1e-6f);
                    f32x4 x1 = acc[ai][bj][m][0] * rstd * w1, x2 = acc[ai][bj][m][1] * rstd * w2;
                    if (type == 2) {
#pragma unroll
                        for (int r = 0; r < 4; ++r) { const float a = x1[r], b = x2[r]; x1[r] = a * cs[r] - b * sn[r]; x2[r] = b * cs[r] + a * sn[r]; } }
                    *(u32x2*)(rowp + bj * HALF) = (u32x2){cvt_pk_bf16(x1[0], x1[1]), cvt_pk_bf16(x1[2], x1[3])};
                    *(u32x2*)(rowp + bj * HALF + 32) = (u32x2){cvt_pk_bf16(x2[0], x2[1]), cvt_pk_bf16(x2[2], x2[3])};
                }
            }
    }
};
struct EpiX1 {
    static __device__ __forceinline__ int bperm(int R) { return (R & ~31) + perm32(R & 31); }
    static constexpr bool PERM = true, AFTER_DRAIN = false;
    const float* x; float* out; const float* gate;
    __device__ __forceinline__ void operator()(const f32x4 (&acc)[2][2][4][2], const Unit& u, int wr, int wc, int fr, int fq) const {
        const int row0 = u.pm * BM + wr * 64 + fr, col0 = u.pn * BM + wc * 32 + 8 * fq, b = u.pm >> 4;
        typedef __attribute__((address_space(1))) f32x4 gf4;
        f32x4 gv[2][2];
#pragma unroll
        for (int bj = 0; bj < 2; ++bj)
#pragma unroll
            for (int n = 0; n < 2; ++n) gv[bj][n] = *(const f32x4*)(gate + (size_t)b * 12288 + col0 + bj * HALF + 4 * n);
        asm volatile("s_waitcnt vmcnt(0)" ::: "memory");
#define X1_LOAD(V, ai, mp) do { _Pragma("unroll") for (int mm = 0; mm < 2; ++mm) _Pragma("unroll") for (int bj = 0; bj < 2; ++bj) _Pragma("unroll") for (int n = 0; n < 2; ++n) { \
            const gf4* p_ = (const gf4*)(x + (size_t)(row0 + (ai) * HALF + ((mp) * 2 + mm) * 16) * 2048 + col0 + bj * HALF + 4 * n); \
            asm volatile("global_load_dwordx4 %0, %1, off nt" : "=v"(V[mm][bj][n]) : "v"(p_) : "memory"); } } while (0)
#define X1_WAIT(N) do { asm volatile("s_waitcnt vmcnt(" #N ")" ::: "memory"); __builtin_amdgcn_sched_barrier(0); } while (0)
#define X1_STORE(V, ai, mp) do { _Pragma("unroll") for (int mm = 0; mm < 2; ++mm) _Pragma("unroll") for (int bj = 0; bj < 2; ++bj) _Pragma("unroll") for (int n = 0; n < 2; ++n) \
            *(f32x4*)(out + (size_t)(row0 + (ai) * HALF + ((mp) * 2 + mm) * 16) * 2048 + col0 + bj * HALF + 4 * n) = V[mm][bj][n] + gv[bj][n] * acc[ai][bj][(mp) * 2 + mm][n]; } while (0)
        f32x4 xa[2][2][2], xb[2][2][2];
        X1_LOAD(xa, 0, 0); X1_LOAD(xb, 0, 1);
        X1_WAIT(8);  X1_STORE(xa, 0, 0); X1_LOAD(xa, 1, 0);
        X1_WAIT(16); X1_STORE(xb, 0, 1); X1_LOAD(xb, 1, 1);
        X1_WAIT(16); X1_STORE(xa, 1, 0);
        X1_WAIT(8);  X1_STORE(xb, 1, 1);
#undef X1_LOAD
#undef X1_WAIT
#undef X1_STORE
    }
};
struct EpiSwiGLU {
    static __device__ __forceinline__ int bperm(int R) { return (R & ~31) + perm32(R & 31); }
    static constexpr bool PERM = true, AFTER_DRAIN = false;
    unsigned char* O;
    __device__ __forceinline__ void operator()(const f32x4 (&acc)[2][2][4][2], const Unit& u, int wr, int wc, int fr, int fq) const {
        const int row0 = u.pm * BM + wr * 64 + fr, col0 = (u.pn & 15) * HALF + wc * 32 + 8 * fq;
#pragma unroll
        for (int ai = 0; ai < 2; ++ai)
#pragma unroll
            for (int m = 0; m < 4; ++m) { unsigned char* rowp = O + (size_t)(row0 + ai * HALF + m * 16) * 2048 + col0;
                float r[8];
#pragma unroll
                for (int n = 0; n < 2; ++n)
#pragma unroll
                    for (int i = 0; i < 4; ++i) { const float a = acc[ai][0][m][n][i] * (1.f / 256.f), uu = acc[ai][1][m][n][i] * (1.f / 256.f);
                        const float sg = __builtin_amdgcn_rcpf(1.f + __builtin_amdgcn_exp2f(-1.4426950408889634f * a));
                        r[n * 4 + i] = __builtin_fminf(__builtin_fmaxf(a * sg * uu, -448.f), 448.f); }
                int lo = __builtin_amdgcn_cvt_pk_fp8_f32(r[0], r[1], 0, false); lo = __builtin_amdgcn_cvt_pk_fp8_f32(r[2], r[3], lo, true);
                int hi = __builtin_amdgcn_cvt_pk_fp8_f32(r[4], r[5], 0, false); hi = __builtin_amdgcn_cvt_pk_fp8_f32(r[6], r[7], hi, true);
                typedef unsigned u32x2 __attribute__((ext_vector_type(2)));
                *(u32x2*)rowp = (u32x2){(unsigned)lo, (unsigned)hi}; }
    }
};
struct EpiDown {
    static __device__ __forceinline__ int bperm(int R) { return (R & ~31) + perm32(R & 31); }
    static constexpr bool PERM = true, AFTER_DRAIN = false;
    bf16_t* O; const float* gvr;
    __device__ __forceinline__ void operator()(const f32x4 (&acc)[2][2][4][2], const Unit& u, int wr, int wc, int fr, int fq) const {
        const int row0 = u.pm * BM + wr * 64 + fr, col0 = (u.pn & 7) * BM + wc * 32 + 8 * fq;
#pragma unroll
        for (int ai = 0; ai < 2; ++ai)
#pragma unroll
            for (int m = 0; m < 4; ++m) { const int row = row0 + ai * HALF + m * 16; const float g = (1.f / 256.f); bf16_t* rowp = O + (size_t)row * 2048 + col0;
#pragma unroll
                for (int bj = 0; bj < 2; ++bj) { const f32x4 v0 = acc[ai][bj][m][0] * g, v1 = acc[ai][bj][m][1] * g;
                    u32x4 w; w.x = cvt_pk_bf16(v0[0], v0[1]); w.y = cvt_pk_bf16(v0[2], v0[3]); w.z = cvt_pk_bf16(v1[0], v1[1]); w.w = cvt_pk_bf16(v1[2], v1[3]);
                    *(u32x4*)(rowp + bj * HALF) = w; } }
    }
};

typedef int v4i_t __attribute__((ext_vector_type(4)));
typedef int v8i_t __attribute__((ext_vector_type(8)));
template <class Epi, class Sched, bool ALIGN_EPI = false, bool SP2 = false, bool FP8 = false, bool GATHER = false>
__device__ __forceinline__ void gemm_phase(PG8_LAS unsigned char* lds, const Gemm g, const Sched& S, const Epi& E, const PG8_LAS int* rowmap = nullptr) {
    int tid_ = threadIdx.x; asm volatile("" : "+v"(tid_));
    const int tid = tid_ & 511, wid = __builtin_amdgcn_readfirstlane(tid >> 6), lane = tid & 63, wr = wid >> 2, wc = wid & 3, fr = lane & 15, fq = lane >> 4;
    constexpr int ES = FP8 ? 1 : 2, BKE = FP8 ? 128 : 64;
    const int K = g.K, nt = K / BKE;
    const unsigned Kb = (unsigned)K * ES;
    unsigned voffB[2];
#pragma unroll
    for (int i = 0; i < 2; ++i) { int R, C; stage_rc(tid * 16 + i * 8192, R, C); const int Rb = Epi::bperm(R);
        voffB[i] = (unsigned)Rb * Kb + (unsigned)C * 2u; }
    const size_t kstep = (size_t)128;
    const size_t hstep = (size_t)HALF * Kb;
    const size_t tstep = 2 * hstep;
    const unsigned ldsw = (unsigned)wid * 1024u;
    const int aoff = lds_byte(wr * 64 + fr, fq * 8), boff = lds_byte(wc * 32 + fr, fq * 8);
#define PG8_SA(b, h) (((b) * 2 + (h)) * HTB)
#define PG8_SB(b, h) ((4 + (b) * 2 + (h)) * HTB)
#define PG8_STAGE(bufoff, gbase, voff) do { _Pragma("unroll") for (int _i = 0; _i < 2; ++_i) \
        __builtin_amdgcn_global_load_lds((const unsigned*)((const char*)(gbase) + (voff)[_i]), (PG8_LAS unsigned*)(lds + (bufoff) + ldsw + _i * 8192), 16, 0, 0); } while (0)
#define PG8_LDA(dst, b, h) do { _Pragma("unroll") for (int m = 0; m < 4; ++m) _Pragma("unroll") for (int k = 0; k < 2; ++k) dst[m][k] = *(const PG8_LAS bf16x8*)(lds + PG8_SA(b, h) + aoff + m * 2048 + k * 1024); } while (0)
#define PG8_LDB(dst, b, h) do { _Pragma("unroll") for (int n = 0; n < 2; ++n) _Pragma("unroll") for (int k = 0; k < 2; ++k) dst[n][k] = *(const PG8_LAS bf16x8*)(lds + PG8_SB(b, h) + boff + n * 2048 + k * 1024); } while (0)
#define PG8_CAT(X) __builtin_shufflevector(__builtin_bit_cast(v4i_t, X[0]), __builtin_bit_cast(v4i_t, X[1]), 0, 1, 2, 3, 4, 5, 6, 7)
#define PG8_MMA(ai, bj, At, Bt) do { __builtin_amdgcn_s_setprio(1); _Pragma("unroll") for (int m = 0; m < 4; ++m) _Pragma("unroll") for (int n = 0; n < 2; ++n) { \
        if constexpr (FP8) acc[ai][bj][m][n] = __builtin_amdgcn_mfma_scale_f32_16x16x128_f8f6f4(PG8_CAT(Bt[n]), PG8_CAT(At[m]), acc[ai][bj][m][n], 0, 0, 0, 0x7F7F7F7F, 0, 0x7F7F7F7F); \
        else { _Pragma("unroll") for (int k = 0; k < 2; ++k) acc[ai][bj][m][n] = __builtin_amdgcn_mfma_f32_16x16x32_bf16(Bt[n][k], At[m][k], acc[ai][bj][m][n], 0, 0, 0); } } \
        __builtin_amdgcn_s_setprio(0); } while (0)
#define PG8_WAIT_V(n) asm volatile("s_waitcnt vmcnt(" #n ")" ::: "memory")
#define PG8_WAIT_L(n) asm volatile("s_waitcnt lgkmcnt(" #n ")" ::: "memory")
#define PG8_BAR __builtin_amdgcn_s_barrier()
#define PG8_SCHED __builtin_amdgcn_sched_barrier(0)
#define PG8_AOFFS(dst, unit, uidx) do { _Pragma("unroll") for (int i = 0; i < 2; ++i) { int R_, C_; stage_rc(tid * 16 + i * 8192, R_, C_); _Pragma("unroll") for (int h = 0; h < 2; ++h) { \
        unsigned row; if constexpr (GATHER) row = (unsigned)rowmap[(uidx) * 256 + h * HALF + R_]; else row = (unsigned)((unit).pm * BM + h * HALF + R_); \
        dst[h][i] = row * Kb + (unsigned)C_ * 2u; } } } while (0)
    Unit cur, nxt; int ui = 0;
    if (!S.next(0, cur)) return;
    f32x4 acc[2][2][4][2];
#pragma unroll
    for (int a = 0; a < 2; ++a)
#pragma unroll
        for (int b = 0; b < 2; ++b)
#pragma unroll
            for (int m = 0; m < 4; ++m)
#pragma unroll
                for (int n = 0; n < 2; ++n) acc[a][b][m][n] = (f32x4){0.f, 0.f, 0.f, 0.f};
    bf16x8 At[4][2], B0[2][2], B1[2][2];
    unsigned vA[2][2];
    PG8_AOFFS(vA, cur, 0);
    const char* const gA = (const char*)g.A;
    const char* cB = (const char*)g.Bt + (size_t)cur.pn * tstep;
    S.a_ready(cur);
    if constexpr (SP2) {
        PG8_STAGE(PG8_SB(0, 0), cB, voffB); PG8_STAGE(PG8_SB(0, 1), cB + hstep, voffB); PG8_STAGE(PG8_SA(0, 0), gA, vA[0]); PG8_STAGE(PG8_SA(0, 1), gA, vA[1]);
        if (wr == 1) PG8_BAR;
        PG8_WAIT_V(2); PG8_BAR;
        PG8_STAGE(PG8_SB(1, 0), cB + kstep, voffB); PG8_STAGE(PG8_SA(1, 0), gA + kstep, vA[0]); PG8_STAGE(PG8_SB(1, 1), cB + hstep + kstep, voffB);
        PG8_WAIT_V(6); PG8_BAR;
    } else {
        PG8_STAGE(PG8_SB(0, 0), cB, voffB); PG8_STAGE(PG8_SA(0, 0), gA, vA[0]); PG8_STAGE(PG8_SB(0, 1), cB + hstep, voffB); PG8_STAGE(PG8_SA(0, 1), gA, vA[1]);
        if (wr == 1) PG8_BAR;
        PG8_WAIT_V(4); PG8_BAR;
        PG8_STAGE(PG8_SB(1, 0), cB + kstep, voffB); PG8_STAGE(PG8_SA(1, 0), gA + kstep, vA[0]); PG8_STAGE(PG8_SB(1, 1), cB + hstep + kstep, voffB);
        PG8_WAIT_V(6); PG8_BAR;
    }
    for (;;) {
        const bool has_next = S.next(ui + 1, nxt);
        const char* nB = has_next ? (const char*)g.Bt + (size_t)nxt.pn * tstep : cB;
        for (int t = 0; t < nt; t += 2) {
            const bool last = (t == nt - 2);
            const char* a1 = gA + (size_t)(t + 1) * kstep;
            const char* a2 = last ? gA : gA + (size_t)(t + 2) * kstep; const char* b2 = last ? nB : cB + (size_t)(t + 2) * kstep;
            const char* a3 = a2 + kstep; const char* b3 = b2 + kstep;
            if (last && has_next) S.a_ready(nxt);
            if constexpr (SP2) {
            PG8_LDB(B0, 0, 0); PG8_LDB(B1, 0, 1); PG8_SCHED; PG8_LDA(At, 0, 0); PG8_STAGE(PG8_SA(1, 1), a1, vA[1]);
            if (last && has_next) { PG8_AOFFS(vA, nxt, ui + 1); }
            PG8_WAIT_V(8); PG8_WAIT_L(0); PG8_BAR; PG8_MMA(0, 0, At, B0); PG8_MMA(0, 1, At, B1); PG8_BAR; PG8_SCHED;
            PG8_LDA(At, 0, 1); PG8_STAGE(PG8_SB(0, 0), b2, voffB); PG8_STAGE(PG8_SB(0, 1), b2 + hstep, voffB); PG8_STAGE(PG8_SA(0, 0), a2, vA[0]);
            PG8_WAIT_V(8); PG8_WAIT_L(0); PG8_BAR; PG8_MMA(1, 0, At, B0); PG8_MMA(1, 1, At, B1); PG8_BAR; PG8_SCHED;
            PG8_LDB(B0, 1, 0); PG8_LDB(B1, 1, 1); PG8_SCHED; PG8_LDA(At, 1, 0); PG8_STAGE(PG8_SA(0, 1), a2, vA[1]);
            PG8_WAIT_V(8); PG8_WAIT_L(0); PG8_BAR; PG8_MMA(0, 0, At, B0); PG8_MMA(0, 1, At, B1); PG8_BAR; PG8_SCHED;
            PG8_LDA(At, 1, 1); PG8_STAGE(PG8_SB(1, 0), b3, voffB); PG8_STAGE(PG8_SB(1, 1), b3 + hstep, voffB); PG8_STAGE(PG8_SA(1, 0), a3, vA[0]);
            PG8_WAIT_V(8); PG8_WAIT_L(0); PG8_BAR; PG8_MMA(1, 0, At, B0); PG8_MMA(1, 1, At, B1); PG8_BAR; PG8_SCHED;
            } else {
            PG8_LDB(B0, 0, 0); PG8_SCHED; PG8_LDA(At, 0, 0); PG8_STAGE(PG8_SA(1, 1), a1, vA[1]);
            if (last && has_next) { PG8_AOFFS(vA, nxt, ui + 1); }
            PG8_WAIT_L(8); PG8_BAR; PG8_WAIT_L(0); PG8_MMA(0, 0, At, B0); PG8_BAR; PG8_SCHED;
            PG8_LDB(B1, 0, 1); PG8_STAGE(PG8_SB(0, 0), b2, voffB);
            PG8_BAR; PG8_WAIT_L(0); PG8_MMA(0, 1, At, B1); PG8_BAR;
            PG8_LDA(At, 0, 1); PG8_STAGE(PG8_SA(0, 0), a2, vA[0]);
            PG8_BAR; PG8_WAIT_L(0); PG8_MMA(1, 0, At, B0); PG8_BAR; PG8_SCHED;
            PG8_STAGE(PG8_SB(0, 1), b2 + hstep, voffB);
            PG8_WAIT_V(6); PG8_BAR; PG8_MMA(1, 1, At, B1); PG8_BAR;
            PG8_LDB(B0, 1, 0); PG8_SCHED; PG8_LDA(At, 1, 0); PG8_STAGE(PG8_SA(0, 1), a2, vA[1]);
            PG8_WAIT_L(8); PG8_BAR; PG8_WAIT_L(0); PG8_MMA(0, 0, At, B0); PG8_BAR; PG8_SCHED;
            PG8_LDB(B1, 1, 1); PG8_STAGE(PG8_SB(1, 0), b3, voffB);
            PG8_BAR; PG8_WAIT_L(0); PG8_MMA(0, 1, At, B1); PG8_BAR;
            PG8_LDA(At, 1, 1); PG8_STAGE(PG8_SA(1, 0), a3, vA[0]);
            PG8_BAR; PG8_WAIT_L(0); PG8_MMA(1, 0, At, B0); PG8_BAR; PG8_SCHED;
            PG8_STAGE(PG8_SB(1, 1), b3 + hstep, voffB);
            PG8_WAIT_V(6); PG8_BAR; PG8_MMA(1, 1, At, B1); PG8_BAR;
            }
        }
        if constexpr (ALIGN_EPI) { if (wr == 0) PG8_BAR; }
        if constexpr (!Epi::AFTER_DRAIN) { E(acc, cur, wr, wc, fr, fq); S.done(cur); }
        if (!has_next) break;
#pragma unroll
        for (int a = 0; a < 2; ++a)
#pragma unroll
            for (int b = 0; b < 2; ++b)
#pragma unroll
                for (int m = 0; m < 4; ++m)
#pragma unroll
                    for (int n = 0; n < 2; ++n) acc[a][b][m][n] = (f32x4){0.f, 0.f, 0.f, 0.f};
        cur = nxt; cB = nB; ++ui;
        if constexpr (ALIGN_EPI) { if (wr == 1) PG8_BAR; }
    }
    PG8_WAIT_V(0);
    if constexpr (!ALIGN_EPI) { if (wr == 0) PG8_BAR; }
    PG8_BAR;
#undef PG8_SA
#undef PG8_SB
#undef PG8_STAGE
#undef PG8_LDA
#undef PG8_LDB
#undef PG8_CAT
#undef PG8_MMA
#undef PG8_WAIT_V
#undef PG8_WAIT_L
#undef PG8_BAR
#undef PG8_SCHED
#undef PG8_AOFFS
}
}

namespace att {
using bf16 = unsigned short;
using bf16x8 = __attribute__((ext_vector_type(8))) short;
using s16x4  = __attribute__((ext_vector_type(4))) short;
using f32x16 = __attribute__((ext_vector_type(16))) float;
using u32x4  = __attribute__((ext_vector_type(4))) unsigned;
constexpr int D = 128, NW = 8, QBLK = 32, KVBLK = 64;
constexpr float SCALE = 0.088388347648318440f;
constexpr float THR = 8.f;
#ifndef ATT_SDEPTH
#define ATT_SDEPTH 2
#endif
constexpr int SDEPTH = ATT_SDEPTH;
constexpr int LDZ = 3072, LDO = 2048;
constexpr int SHM_V = KVBLK * D * 2, SHM_K = KVBLK * D * 2;
constexpr int OFF_WS = 2 * SHM_V + 2 * SHM_K, OFF_TAB = OFF_WS + NW * 64 * 4, SHM_ATTN = OFF_TAB + 768 * 4;
constexpr float MASKV = -1e37f;
#define KSWZ(row, colB) ((row) * 256 + ((colB) ^ (((row) & 7) << 4)))
#define SBAR() __builtin_amdgcn_sched_barrier(0)
__device__ __forceinline__ int crow(int r, int hi) { return (r & 3) + 8 * (r >> 2) + 4 * hi; }
__device__ __forceinline__ unsigned cvtpk(float lo, float hi) { unsigned r; asm volatile("v_cvt_pk_bf16_f32 %0, %1, %2" : "=v"(r) : "v"(lo), "v"(hi)); return r; }
__device__ __forceinline__ float bf2f(unsigned short h) { return __builtin_bit_cast(float, (unsigned)h << 16); }

__device__ __forceinline__ void partialSM(f32x16& p0, f32x16& p1, float& m_reg, float& mn, float& alpha) {
  constexpr float C = SCALE * 1.4426950408889634f;
  float pmax = p0[0];
#pragma unroll
  for (int r = 1; r < 16; ++r) pmax = fmaxf(pmax, p0[r]);
#pragma unroll
  for (int r = 0; r < 16; ++r) pmax = fmaxf(pmax, p1[r]);
  { auto rr = __builtin_amdgcn_permlane32_swap(__float_as_uint(pmax), __float_as_uint(pmax), false, false);
    pmax = fmaxf(__uint_as_float(rr[0]), __uint_as_float(rr[1])); }
  if (__builtin_expect(__all(pmax - m_reg <= THR / SCALE), 1)) { mn = m_reg; alpha = 1.f; }
  else { mn = fmaxf(m_reg, pmax); alpha = __builtin_amdgcn_exp2f((m_reg - mn) * C); m_reg = mn; }
  float mnC = -mn * C;
#pragma unroll
  for (int r = 0; r < 16; ++r) p0[r] = fmaf(p0[r], C, mnC);
#pragma unroll
  for (int r = 0; r < 16; ++r) p1[r] = fmaf(p1[r], C, mnC);
#pragma unroll
  for (int r = 0; r < 16; ++r) p0[r] = __builtin_amdgcn_exp2f(p0[r]);
}
__device__ __forceinline__ void finishSM(f32x16& p0, f32x16& p1, float alpha, float& l_reg, bf16x8& pa0, bf16x8& pa1, bf16x8& pa2, bf16x8& pa3) {
#pragma unroll
  for (int r = 0; r < 16; ++r) p1[r] = __builtin_amdgcn_exp2f(p1[r]);
  float ps = 0;
#pragma unroll
  for (int r = 0; r < 16; ++r) ps += p0[r];
#pragma unroll
  for (int r = 0; r < 16; ++r) ps += p1[r];
  { auto rr = __builtin_amdgcn_permlane32_swap(__float_as_uint(ps), __float_as_uint(ps), false, false);
    ps = __uint_as_float(rr[0]) + __uint_as_float(rr[1]); }
  l_reg = l_reg * alpha + ps;
#define PK4(P, BASE, OUT) do { unsigned a0 = cvtpk(P[BASE + 0], P[BASE + 1]), a1 = cvtpk(P[BASE + 2], P[BASE + 3]);   \
    unsigned b0 = cvtpk(P[BASE + 4], P[BASE + 5]), b1 = cvtpk(P[BASE + 6], P[BASE + 7]);                              \
    auto r0 = __builtin_amdgcn_permlane32_swap(a0, b0, false, false); auto r1 = __builtin_amdgcn_permlane32_swap(a1, b1, false, false); \
    u32x4 w = {r0[0], r1[0], r0[1], r1[1]}; OUT = *reinterpret_cast<bf16x8*>(&w); } while (0)
  PK4(p0, 0, pa0); PK4(p0, 8, pa1); PK4(p1, 0, pa2); PK4(p1, 8, pa3);
#undef PK4
}
__device__ __forceinline__ void qkt(f32x16& p0, f32x16& p1, const char* Ks, const bf16x8* qr, int r32, int hi) {
  p0 = f32x16{}; p1 = f32x16{};
#pragma unroll
  for (int d0 = 0; d0 < 8; ++d0) { int cb = (d0 * 16 + hi * 8) * 2;
    bf16x8 b0 = *reinterpret_cast<const bf16x8*>(Ks + KSWZ(r32, cb));
    bf16x8 b1 = *reinterpret_cast<const bf16x8*>(Ks + KSWZ(32 + r32, cb));
    p0 = __builtin_amdgcn_mfma_f32_32x32x16_bf16(b0, qr[d0], p0, 0, 0, 0);
    p1 = __builtin_amdgcn_mfma_f32_32x32x16_bf16(b1, qr[d0], p1, 0, 0, 0); }
}
__device__ __forceinline__ int v_st(int k, int c) { const int kk = (k & ~0xC) | ((k & 4) << 1) | ((k & 8) >> 1); return ((kk >> 3) * 4 + (c >> 5)) * 512 + ((kk & 7) * 32 + (c & 31)) * 2; }
__device__ __forceinline__ int v_rd_base(int lane) { return ((lane & 3) << 3) | (((lane >> 2) & 3) << 6) | (((lane >> 4) & 1) << 5) | (((lane >> 5) & 1) << 8); }
constexpr int v_rd_off(int d0, int ks, int half) { return d0 * 512 + ks * 4096 + half * 2048; }
template <int OFF> __device__ __forceinline__ s16x4 tr_read(int vb) {
  s16x4 r; asm volatile("ds_read_b64_tr_b16 %0, %1 offset:%2" : "=&v"(r) : "v"(vb), "i"(OFF) : "memory"); return r;
}
template <int D0> __device__ __forceinline__ void pv_one(f32x16& od, int vb, bf16x8 pa0, bf16x8 pa1, bf16x8 pa2, bf16x8 pa3) {
  const s16x4 l0 = tr_read<v_rd_off(D0, 0, 0)>(vb), h0 = tr_read<v_rd_off(D0, 0, 1)>(vb), l1 = tr_read<v_rd_off(D0, 1, 0)>(vb), h1 = tr_read<v_rd_off(D0, 1, 1)>(vb);
  const s16x4 l2 = tr_read<v_rd_off(D0, 2, 0)>(vb), h2 = tr_read<v_rd_off(D0, 2, 1)>(vb), l3 = tr_read<v_rd_off(D0, 3, 0)>(vb), h3 = tr_read<v_rd_off(D0, 3, 1)>(vb);
  asm volatile("s_waitcnt lgkmcnt(0)" ::: "memory"); SBAR();
#define PK(L, H) (bf16x8){L[0], L[1], L[2], L[3], H[0], H[1], H[2], H[3]}
  od = __builtin_amdgcn_mfma_f32_32x32x16_bf16(pa0, PK(l0, h0), od, 0, 0, 0);
  od = __builtin_amdgcn_mfma_f32_32x32x16_bf16(pa1, PK(l1, h1), od, 0, 0, 0);
  od = __builtin_amdgcn_mfma_f32_32x32x16_bf16(pa2, PK(l2, h2), od, 0, 0, 0);
  od = __builtin_amdgcn_mfma_f32_32x32x16_bf16(pa3, PK(l3, h3), od, 0, 0, 0);
#undef PK
}
__device__ __forceinline__ void pv_d0(f32x16* o, int vb, bf16x8 pa0, bf16x8 pa1, bf16x8 pa2, bf16x8 pa3) {
  pv_one<0>(o[0], vb, pa0, pa1, pa2, pa3); pv_one<1>(o[1], vb, pa0, pa1, pa2, pa3); pv_one<2>(o[2], vb, pa0, pa1, pa2, pa3); pv_one<3>(o[3], vb, pa0, pa1, pa2, pa3);
}
__device__ __forceinline__ int t5_bucket(int rel) {
  const int n = rel < 0 ? -rel : rel;
  const int large = 8 + (n >= 12) + (n >= 16) + (n >= 23) + (n >= 32) + (n >= 46) + (n >= 64) + (n >= 91);
  return (rel > 0 ? 16 : 0) + (n < 8 ? n : large);
}
__device__ __forceinline__ float rope_inv(int i) { return __builtin_amdgcn_exp2f((float)i * (-13.287712379549449f / 32.f)); }
__device__ __forceinline__ void sincos_rev(float ang, float& s, float& c) {
  float rev = ang * 0.15915494309189535f; rev = rev - __builtin_rintf(rev);
  s = __builtin_amdgcn_sinf(rev); c = __builtin_amdgcn_cosf(rev);
}

template <bool WIN>
__device__ __forceinline__ void attn_unit(const bf16* __restrict__ Zq, const bf16* __restrict__ Kh, const bf16* __restrict__ Vh, bf16* __restrict__ Ob, int NT,
                                          int relk0, float sinkv, const float* __restrict__ relb, char* lds) {
  int tid_ = threadIdx.x; asm volatile("" : "+v"(tid_));
  const int tid = tid_ & 511, wid = tid >> 6, lane = tid & 63, r32 = lane & 31, hi = lane >> 5;
  char* V_lds = lds; char* K_lds = lds + 2 * SHM_V;
  float* ws = (float*)(lds + OFF_WS) + wid * 64; float* li_l = ws; float* al_l = ws + 32;
  float* tab = (float*)(lds + OFF_TAB);
  __syncthreads();
  if constexpr (WIN) {
    for (int i = tid; i < 768; i += 512) { const int rel = i - 384; const int n = rel < 0 ? -rel : rel;
      tab[i] = (n <= 128) ? relb[t5_bucket(rel) * 8] * (1.0f / SCALE) : MASKV; }
  }
  float m_reg = -1e30f, l_reg = 0; f32x16 o[4] = {}; bf16x8 qr[8];
  {
    const bf16* Qw = Zq + (long)(wid * QBLK + r32) * LDZ + hi * 8;
#pragma unroll
    for (int d0 = 0; d0 < 8; ++d0) qr[d0] = *reinterpret_cast<const bf16x8*>(Qw + d0 * 16);
  }
  const int sr = tid >> 4, sc = (tid & 15) * 8, vst0 = v_st(sr, sc), vst1 = v_st(32 + sr, sc);
  const int vb0 = (int)(uintptr_t)V_lds + v_rd_base(lane);
  struct { bf16x8 vs0, vs1, ks0, ks1; } sr_[SDEPTH];
#define LD8(p) (*reinterpret_cast<const bf16x8*>(p))
#define SLOAD(i, k0) do { sr_[i].vs0 = LD8(&Vh[(long)((k0) + sr) * LDZ + sc]); sr_[i].vs1 = LD8(&Vh[(long)((k0) + 32 + sr) * LDZ + sc]); \
    sr_[i].ks0 = LD8(&Kh[(long)((k0) + sr) * LDZ + sc]); sr_[i].ks1 = LD8(&Kh[(long)((k0) + 32 + sr) * LDZ + sc]); } while (0)
#define SWRITE(b, i) do { *(bf16x8*)(V_lds + (b) * SHM_V + vst0) = sr_[i].vs0;          \
    *(bf16x8*)(V_lds + (b) * SHM_V + vst1) = sr_[i].vs1; int kc = sc * 2;               \
    *(bf16x8*)(K_lds + (b) * SHM_K + KSWZ(sr, kc)) = sr_[i].ks0;                       \
    *(bf16x8*)(K_lds + (b) * SHM_K + KSWZ(32 + sr, kc)) = sr_[i].ks1; } while (0)
#define SWAIT() do { if constexpr (SDEPTH == 2) asm volatile("s_waitcnt vmcnt(4)" ::: "memory"); else asm volatile("s_waitcnt vmcnt(0)" ::: "memory"); } while (0)
#define RESC(a) do { if (__any((a) < 1.f)) { if (hi == 0) al_l[r32] = (a); asm volatile("s_waitcnt lgkmcnt(0)" ::: "memory"); \
    _Pragma("unroll") for (int d = 0; d < 4; ++d) _Pragma("unroll") for (int r = 0; r < 16; ++r) o[d][r] *= al_l[crow(r, hi)]; } } while (0)
#define BIAS(P0, P1, t) do { if constexpr (WIN) { const float* tp = tab + (384 + relk0 + 64 * (t) - (wid * QBLK + r32) + 4 * hi); \
    _Pragma("unroll") for (int r = 0; r < 16; ++r) { P0[r] += tp[(r & 3) + 8 * (r >> 2)]; P1[r] += tp[32 + (r & 3) + 8 * (r >> 2)]; } } } while (0)
  f32x16 pA0, pA1, pB0, pB1; float mnA, mnB, alA, alB; bf16x8 pa0, pa1, pa2, pa3;
  constexpr int SE = 0, SO = SDEPTH - 1;
  SLOAD(SE, 0); asm volatile("s_waitcnt vmcnt(0)" ::: "memory"); SWRITE(0, SE); __syncthreads();
  qkt(pA0, pA1, K_lds, qr, r32, hi); BIAS(pA0, pA1, 0); partialSM(pA0, pA1, m_reg, mnA, alA);
  SLOAD(SO, KVBLK); if constexpr (SDEPTH == 2) { if (2 < NT) SLOAD(SE, 2 * KVBLK); }
  SWAIT(); SWRITE(1, SO); __syncthreads();
  for (int j = 1; j + 1 < NT; j += 2) {
    SBAR(); qkt(pB0, pB1, K_lds + SHM_K, qr, r32, hi);
    finishSM(pA0, pA1, alA, l_reg, pa0, pa1, pa2, pa3); SBAR();
    SLOAD(SO, (j + SDEPTH) * KVBLK); SBAR();
    pv_d0(o, vb0, pa0, pa1, pa2, pa3); BIAS(pB0, pB1, j); partialSM(pB0, pB1, m_reg, mnB, alB);
    __syncthreads(); SWAIT(); SWRITE(0, SE);
    RESC(alB); __syncthreads();
    SBAR(); qkt(pA0, pA1, K_lds, qr, r32, hi);
    finishSM(pB0, pB1, alB, l_reg, pa0, pa1, pa2, pa3); SBAR();
    if (SDEPTH == 1 || j + 3 < NT) SLOAD(SE, (j + 1 + SDEPTH) * KVBLK); SBAR();
    pv_d0(o, vb0 + SHM_V, pa0, pa1, pa2, pa3); BIAS(pA0, pA1, j + 1); partialSM(pA0, pA1, m_reg, mnA, alA);
    __syncthreads(); SWAIT(); SWRITE(1, SO);
    RESC(alA); __syncthreads();
  }
  SBAR(); qkt(pB0, pB1, K_lds + SHM_K, qr, r32, hi);
  finishSM(pA0, pA1, alA, l_reg, pa0, pa1, pa2, pa3); SBAR();
  pv_d0(o, vb0, pa0, pa1, pa2, pa3); BIAS(pB0, pB1, NT - 1); partialSM(pB0, pB1, m_reg, mnB, alB);
  __syncthreads(); RESC(alB);
  finishSM(pB0, pB1, alB, l_reg, pa0, pa1, pa2, pa3); SBAR();
  pv_d0(o, vb0 + SHM_V, pa0, pa1, pa2, pa3);
  if constexpr (WIN) { constexpr float C = SCALE * 1.4426950408889634f; l_reg += __builtin_amdgcn_exp2f(fminf(sinkv * 1.4426950408889634f - m_reg * C, 120.f)); }
  if (hi == 0) li_l[r32] = l_reg; asm volatile("s_waitcnt lgkmcnt(0)" ::: "memory");
  float rli[16];
#pragma unroll
  for (int r = 0; r < 16; ++r) rli[r] = __builtin_amdgcn_rcpf(li_l[crow(r, hi)]);
  bf16* Ow = Ob + (long)(wid * QBLK) * LDO;
  const int odd = lane & 1;
#pragma unroll
  for (int r = 0; r < 16; r += 2) { const int orow = crow(r, hi) + odd;
#pragma unroll
    for (int d0 = 0; d0 < 4; ++d0) { const float v0 = o[d0][r] * rli[r], v1 = o[d0][r + 1] * rli[r + 1];
      const float snd = odd ? v0 : v1;
      const float rcv = __builtin_bit_cast(float, __builtin_amdgcn_update_dpp(0, __builtin_bit_cast(int, snd), 0xB1, 0xF, 0xF, true));
      const unsigned w = odd ? cvtpk(rcv, v1) : cvtpk(v0, rcv);
      *(unsigned*)(Ow + (long)orow * LDO + d0 * 32 + (r32 & ~1)) = w; } }
#undef LD8
#undef SLOAD
#undef SWRITE
#undef SWAIT
#undef RESC
#undef BIAS
}
#undef KSWZ
}

constexpr int NWAVES = 8;
constexpr int NB = 4, SEQ = 4096, DM = 2048, M = NB * SEQ, DIN = 3072, NE = 16, CAP = 512, DE = 2048, RE = NE * NB * CAP;
constexpr int N_PHASES = 10;
constexpr float WSCALE = 256.f, WSCALE_INV = 1.f / 256.f;
constexpr size_t MiB = 1u << 20;
constexpr size_t WS_CTL = 0, CTL_ZERO_BYTES = 64 * 1024;
constexpr size_t WS_MOD = 256 * 1024;
constexpr size_t WS_WIN = 2 * MiB, WS_WOUT = 14 * MiB;
constexpr size_t WS_WGU = 24 * MiB, WS_WDN = 152 * MiB;
constexpr size_t WS_H = 216 * MiB;
constexpr size_t WS_Z = 280 * MiB, WS_O = 376 * MiB;
constexpr size_t WS_ACT = 440 * MiB;
constexpr size_t WS_Y = 280 * MiB;
constexpr size_t WS_AFF = 504 * MiB, WS_IDX = 505 * MiB, WS_GVR = 505 * MiB + 128 * 1024, WS_RMAP = 505 * MiB + 256 * 1024, WS_INV = 506 * MiB, WS_PART = 507 * MiB, WS_QKW = 513 * MiB + 512 * 1024, WS_END = 514 * MiB;
constexpr int CW_BAR = 4096;
constexpr int CW_GEMV = 8192;
constexpr int RING_OFF = 0, RING_BYTES = 131072;
constexpr int LDSCTL_OFF = RING_BYTES, MISC_OFF = LDSCTL_OFF + 320, RMAP_OFF = LDSCTL_OFF + 1024;
constexpr int LDS_BYTES = 147456;

#define GAS __attribute__((address_space(1)))
#define LAS __attribute__((address_space(3)))
typedef unsigned short bf16;
typedef unsigned v4u __attribute__((ext_vector_type(4)));
typedef unsigned v2u __attribute__((ext_vector_type(2)));
typedef float f32x4 __attribute__((ext_vector_type(4)));
typedef float f32x2 __attribute__((ext_vector_type(2)));
typedef GAS unsigned gu32;
#define RLX_AGENT __ATOMIC_RELAXED, __HIP_MEMORY_SCOPE_AGENT
#define LDS_WAIT() asm volatile("s_waitcnt lgkmcnt(0)" ::: "memory")
#define VM_WAIT() asm volatile("s_waitcnt vmcnt(0)" ::: "memory")
__device__ __forceinline__ unsigned f2bf(float f) { unsigned u = __builtin_bit_cast(unsigned, f); return (u + 0x7fffu + ((u >> 16) & 1u)) >> 16; }
__device__ __forceinline__ unsigned pk2(float lo, float hi) { return f2bf(lo) | (f2bf(hi) << 16); }
__device__ __forceinline__ float bf_lo(unsigned w) { return __builtin_bit_cast(float, w << 16); }
__device__ __forceinline__ float bf_hi(unsigned w) { return __builtin_bit_cast(float, w & 0xffff0000u); }

__device__ __forceinline__ unsigned pk4_fp8(float a, float b, float c, float d) {
    int v = __builtin_amdgcn_cvt_pk_fp8_f32(a, b, 0, false); v = __builtin_amdgcn_cvt_pk_fp8_f32(c, d, v, true); return (unsigned)v; }
#define XB_TMO      128
#define XB_XCNT(j)  (256  + 64 * (j))
#define XB_XSUB(j)  (1280 + 64 * (j))
#define XB_XGEN(j)  (2304 + 64 * (j))
#define XB_TOP      3328
#define XB_TOPGEN   3392
#define XCD_BAR_WORDS 3456
#define XB_SPIN_CAP (1u << 18)
__device__ __forceinline__ unsigned xb_ld(unsigned* p)              { return __hip_atomic_load(p, __ATOMIC_RELAXED, __HIP_MEMORY_SCOPE_AGENT); }
__device__ __forceinline__ unsigned xb_add(unsigned* p, unsigned v) { return __hip_atomic_fetch_add(p, v, __ATOMIC_RELAXED, __HIP_MEMORY_SCOPE_AGENT); }
__device__ __forceinline__ unsigned xb_xcc_id() { return (unsigned)__builtin_amdgcn_s_getreg((3 << 11) | 20) & 0xFu; }
#define XB_SPIN(cond, bar) do { unsigned _sp = 0; while (cond) { __builtin_amdgcn_s_sleep(1); \
    if ((++_sp & 255u) == 0u) { if (xb_ld(&(bar)[XB_TMO])) break; if (_sp > XB_SPIN_CAP) { atomicAdd(&(bar)[XB_TMO], 1u); break; } } } } while (0)
struct XcdBarrier { unsigned* bar; unsigned x; volatile LAS unsigned* st; };
__device__ __forceinline__ XcdBarrier xcd_barrier_post(unsigned* bar, volatile LAS unsigned* st) {
    XcdBarrier b; b.bar = bar; b.x = xb_xcc_id(); b.st = st;
    if (threadIdx.x == 0) (void)xb_add(&bar[XB_XCNT(b.x)], 1u);
    return b;
}
__device__ __forceinline__ void xcd_barrier_complete(unsigned* bar, unsigned x, unsigned& nloc, unsigned& nx, volatile LAS unsigned* bst) {
    const unsigned G = bst[2];
    unsigned sum, cnt, mine, sp = 0u;
    for (;;) {
        sum = 0u; cnt = 0u; mine = 0u;
#pragma unroll
        for (unsigned j = 0; j < 16; ++j) { const unsigned c = xb_ld(&bar[XB_XCNT(j)]); sum += c; cnt += (c > 0u) ? 1u : 0u; mine = (j == x) ? c : mine; }
        if (sum == G) break;
        __builtin_amdgcn_s_sleep(1);
        if ((++sp & 255u) == 0u) { if (xb_ld(&bar[XB_TMO])) break; if (sp > XB_SPIN_CAP) { atomicAdd(&bar[XB_TMO], 1u); break; } }
    }
    nloc = mine > 0u ? mine : 1u; nx = cnt > 0u ? cnt : 1u;
}
__device__ __forceinline__ void xcd_barrier(const XcdBarrier& b) {
    asm volatile("s_waitcnt vmcnt(0)" ::: "memory");
    __syncthreads();
    int tid0_ = threadIdx.x; asm volatile("" : "+v"(tid0_));
    if (tid0_ == 0) {
        unsigned* bar = b.bar;
        __builtin_amdgcn_s_waitcnt(0);
        unsigned nloc = b.st[0], nx = b.st[1];
        if (nloc == 0u) { xcd_barrier_complete(bar, b.x, nloc, nx, b.st); b.st[0] = nloc; b.st[1] = nx; }
        const unsigned old = xb_add(&bar[XB_XSUB(b.x)], 1u);
        const unsigned gen = old / nloc;
        if (old + 1u == (gen + 1u) * nloc) {
            __builtin_amdgcn_fence(__ATOMIC_RELEASE, "agent");
            asm volatile("s_waitcnt vmcnt(0)" ::: "memory");
            const unsigned og = xb_add(&bar[XB_TOP], 1u);
            const unsigned tg = og / nx;
            if (og + 1u == (tg + 1u) * nx) xb_add(&bar[XB_TOPGEN], 1u);
            else XB_SPIN(xb_ld(&bar[XB_TOPGEN]) == tg, bar);
            __builtin_amdgcn_fence(__ATOMIC_ACQUIRE, "agent");
            xb_add(&bar[XB_XGEN(b.x)], 1u);
            asm volatile("s_waitcnt vmcnt(0)" ::: "memory");
        } else {
            XB_SPIN(xb_ld(&bar[XB_XGEN(b.x)]) == gen, bar);
            __builtin_amdgcn_fence(__ATOMIC_ACQUIRE, "agent");
            asm volatile("s_waitcnt vmcnt(0)" ::: "memory");
        }
    }
    __syncthreads();
}

struct Frame {
    LAS unsigned char* lds;
    volatile LAS unsigned* MISC;
    int tid, lane, wave, vcu, G;
};
__device__ __forceinline__ float wave_sum(float v) {
    v += __builtin_bit_cast(float, __builtin_amdgcn_update_dpp(0, __builtin_bit_cast(int, v), 0xB1, 0xF, 0xF, true));
    v += __builtin_bit_cast(float, __builtin_amdgcn_update_dpp(0, __builtin_bit_cast(int, v), 0x4E, 0xF, 0xF, true));
    v += __builtin_bit_cast(float, __builtin_amdgcn_update_dpp(0, __builtin_bit_cast(int, v), 0x141, 0xF, 0xF, true));
    v += __builtin_bit_cast(float, __builtin_amdgcn_update_dpp(0, __builtin_bit_cast(int, v), 0x140, 0xF, 0xF, true));
    { auto r = __builtin_amdgcn_permlane16_swap(__float_as_uint(v), __float_as_uint(v), false, false); v = __uint_as_float(r[0]) + __uint_as_float(r[1]); }
    { auto r = __builtin_amdgcn_permlane32_swap(__float_as_uint(v), __float_as_uint(v), false, false); v = __uint_as_float(r[0]) + __uint_as_float(r[1]); }
    return v;
}
__device__ __forceinline__ float wave_max(float v) {
#pragma unroll
    for (int o = 1; o < 64; o <<= 1) v = fmaxf(v, __shfl_xor(v, o));
    return v;
}
template <int MODE>
__device__ __forceinline__ void convert_weights(const float* __restrict__ wa, const float* __restrict__ wb, const float* __restrict__ wc, unsigned char* da, unsigned char* db,
                                                LAS float* scr, int gw, int NGW, int lane) {
    constexpr bool EXPERTS = (MODE == 2);
    constexpr int NBW = (MODE == 0) ? 96 : 64;
    constexpr int I_M = 16 * NBW;
    constexpr int NITEMS = EXPERTS ? 48 * I_M : I_M;
    constexpr int NN = (MODE == 0) ? 3072 : 2048;
    constexpr int ES = EXPERTS ? 1 : 2, KB = 2048 * ES;
    const int nitems = (gw < NITEMS) ? ((NITEMS - 1 - gw) / NGW + 1) : 0;
    const float* nsrc = nullptr; unsigned char* dst = nullptr; unsigned char* ndst = nullptr;
#define CVT_DECODE(itx, SRC, DST) do { const int r = gw + (itx) * NGW; \
        if constexpr (!EXPERTS) { const int kb = r / NBW, nb = r % NBW, k0 = 128 * kb, n0 = 32 * nb; SRC = wa + (size_t)k0 * NN + n0; DST = da + ((size_t)n0 * 2048 + k0) * 2; } \
        else { const int mat = r / I_M, q = r % I_M, kb = q / NBW, nb = q % NBW, n0 = 32 * nb, k0 = 128 * kb; \
            if (mat < 16)      { SRC = wa + (size_t)mat * 2048 * 2048 + (size_t)k0 * 2048 + n0;        DST = da + (size_t)mat * 4096 * 2048 + (size_t)((n0 >> 7) * 256 + (n0 & 127)) * 2048 + k0; } \
            else if (mat < 32) { SRC = wb + (size_t)(mat - 16) * 2048 * 2048 + (size_t)k0 * 2048 + n0; DST = da + (size_t)(mat - 16) * 4096 * 2048 + (size_t)((n0 >> 7) * 256 + 128 + (n0 & 127)) * 2048 + k0; } \
            else               { SRC = wc + (size_t)(mat - 32) * 2048 * 2048 + (size_t)k0 * 2048 + n0; DST = db + (size_t)(mat - 32) * 2048 * 2048 + (size_t)n0 * 2048 + k0; } } } while (0)
    const unsigned voff = (unsigned)((lane >> 3) * NN + 4 * (lane & 7)) * 4u;
#define CVT_LOAD(V, SRC, HF) do { _Pragma("unroll") for (int i = 0; i < 8; ++i) { const float* b_ = (SRC) + (size_t)((HF) * 64 + 8 * i) * NN; \
            asm volatile("s_nop 4\n\tglobal_load_dwordx4 %0, %1, %2 nt" : "=v"(V[i]) : "v"(voff), "s"(b_) : "memory"); } } while (0)
#define CVT_WAIT(V, N) asm volatile("s_waitcnt vmcnt(" #N ")" : "+v"(V[0]), "+v"(V[1]), "+v"(V[2]), "+v"(V[3]), "+v"(V[4]), "+v"(V[5]), "+v"(V[6]), "+v"(V[7]) :: "memory")
#define CVT_HALF(V, HF) do { CVT_WAIT(V, 16); \
        if constexpr (EXPERTS) { LAS unsigned* s8_ = (LAS unsigned*)scr; \
            _Pragma("unroll") for (int i = 0; i < 8; ++i) { const f32x4 t_ = V[i] * WSCALE; s8_[72 * i + lane] = pk4_fp8(t_.x, t_.y, t_.z, t_.w); } \
            CVT_LOAD(V, nsrc, HF); \
            LDS_WAIT(); asm volatile("" ::: "memory"); \
            const int c = lane & 7, nq = lane >> 3; const LAS unsigned* r8_ = s8_ + 72 * c + nq; unsigned D_[8]; \
            _Pragma("unroll") for (int i = 0; i < 8; ++i) D_[i] = r8_[8 * i]; \
            unsigned T_[2][4]; \
            _Pragma("unroll") for (int h = 0; h < 2; ++h) { \
                const unsigned p01l = __builtin_amdgcn_perm(D_[4 * h + 1], D_[4 * h + 0], 0x05010400u), p01h = __builtin_amdgcn_perm(D_[4 * h + 1], D_[4 * h + 0], 0x07030602u); \
                const unsigned p23l = __builtin_amdgcn_perm(D_[4 * h + 3], D_[4 * h + 2], 0x05010400u), p23h = __builtin_amdgcn_perm(D_[4 * h + 3], D_[4 * h + 2], 0x07030602u); \
                T_[h][0] = __builtin_amdgcn_perm(p23l, p01l, 0x05040100u); T_[h][1] = __builtin_amdgcn_perm(p23l, p01l, 0x07060302u); \
                T_[h][2] = __builtin_amdgcn_perm(p23h, p01h, 0x05040100u); T_[h][3] = __builtin_amdgcn_perm(p23h, p01h, 0x07060302u); } \
            _Pragma("unroll") for (int s_ = 0; s_ < 4; ++s_) { v2u o; o.x = T_[0][s_]; o.y = T_[1][s_]; \
                __builtin_nontemporal_store(o, (GAS v2u*)(dst + (size_t)(4 * nq + s_) * KB + (HF) * 64 + 8 * c)); } \
            LDS_WAIT(); asm volatile("" ::: "memory"); \
        } else { \
        _Pragma("unroll") for (int i = 0; i < 8; ++i) { LAS float* w_ = scr + (8 * i + (lane >> 3)) * 33 + 4 * (lane & 7); const f32x4 t_ = V[i]; \
            w_[0] = t_.x; w_[1] = t_.y; w_[2] = t_.z; w_[3] = t_.w; } \
        CVT_LOAD(V, nsrc, HF); \
        LDS_WAIT(); asm volatile("" ::: "memory"); \
        const int c = lane & 7; \
        _Pragma("unroll") for (int j = 0; j < 4; ++j) { const int n = (lane >> 3) + 8 * j; const LAS float* sp = scr + (8 * c) * 33 + n; \
            v4u o; o.x = pk2(sp[0 * 33], sp[1 * 33]); o.y = pk2(sp[2 * 33], sp[3 * 33]); o.z = pk2(sp[4 * 33], sp[5 * 33]); o.w = pk2(sp[6 * 33], sp[7 * 33]); \
            *(GAS v4u*)(dst + (size_t)n * KB + (HF) * 128 + 16 * c) = o; } \
        LDS_WAIT(); asm volatile("" ::: "memory"); } } while (0)
    f32x4 va[8], vb[8];
    if (nitems > 0) {
        const int lastit = nitems - 1;
        { const float* s_; CVT_DECODE(0, s_, dst); CVT_LOAD(va, s_, 0); CVT_LOAD(vb, s_, 1); }
        CVT_WAIT(va, 0); CVT_WAIT(vb, 0);
        for (int it = 0; it < nitems; ++it) {
            const int nx = it + 1 < lastit ? it + 1 : lastit;
            CVT_DECODE(nx, nsrc, ndst);
            CVT_HALF(va, 0);
            CVT_HALF(vb, 1);
            dst = ndst;
        }
        CVT_WAIT(va, 0); CVT_WAIT(vb, 0);
    }
#undef CVT_WAIT
#undef CVT_DECODE
#undef CVT_LOAD
#undef CVT_HALF
}

__device__ __forceinline__ void adaln_gemv(const float* __restrict__ cvec, const float* __restrict__ w_ada, const float* __restrict__ b_ada, float* MOD, float* PART, gu32* ctl,
                                           int cg0, int ncg, int gw, int NGW, int lane) {
    for (int it = gw; it < ncg * 32; it += NGW) {
        const int cg = cg0 + it % ncg, kc = it / ncg, k0 = kc * 64, col0 = cg * 256 + lane * 4;
        float sc[4];
#pragma unroll
        for (int b = 0; b < 4; ++b) { const float v = cvec[b * 2048 + k0 + lane]; sc[b] = v / (1.f + __expf(-v)); }
        f32x4 acc[4];
#pragma unroll
        for (int b = 0; b < 4; ++b) acc[b] = (f32x4){0.f, 0.f, 0.f, 0.f};
#pragma unroll 8
        for (int kk = 0; kk < 64; ++kk) { const f32x4 w = __builtin_nontemporal_load((const GAS f32x4*)(w_ada + (size_t)(k0 + kk) * 12288 + col0));
#pragma unroll
            for (int b = 0; b < 4; ++b) { const float s = __builtin_bit_cast(float, __builtin_amdgcn_readlane(__builtin_bit_cast(int, sc[b]), kk)); acc[b] += w * s; } }
#pragma unroll
        for (int b = 0; b < 4; ++b) {
            GAS unsigned long long* pp = (GAS unsigned long long*)(PART + ((size_t)kc * 4 + b) * 12288 + col0);
            const float ax = acc[b].x, ay = acc[b].y, az = acc[b].z, aw = acc[b].w;
            __hip_atomic_store(pp, ((unsigned long long)__float_as_uint(ay) << 32) | __float_as_uint(ax), RLX_AGENT);
            __hip_atomic_store(pp + 1, ((unsigned long long)__float_as_uint(aw) << 32) | __float_as_uint(az), RLX_AGENT); }
        VM_WAIT();
        unsigned old = 0;
        if (lane == 0) old = __hip_atomic_fetch_add((unsigned*)(ctl + CW_GEMV + cg * 64), 1u, __ATOMIC_RELAXED, __HIP_MEMORY_SCOPE_AGENT);
        old = (unsigned)__builtin_amdgcn_readfirstlane((int)old);
        if (old == 31u) {
            __builtin_amdgcn_fence(__ATOMIC_ACQUIRE, "agent");
            VM_WAIT();
            const f32x4 bb = *(const f32x4*)(b_ada + col0);
            f32x4 tot[4] = {bb, bb, bb, bb};
            for (int k2 = 0; k2 < 32; ++k2) {
#pragma unroll
                for (int b = 0; b < 4; ++b) { const f32x4 p = *(const GAS f32x4*)(PART + ((size_t)k2 * 4 + b) * 12288 + col0); tot[b] += p; } }
#pragma unroll
            for (int b = 0; b < 4; ++b) *(GAS f32x4*)(MOD + b * 12288 + col0) = tot[b];
        }
    }
}

struct Args { const float* in[18]; float* out; unsigned char* ws; int ph_lo, ph_hi; };

__global__ void __launch_bounds__(NWAVES * 64, 2) fwd_kernel(Args args) {
    extern __shared__ __attribute__((aligned(16))) unsigned char lds[];
    Frame F;
    F.lds = (LAS unsigned char*)lds;
    F.MISC = (volatile LAS unsigned*)(F.lds + MISC_OFF);
    F.tid = threadIdx.x; F.lane = F.tid & 63; F.wave = __builtin_amdgcn_readfirstlane(F.tid >> 6);
    F.G = gridDim.x; { const int bx = blockIdx.x; F.vcu = (F.G % 8 == 0) ? (bx % 8) * (F.G / 8) + bx / 8 : bx; }
#define PHASE_PTRS() const __attribute__((address_space(4))) unsigned long long* kap = (const __attribute__((address_space(4))) unsigned long long*)__builtin_amdgcn_kernarg_segment_ptr(); asm volatile("" : "+s"(kap)); \
    unsigned char* const ws = (unsigned char*)(GAS unsigned char*)kap[19]; (void)ws
#define KIN(i) ((const float*)(const GAS float*)kap[i])
#define KOUT ((float*)(GAS float*)kap[18])
#define P_MOD ((float*)(ws + WS_MOD))
#define P_WIN_T ((bf16*)(ws + WS_WIN))
#define P_WOUT_T ((bf16*)(ws + WS_WOUT))
#define P_WGU_T ((bf16*)(ws + WS_WGU))
#define P_WDN_T ((bf16*)(ws + WS_WDN))
#define P_HB ((bf16*)(ws + WS_H))
#define P_ZB ((bf16*)(ws + WS_Z))
#define P_OB ((bf16*)(ws + WS_O))
#define P_ACT ((unsigned char*)(ws + WS_ACT))
#define P_YB ((bf16*)(ws + WS_Y))
#define P_AFF ((float*)(ws + WS_AFF))
#define P_IDX ((int*)(ws + WS_IDX))
#define P_GVR ((float*)(ws + WS_GVR))
#define P_INV ((int*)(ws + WS_INV))
#define P_RMAP ((int*)(ws + WS_RMAP))
    gu32* ctl = (gu32*)(args.ws + WS_CTL);
    for (int u = F.tid; u < (LDS_BYTES - LDSCTL_OFF) / 4; u += NWAVES * 64) ((LAS unsigned*)(F.lds + LDSCTL_OFF))[u] = 0u;
    if (F.tid == 0) F.MISC[10] = (unsigned)F.G;
    __syncthreads();
    const int lo = args.ph_lo, hi = args.ph_hi;
    XcdBarrier bar; bar.bar = (unsigned*)(ctl + CW_BAR); bar.x = 0; bar.st = nullptr;
    if (hi - lo > 1) bar = xcd_barrier_post((unsigned*)(ctl + CW_BAR), F.MISC + 8);
#ifndef PH_MASK
#define PH_MASK 0x3FF
#endif
#define IN(k) (((PH_MASK >> (k)) & 1) && lo <= (k) && (k) < hi)
#define BOTH(k) (IN(k) && IN((k) + 1))
#ifndef DUP_MASK
#define DUP_MASK 0
#endif
#define REP(k) for (int rep_ = 0; rep_ < (((DUP_MASK >> (k)) & 1) ? 2 : 1); ++rep_)
#ifndef TS_A
#define TS_A (-1)
#define TS_B (-1)
#endif
#ifndef TS_F
#define TS_F 8
#endif
#define TS_SLOT(i) do { if (TS_A >= 0 && blockIdx.x == 0 && F.tid == 0) F.MISC[16 + (i)] = (unsigned)__builtin_amdgcn_s_memrealtime(); } while (0)
#define TS_MARK(k) TS_SLOT((k) + 1)
    TS_SLOT(0);
#define GRID_BAR() xcd_barrier(bar)
    const int gw = F.vcu * NWAVES + F.wave, NGW = F.G * NWAVES;

    if (IN(0)) {
        if (blockIdx.x == 0) { PHASE_PTRS(); float* qkw = (float*)(ws + WS_QKW); const int v = F.tid >> 7, j = F.tid & 127;
            qkw[F.tid] = (v == 0 ? KIN(6) : v == 1 ? KIN(7) : v == 2 ? KIN(8) : KIN(9))[j]; }
        constexpr int W_CONV = 1536;
        if (NGW >= W_CONV + 512) {
            if (gw < W_CONV) { PHASE_PTRS();
                convert_weights<0>(KIN(5), nullptr, nullptr, (unsigned char*)P_WIN_T, nullptr, (LAS float*)(F.lds + RING_OFF + F.wave * 16384), gw, W_CONV, F.lane); }
            else { PHASE_PTRS();
                adaln_gemv(KIN(1), KIN(2), KIN(3), P_MOD, (float*)(ws + WS_PART), ctl, 0, 16, gw - W_CONV, NGW - W_CONV, F.lane); }
        } else {
            { PHASE_PTRS(); adaln_gemv(KIN(1), KIN(2), KIN(3), P_MOD, (float*)(ws + WS_PART), ctl, 0, 16, gw, NGW, F.lane); }
            { PHASE_PTRS(); convert_weights<0>(KIN(5), nullptr, nullptr, (unsigned char*)P_WIN_T, nullptr, (LAS float*)(F.lds + RING_OFF + F.wave * 16384), gw, NGW, F.lane); }
        }
        if (BOTH(0)) GRID_BAR();
        TS_MARK(0);
    }

    if (IN(1)) REP(1) {
        PHASE_PTRS(); const float* x = KIN(0); const float* g_norm1 = KIN(4); const float* MOD = P_MOD; bf16* HB = P_HB;
        f32x4 v[8], v1[8], v2[8];
#ifndef P1_NT
#define P1_NT 1
#endif
#ifndef P1_CHUNK
#define P1_CHUNK 0
#endif
#define P1_LOAD(dst, row) do { if ((row) < M) { const GAS f32x4* xr_ = (const GAS f32x4*)(x + (size_t)(row) * DM) + F.lane; _Pragma("unroll") for (int j = 0; j < 8; ++j) dst[j] = P1_NT ? __builtin_nontemporal_load(xr_ + 64 * j) : xr_[64 * j]; } } while (0)
        const bool chunk = P1_CHUNK && (M % F.G == 0) && ((M / F.G) % NWAVES == 0);
        const int mstart = chunk ? F.vcu * (M / F.G) + F.wave : gw, mstep = chunk ? NWAVES : NGW, mend = chunk ? (F.vcu + 1) * (M / F.G) : M;
#define P1_LOADC(dst, row) do { if ((row) < mend) P1_LOAD(dst, row); } while (0)
        P1_LOADC(v1, mstart); P1_LOADC(v2, mstart + mstep);
        for (int m = mstart; m < mend; m += mstep) {
#pragma unroll
            for (int j = 0; j < 8; ++j) { v[j] = v1[j]; v1[j] = v2[j]; }
            P1_LOADC(v2, m + 2 * mstep);
            const int b = m >> 12; const float* modb = MOD + b * 12288;
            float s = 0.f;
#pragma unroll
            for (int j = 0; j < 8; ++j) s += (v[j].x * v[j].x + v[j].y * v[j].y) + (v[j].z * v[j].z + v[j].w * v[j].w);
            const float rstd = 1.0f / sqrtf(wave_sum(s) * (1.f / DM) + 1e-6f);
            GAS v2u* o8 = (GAS v2u*)(HB + (size_t)m * DM) + F.lane;
#pragma unroll
            for (int j = 0; j < 8; ++j) { const int c0 = 256 * j + 4 * F.lane;
                const f32x4 g = *(const f32x4*)(g_norm1 + c0), sh = *(const f32x4*)(modb + c0), scl = *(const f32x4*)(modb + 2048 + c0);
                const f32x4 h = v[j] * rstd * g * (scl + 1.0f) + sh;
                v2u w; w.x = pk2(h.x, h.y); w.y = pk2(h.z, h.w); o8[64 * j] = w; }
        }
#undef P1_LOAD
#undef P1_LOADC
        if (BOTH(1)) GRID_BAR();
        TS_MARK(1);
    }

    if (IN(2)) REP(2) {
        PHASE_PTRS(); bf16* HB = P_HB; bf16* WIN_T = P_WIN_T; bf16* ZB = P_ZB;
        pg8::Gemm g{HB, WIN_T, M, DIN, DM}; pg8::StaticOrder S; S.init(M, DIN, F.G, (int)blockIdx.x);
        pg8::EpiQKV E{ZB, (const float*)(ws + WS_QKW), (LAS float*)(F.lds + RMAP_OFF)};
        pg8::gemm_phase<pg8::EpiQKV, pg8::StaticOrder, true, true>(F.lds + RING_OFF, g, S, E);
        if (BOTH(2)) GRID_BAR();
        TS_MARK(2);
    }

    if (IN(3)) REP(3) {
        const int cgrp = ((int)blockIdx.x >> 3) % 3;
#define P4_AUNIT(i) do { const int w = (i) * F.G + (int)blockIdx.x; if (w < 512) { PHASE_PTRS(); bf16* ZB = P_ZB; bf16* OB = P_OB; \
            const int combo = w & 7, local = w >> 3, b = combo >> 1, kvh = combo & 1, g = local >> 4, qblk = local & 15, h = kvh * 4 + g; \
            const int q0 = qblk * 256; const size_t rowq = (size_t)b * SEQ + q0; \
            int ntA = SEQ / 64; asm volatile("" : "+s"(ntA)); \
            att::attn_unit<false>(ZB + rowq * DIN + h * 128, ZB + (size_t)b * SEQ * DIN + 1024 + kvh * 128, ZB + (size_t)b * SEQ * DIN + 1280 + kvh * 128, \
                                  OB + rowq * DM + h * 128, ntA, 0, 0.f, nullptr, (char*)lds + RING_OFF); } } while (0)
        const int nAu = (512 - (int)blockIdx.x + F.G - 1) / F.G;
        const int nbefore = cgrp < nAu ? cgrp : nAu;
        for (int i = 0; i < nbefore; ++i) P4_AUNIT(i);
        {
            PHASE_PTRS(); __syncthreads();
            adaln_gemv(KIN(1), KIN(2), KIN(3), P_MOD, (float*)(ws + WS_PART), ctl, 16, 32, gw, NGW, F.lane);
            convert_weights<1>(KIN(12), nullptr, nullptr, (unsigned char*)P_WOUT_T, nullptr, (LAS float*)(F.lds + RING_OFF + F.wave * 16384), gw, NGW, F.lane);
            convert_weights<2>(KIN(15), KIN(16), KIN(17), (unsigned char*)P_WGU_T, (unsigned char*)P_WDN_T, (LAS float*)(F.lds + RING_OFF + F.wave * 16384), gw, NGW, F.lane);
        }
        for (int i = nbefore; i < nAu; ++i) P4_AUNIT(i);
#undef P4_AUNIT
        { PHASE_PTRS(); const float* sink_b = KIN(10); const float* rel_bias = KIN(11); bf16* ZB = P_ZB; bf16* OB = P_OB;
        for (int i = 0; ; ++i) {
            const int w = i * F.G + (int)blockIdx.x; if (w >= 512) break;
            const int combo = w & 7, local = w >> 3, b = combo >> 1, kvh = combo & 1, g = local >> 4, qblk = local & 15, h = kvh * 4 + g;
            const int q0 = qblk * 256; const size_t rowq = (size_t)b * SEQ + q0;
            const int ks = (q0 - 128 < 0) ? 0 : q0 - 128, ke = (q0 + 384 > SEQ) ? SEQ : q0 + 384;
            const size_t rowk = (size_t)b * SEQ + ks;
            att::attn_unit<true>(ZB + rowq * DIN + 1536 + h * 128, ZB + rowk * DIN + 2560 + kvh * 128, ZB + rowk * DIN + 2816 + kvh * 128,
                                 OB + rowq * DM + 1024 + h * 128, (ke - ks) / 64, ks - q0, sink_b[h], rel_bias + h, (char*)lds + RING_OFF);
        }
        }
        __syncthreads();
        if (BOTH(3)) GRID_BAR();
        TS_MARK(3);
    }

    if (IN(4)) REP(4) {
        PHASE_PTRS(); const float* x = KIN(0); float* out = KOUT; const float* MOD = P_MOD; bf16* OB = P_OB; bf16* WOUT_T = P_WOUT_T;
        pg8::Gemm g{OB, WOUT_T, M, DM, DM}; pg8::StaticOrder S; S.init(M, DM, F.G, (int)blockIdx.x);
        pg8::EpiX1 E{x, out, MOD + 4096};
        pg8::gemm_phase<pg8::EpiX1, pg8::StaticOrder, true, true>(F.lds + RING_OFF, g, S, E);
        if (BOTH(4)) GRID_BAR();
        TS_MARK(4);
    }

    if (IN(5)) REP(5) {
        PHASE_PTRS(); const float* g_norm2 = KIN(13); const float* w_router = KIN(14); float* out = KOUT; const float* MOD = P_MOD; bf16* HB = P_HB; float* AFF = P_AFF;
        LAS f32x4* wr = (LAS f32x4*)(F.lds + RING_OFF);
        for (int gidx = F.tid; gidx < 8192; gidx += NWAVES * 64) { const int k = gidx >> 2, q = gidx & 3, j = k >> 8, ln = (k & 255) >> 2, i = k & 3;
            wr[((j * 4 + i) * 4 + q) * 64 + ln] = *(const f32x4*)(w_router + (size_t)gidx * 4); }
        __syncthreads();
        if ((F.G & 3) == 0 && (SEQ % (NGW >> 2)) == 0) {
            const int b = F.vcu & 3, r0 = (F.vcu >> 2) * NWAVES + F.wave, rstep = NGW >> 2, nrow = SEQ / rstep;
            const float* modb = MOD + b * 12288;
            LAS f32x4* sal = (LAS f32x4*)(F.lds + RMAP_OFF);
            sal[F.tid] = *(const f32x4*)(modb + 6144 + 4 * F.tid);
            __syncthreads();
            f32x4 ga[8];
#pragma unroll
            for (int j = 0; j < 8; ++j) { const int c0 = 256 * j + 4 * F.lane; const f32x4 g = *(const f32x4*)(g_norm2 + c0), scl = *(const f32x4*)(modb + 8192 + c0); ga[j] = g * (scl + 1.0f); }
            const unsigned voff = (unsigned)F.lane * 16u;
#define P5_LOADA(V, row) do { const float* b_ = out + (size_t)(row) * DM; _Pragma("unroll") for (int j = 0; j < 8; ++j) \
                asm volatile("s_nop 4\n\tglobal_load_dwordx4 %0, %1, %2 nt" : "=v"(V[j]) : "v"(voff), "s"(b_ + 256 * j) : "memory"); } while (0)
#ifndef P5_RB
#define P5_RB 4
#endif
#define P5_WAIT(N) do { asm volatile("s_waitcnt vmcnt(" #N ")" ::: "memory"); __builtin_amdgcn_sched_barrier(0); } while (0)
#define P5_STEP(CUR, NXT, i) do { const int s_ = r0 + (i) * rstep, row_ = b * SEQ + s_, nrow_ = b * SEQ + r0 + (((i) + 1 < nrow) ? (i) + 1 : (i)) * rstep; \
                P5_LOADA(NXT, nrow_); P5_WAIT(17); \
                float sq_ = 0.f; _Pragma("unroll") for (int j = 0; j < 8; ++j) sq_ += (CUR[j].x * CUR[j].x + CUR[j].y * CUR[j].y) + (CUR[j].z * CUR[j].z + CUR[j].w * CUR[j].w); \
                const float rstd_ = 1.0f / sqrtf(wave_sum(sq_) * (1.f / DM) + 1e-6f); \
                GAS unsigned* o4_ = (GAS unsigned*)((unsigned char*)HB + (size_t)row_ * DM) + F.lane; \
                _Pragma("unroll") for (int j = 0; j < 8; ++j) { CUR[j] = CUR[j] * rstd_ * ga[j] + sal[64 * j + F.lane]; o4_[64 * j] = pk4_fp8(CUR[j].x, CUR[j].y, CUR[j].z, CUR[j].w); } \
                f32x2 l2_[8]; _Pragma("unroll") for (int e = 0; e < 8; ++e) l2_[e] = (f32x2){0.f, 0.f}; \
                _Pragma("unroll") for (int j = 0; j < 8; ++j) { _Pragma("unroll") for (int hb = 0; hb < 4 / P5_RB; ++hb) { f32x4 wv_[P5_RB][4]; \
                    _Pragma("unroll") for (int i2 = 0; i2 < P5_RB; ++i2) _Pragma("unroll") for (int q = 0; q < 4; ++q) wv_[i2][q] = wr[((j * 4 + hb * P5_RB + i2) * 4 + q) * 64 + F.lane]; \
                    __builtin_amdgcn_sched_barrier(0); \
                    _Pragma("unroll") for (int i2 = 0; i2 < P5_RB; ++i2) _Pragma("unroll") for (int q = 0; q < 4; ++q) { const f32x4 wv = wv_[i2][q]; \
                        const f32x2 c2_ = {CUR[j][hb * P5_RB + i2], CUR[j][hb * P5_RB + i2]}; \
                        l2_[2 * q + 0] = __builtin_elementwise_fma(c2_, (f32x2){wv.x, wv.y}, l2_[2 * q + 0]); l2_[2 * q + 1] = __builtin_elementwise_fma(c2_, (f32x2){wv.z, wv.w}, l2_[2 * q + 1]); } \
                    __builtin_amdgcn_sched_barrier(0); } } \
                float lg_[16]; _Pragma("unroll") for (int e = 0; e < 8; ++e) { lg_[2 * e] = l2_[e].x; lg_[2 * e + 1] = l2_[e].y; } \
                float mx_ = -1e30f; _Pragma("unroll") for (int e = 0; e < 16; ++e) { lg_[e] = wave_sum(lg_[e]); mx_ = fmaxf(mx_, lg_[e]); } \
                float den_ = 0.f, mine_ = 0.f; _Pragma("unroll") for (int e = 0; e < 16; ++e) { const float p_ = __expf(lg_[e] - mx_); den_ += p_; if (e == (F.lane & 15)) mine_ = p_; } \
                if (F.lane < 16) AFF[((size_t)b * NE + F.lane) * SEQ + s_] = mine_ / den_; } while (0)
            f32x4 va[8], vb[8];
            P5_LOADA(va, b * SEQ + r0); P5_WAIT(0);
            for (int i = 0; i < nrow; i += 2) { P5_STEP(va, vb, i); if (i + 1 < nrow) P5_STEP(vb, va, i + 1); else break; }
            P5_WAIT(0);
#undef P5_LOADA
#undef P5_WAIT
#undef P5_STEP
        } else {
        for (int m = gw; m < M; m += NGW) {
            const int b = m >> 12, s = m & (SEQ - 1); const float* modb = MOD + b * 12288;
            const GAS f32x4* xr = (const GAS f32x4*)(out + (size_t)m * DM) + F.lane;
            f32x4 v[8]; float sq = 0.f;
#pragma unroll
            for (int j = 0; j < 8; ++j) { v[j] = xr[64 * j]; sq += (v[j].x * v[j].x + v[j].y * v[j].y) + (v[j].z * v[j].z + v[j].w * v[j].w); }
            const float rstd = 1.0f / sqrtf(wave_sum(sq) * (1.f / DM) + 1e-6f);
            GAS unsigned* o4 = (GAS unsigned*)((unsigned char*)HB + (size_t)m * DM) + F.lane;
#pragma unroll
            for (int j = 0; j < 8; ++j) { const int c0 = 256 * j + 4 * F.lane;
                const f32x4 g = *(const f32x4*)(g_norm2 + c0), sh = *(const f32x4*)(modb + 6144 + c0), scl = *(const f32x4*)(modb + 8192 + c0);
                v[j] = v[j] * rstd * g * (scl + 1.0f) + sh;
                o4[64 * j] = pk4_fp8(v[j].x, v[j].y, v[j].z, v[j].w); }
            float lg[16];
#pragma unroll
            for (int e = 0; e < 16; ++e) lg[e] = 0.f;
#pragma unroll
            for (int j = 0; j < 8; ++j) {
#pragma unroll
                for (int i = 0; i < 4; ++i)
#pragma unroll
                    for (int q = 0; q < 4; ++q) { const f32x4 wv = wr[((j * 4 + i) * 4 + q) * 64 + F.lane];
                        lg[4 * q + 0] = fmaf(v[j][i], wv.x, lg[4 * q + 0]); lg[4 * q + 1] = fmaf(v[j][i], wv.y, lg[4 * q + 1]);
                        lg[4 * q + 2] = fmaf(v[j][i], wv.z, lg[4 * q + 2]); lg[4 * q + 3] = fmaf(v[j][i], wv.w, lg[4 * q + 3]); }
                __builtin_amdgcn_sched_barrier(0); }
            float mx = -1e30f;
#pragma unroll
            for (int e = 0; e < 16; ++e) { lg[e] = wave_sum(lg[e]); mx = fmaxf(mx, lg[e]); }
            float den = 0.f, mine = 0.f;
#pragma unroll
            for (int e = 0; e < 16; ++e) { const float p = __expf(lg[e] - mx); den += p; if (e == (F.lane & 15)) mine = p; }
            if (F.lane < 16) AFF[((size_t)b * NE + F.lane) * SEQ + s] = mine / den;
        }
        }
        __syncthreads();
        if (BOTH(5)) GRID_BAR();
        TS_MARK(5);
    }

    if (IN(6)) REP(6) {
        PHASE_PTRS(); const float* AFF = P_AFF; int* IDX = P_IDX; float* GVR = P_GVR; int* INV = P_INV; int* RMAP = P_RMAP;
        LAS unsigned* cnts = (LAS unsigned*)(F.lds + RING_OFF);
        for (int p = (int)blockIdx.x; p < NB * NE; p += F.G) {
            const int b = p >> 4, e = p & 15; const float* af = AFF + (size_t)p * SEQ;
            const int s0 = F.tid * 8;
            const f32x4 a0 = *(const f32x4*)(af + s0), a1 = *(const f32x4*)(af + s0 + 4);
            float av[8] = {a0.x, a0.y, a0.z, a0.w, a1.x, a1.y, a1.z, a1.w};
            unsigned key[8];
#pragma unroll
            for (int j = 0; j < 8; ++j) key[j] = __builtin_bit_cast(unsigned, av[j]);
            unsigned prefix = 0u;
            __syncthreads();
            for (int bit = 30; bit >= 0; --bit) {
                const unsigned cand = prefix | (1u << bit);
                unsigned c = 0;
#pragma unroll
                for (int j = 0; j < 8; ++j) c += (unsigned)__builtin_popcountll(__ballot(key[j] >= cand));
                if (F.lane == 0) cnts[(bit & 1) * 8 + F.wave] = c;
                __syncthreads();
                unsigned tot = 0;
#pragma unroll
                for (int w = 0; w < 8; ++w) tot += cnts[(bit & 1) * 8 + w];
                if (tot >= (unsigned)CAP) prefix = cand;
            }
            const unsigned T = prefix;
            unsigned cg = 0, ce = 0;
#pragma unroll
            for (int j = 0; j < 8; ++j) { cg += key[j] > T; ce += key[j] == T; }
            unsigned pk = cg | (ce << 16), inc = pk;
#pragma unroll
            for (int o = 1; o < 64; o <<= 1) { const unsigned t = __shfl_up(inc, o); if (F.lane >= o) inc += t; }
            __syncthreads();
            if (F.lane == 63) cnts[16 + F.wave] = inc;
            __syncthreads();
            unsigned base = 0, total = 0;
#pragma unroll
            for (int w = 0; w < 8; ++w) { const unsigned t = cnts[16 + w]; if (w < F.wave) base += t; total += t; }
            const unsigned excl = base + inc - pk;
            unsigned rg = excl & 0xffffu, re = excl >> 16;
            const unsigned need = (unsigned)CAP - (total & 0xffffu);
#pragma unroll
            for (int j = 0; j < 8; ++j) {
                const int s = s0 + j; int slot = -1;
                if (key[j] > T) { slot = (int)(rg + (re < need ? re : need)); ++rg; }
                else if (key[j] == T) { if (re < need) slot = (int)(rg + re); ++re; }
                INV[((size_t)b * SEQ + s) * NE + e] = slot;
                if (slot >= 0) { IDX[p * CAP + slot] = s; GVR[e * (NB * CAP) + b * CAP + slot] = av[j]; RMAP[e * (NB * CAP) + b * CAP + slot] = b * SEQ + s; }
            }
        }
        __syncthreads();
        if (BOTH(6)) GRID_BAR();
        TS_MARK(6);
    }

    if (IN(7)) REP(7) {
        PHASE_PTRS(); const unsigned char* H8 = (const unsigned char*)P_HB; const unsigned char* WGU_T = (const unsigned char*)P_WGU_T; unsigned char* ACT = (unsigned char*)P_ACT; const int* RMAP = P_RMAP;
        pg8::OrderGU S{F.G, (int)blockIdx.x};
        LAS int* rm = (LAS int*)(F.lds + RMAP_OFF);
        { pg8::Unit u; for (int i = (F.tid >> 8); i < 8; i += 2) { if (S.next(i, u)) rm[i * 256 + (F.tid & 255)] = RMAP[u.pm * 256 + (F.tid & 255)]; } }
        __syncthreads();
        pg8::Gemm g{(const pg8::bf16_t*)H8, (const pg8::bf16_t*)WGU_T, RE, 2 * DE, DM};
        pg8::EpiSwiGLU E{ACT};
        pg8::gemm_phase<pg8::EpiSwiGLU, pg8::OrderGU, true, true, true, true>(F.lds + RING_OFF, g, S, E, rm);
        if (BOTH(7)) GRID_BAR();
        TS_MARK(7);
    }

    if (IN(8)) REP(8) {
        PHASE_PTRS(); const unsigned char* ACT = (const unsigned char*)P_ACT; const unsigned char* WDN_T = (const unsigned char*)P_WDN_T; bf16* YB = P_YB; const float* GVR = P_GVR;
        pg8::Gemm g{(const pg8::bf16_t*)ACT, (const pg8::bf16_t*)WDN_T, RE, DM, DE}; pg8::OrderDN S{F.G, (int)blockIdx.x};
        pg8::EpiDown E{YB, GVR};
        pg8::gemm_phase<pg8::EpiDown, pg8::OrderDN, true, true, true, false>(F.lds + RING_OFF, g, S, E);
        if (BOTH(8)) GRID_BAR();
        TS_MARK(8);
    }

    if (IN(9)) {
        PHASE_PTRS(); float* out = KOUT; const float* MOD = P_MOD; const bf16* YB = P_YB; const int* INV = P_INV; const float* GVR = P_GVR;
        f32x4 v[8], vn[8]; int inv_n = -1;
        if (gw < M) { inv_n = INV[(size_t)gw * NE + (F.lane & 15)]; const GAS f32x4* xr = (const GAS f32x4*)(out + (size_t)gw * DM) + F.lane;
#pragma unroll
            for (int j = 0; j < 8; ++j) vn[j] = __builtin_nontemporal_load(xr + 64 * j); }
        for (int t = gw; t < M; t += NGW) {
            const int b = t >> 12; const float* gt2 = MOD + b * 12288 + 10240;
            const int inv = inv_n;
            f32x4 acc[8];
#pragma unroll
            for (int j = 0; j < 8; ++j) { v[j] = vn[j]; acc[j] = (f32x4){0.f, 0.f, 0.f, 0.f}; }
            if (t + NGW < M) { inv_n = INV[(size_t)(t + NGW) * NE + (F.lane & 15)]; const GAS f32x4* xr = (const GAS f32x4*)(out + (size_t)(t + NGW) * DM) + F.lane;
#pragma unroll
                for (int j = 0; j < 8; ++j) vn[j] = __builtin_nontemporal_load(xr + 64 * j); }
            unsigned mask = (unsigned)(__ballot(inv >= 0) & 0xffffull);
            while (mask) {
                const int e = __builtin_ctz(mask); mask &= mask - 1;
                const int slot = __builtin_amdgcn_readlane(inv, e);
                const size_t yrow = (size_t)e * (NB * CAP) + b * CAP + slot;
                const GAS v2u* yr = (const GAS v2u*)(YB + yrow * DM) + F.lane;
                const float g = __hip_atomic_load(GVR + yrow, __ATOMIC_RELAXED, __HIP_MEMORY_SCOPE_AGENT);
                v2u w[8];
#pragma unroll
                for (int j = 0; j < 8; ++j) w[j] = __builtin_nontemporal_load(yr + 64 * j);
#pragma unroll
                for (int j = 0; j < 8; ++j) { acc[j].x = fmaf(g, bf_lo(w[j].x), acc[j].x); acc[j].y = fmaf(g, bf_hi(w[j].x), acc[j].y); acc[j].z = fmaf(g, bf_lo(w[j].y), acc[j].z); acc[j].w = fmaf(g, bf_hi(w[j].y), acc[j].w); }
            }
            GAS f32x4* xw = (GAS f32x4*)(out + (size_t)t * DM) + F.lane;
#pragma unroll
            for (int j = 0; j < 8; ++j) { const f32x4 g = *(const f32x4*)(gt2 + 256 * j + 4 * F.lane); __builtin_nontemporal_store(v[j] + g * acc[j], xw + 64 * j); }
        }
    }
    if (TS_A >= 0 && blockIdx.x == 0) { TS_SLOT(10); __syncthreads(); const unsigned d = F.MISC[16 + (TS_B >= 0 ? TS_B : 0)] - F.MISC[16 + (TS_A >= 0 ? TS_A : 0)];
        const unsigned long long target = __builtin_amdgcn_s_memrealtime() + (unsigned long long)TS_F * d;
        while (__builtin_amdgcn_s_memrealtime() < target) __builtin_amdgcn_s_sleep(20); }
#undef IN
#undef BOTH
#undef GRID_BAR
}

extern "C" void kernel_launch(void* const* d_in, const int* in_sizes, int n_in, void* d_out, int out_size, void* d_ws, size_t ws_size, hipStream_t stream) {
    static int grid = 0;
    if (grid == 0) {
        if (n_in != 18 || in_sizes[0] != M * DM || out_size != M * DM || ws_size < WS_END) { fprintf(stderr, "kernel_launch: shape/workspace mismatch (n_in %d, in0 %d, out %d, ws %zu)\n", n_in, n_in > 0 ? in_sizes[0] : -1, out_size, ws_size); grid = -1; return; }
        int dev = 0, cus = 0, per_cu = 0;
        if (hipGetDevice(&dev) != hipSuccess || hipDeviceGetAttribute(&cus, hipDeviceAttributeMultiprocessorCount, dev) != hipSuccess) { grid = -1; return; }
        if (hipFuncSetAttribute((const void*)fwd_kernel, hipFuncAttributeMaxDynamicSharedMemorySize, LDS_BYTES) != hipSuccess) { fprintf(stderr, "kernel_launch: hipFuncSetAttribute failed\n"); grid = -1; return; }
        if (hipOccupancyMaxActiveBlocksPerMultiprocessor(&per_cu, (const void*)fwd_kernel, NWAVES * 64, LDS_BYTES) != hipSuccess || per_cu < 1)
            fprintf(stderr, "kernel_launch: note: occupancy query reports %d workgroups per CU\n", per_cu);
        (void)hipGetLastError();
        grid = cus;
    }
    if (grid < 0) return;
    if (hipMemsetAsync((char*)d_ws + WS_CTL, 0, CTL_ZERO_BYTES, stream) != hipSuccess) return;
    Args a{};
    for (int i = 0; i < 18; ++i) a.in[i] = (const float*)d_in[i];
    a.out = (float*)d_out; a.ws = (unsigned char*)d_ws;
#if MK_PER_PHASE
    for (int p = 0; p < N_PHASES; ++p) { a.ph_lo = p; a.ph_hi = p + 1; hipLaunchKernelGGL(fwd_kernel, dim3(grid), dim3(NWAVES * 64), LDS_BYTES, stream, a); }
#else
    a.ph_lo = 0; a.ph_hi = N_PHASES; hipLaunchKernelGGL(fwd_kernel, dim3(grid), dim3(NWAVES * 64), LDS_BYTES, stream, a);
#endif
    const hipError_t le = hipPeekAtLastError();
    if (le != hipSuccess) fprintf(stderr, "kernel_launch: launch failed: %s\n", hipGetErrorName(le));
}
```

```cpp
#include <hip/hip_runtime.h>
#include <hip/hip_bf16.h>
#include <cstdio>
#include <cstdint>

#ifndef MK_PER_PHASE
#define MK_PER_PHASE 0
#endif

#define YSCALE 64.f
namespace pg8 {
#define PG8_LAS __attribute__((address_space(3)))
typedef unsigned short bf16_t;
typedef short bf16x8 __attribute__((ext_vector_type(8)));
typedef float f32x4 __attribute__((ext_vector_type(4)));
typedef unsigned u32x4 __attribute__((ext_vector_type(4)));
constexpr int BM = 256, BK = 64, HALF = 128, HTB = HALF * BK * 2, STAGE_BYTES = 8 * HTB, NXCD = 8, WGM = 8;

__host__ __device__ __forceinline__ int lds_byte(int r, int c) { const int st = (r >> 4) * 2 + (c >> 5), rr = r & 15, cc = c & 31, ob = rr * 64 + cc * 2; return st * 1024 + (ob ^ (((ob >> 9) & 1) << 5)); }
__host__ __device__ __forceinline__ void stage_rc(int b, int& R, int& C) { const int st = b / 1024, sb = b % 1024, swz = sb ^ (((sb >> 9) & 1) << 5); R = (st >> 1) * 16 + swz / 64; C = (st & 1) * 32 + (swz % 64) / 2; }
__host__ __device__ __forceinline__ int perm32(int rho) { const int n = rho >> 4, i = rho & 15; return 8 * (i >> 2) + 4 * n + (i & 3); }

struct Unit { int pm, pn; };
struct Gemm { const bf16_t* A; const bf16_t* Bt; int M, N, K; };

struct StaticOrder {
    int nM, nN, nwg, G, c;
    __host__ __device__ void init(int M, int N, int G_, int c_) { nM = M / BM; nN = N / BM; nwg = nM * nN; G = G_; c = c_; }
    __host__ __device__ __forceinline__ bool next(int i, Unit& u) const {
        const long L = (long)i * G + c; if (L >= nwg) return false;
        int wgid = (int)L; { const int q = nwg / NXCD, r = nwg % NXCD, xcd = wgid % NXCD, off = wgid / NXCD; wgid = (xcd < r ? xcd * (q + 1) : r * (q + 1) + (xcd - r) * q) + off; }
        const int nig = WGM * nN, gid = wgid / nig, fm = gid * WGM, gsz = (nM - fm) < WGM ? (nM - fm) : WGM;
        u.pm = fm + ((wgid % nig) % gsz); u.pn = (wgid % nig) / gsz; return true;
    }
    __device__ __forceinline__ void a_ready(const Unit&) const {}
    __device__ __forceinline__ void done(const Unit&) const {}
};
struct OrderGU {
    int G, c;
    __device__ __forceinline__ bool next(int i, Unit& u) const { const int L = i * G + c; if (L >= 2048) return false; const int e = L >> 7, j = L & 127, x = j & 7, jj = j >> 3;
        u.pm = e * 8 + (x >> 2) * 4 + (jj >> 2); u.pn = e * 16 + (x & 3) * 4 + (jj & 3); return true; }
    __device__ __forceinline__ void a_ready(const Unit&) const {}
    __device__ __forceinline__ void done(const Unit&) const {}
};
struct OrderDN {
    int G, c;
    __device__ __forceinline__ bool next(int i, Unit& u) const { const int L = i * G + c; if (L >= 1024) return false; const int rnd = L >> 8, cc = L & 255, x = cc & 7, jj = cc >> 3;
        const int e = rnd * 4 + (x >> 1); u.pm = e * 8 + (x & 1) * 4 + (jj & 3); u.pn = e * 8 + (jj >> 2); return true; }
    __device__ __forceinline__ void a_ready(const Unit&) const {}
    __device__ __forceinline__ void done(const Unit&) const {}
};

__device__ __forceinline__ unsigned cvt_pk_bf16(float lo, float hi) { unsigned r; asm volatile("v_cvt_pk_bf16_f32 %0, %1, %2" : "=v"(r) : "v"(lo), "v"(hi)); return r; }

#define QKV_ST16(P, A0, A1, B0, B1) do { auto r0_ = __builtin_amdgcn_permlane16_swap((A0), (B0), false, false); auto r1_ = __builtin_amdgcn_permlane16_swap((A1), (B1), false, false); \
        typedef unsigned u32x4_ __attribute__((ext_vector_type(4))); \
        *(u32x4_*)((P) + ((fq & 1) ? 28 : 0)) = (u32x4_){r0_[0], r1_[0], r0_[1], r1_[1]}; } while (0)
struct EpiQKV {
    static constexpr bool PERM = true, AFTER_DRAIN = false;
    static __device__ __forceinline__ int bperm(int R) { const int s = R & 127, wc = s >> 5, n = (s >> 4) & 1, i = s & 15; return (R & ~127) + 64 * (wc >> 1) + 32 * n + 16 * (wc & 1) + i; }
    bf16_t* Z; const float* qkw; PG8_LAS float* xch;
    __device__ __forceinline__ void operator()(const f32x4 (&acc)[2][2][4][2], const Unit& u, int wr, int wc, int fr, int fq) const {
        typedef unsigned u32x2 __attribute__((ext_vector_type(2)));
        const int pn = u.pn, row0 = u.pm * BM + wr * 64 + fr;
        const int hc = 64 * (wc >> 1) + 16 * (wc & 1) + 4 * fq;
        const int type = (pn == 5 || pn == 11) ? 0 : (pn < 5 ? 2 : 1);
        bf16_t* zc = Z + (size_t)pn * BM + hc;
        if (type == 0) {
#pragma unroll
            for (int ai = 0; ai < 2; ++ai)
#pragma unroll
                for (int m = 0; m < 4; ++m) { bf16_t* rowp = zc + (size_t)(row0 + ai * HALF + m * 16) * 3072;
#pragma unroll
                    for (int bj = 0; bj < 2; ++bj) { const f32x4 v0 = acc[ai][bj][m][0], v1 = acc[ai][bj][m][1];
                        QKV_ST16(rowp + bj * HALF, cvt_pk_bf16(v0[0], v0[1]), cvt_pk_bf16(v0[2], v0[3]), cvt_pk_bf16(v1[0], v1[1]), cvt_pk_bf16(v1[2], v1[3])); } }
            return;
        }
        PG8_LAS float* xw = xch + (size_t)(wr * 128 + fr) * 8 + wc;
#pragma unroll
        for (int ai = 0; ai < 2; ++ai)
#pragma unroll
            for (int m = 0; m < 4; ++m)
#pragma unroll
                for (int bj = 0; bj < 2; ++bj) { const f32x4 a0 = acc[ai][bj][m][0], a1 = acc[ai][bj][m][1];
                    float p = (a0[0] * a0[0] + a0[1] * a0[1]) + (a0[2] * a0[2] + a0[3] * a0[3]) + (a1[0] * a1[0] + a1[1] * a1[1]) + (a1[2] * a1[2] + a1[3] * a1[3]);
                    { auto r_ = __builtin_amdgcn_permlane16_swap(__float_as_uint(p), __float_as_uint(p), false, false); p = __uint_as_float(r_[0]) + __uint_as_float(r_[1]); }
                    { auto r_ = __builtin_amdgcn_permlane32_swap(__float_as_uint(p), __float_as_uint(p), false, false); p = __uint_as_float(r_[0]) + __uint_as_float(r_[1]); }
                    if (fq == 0) xw[(size_t)(ai * 64 + m * 16) * 8 + bj * 4] = p; }
        asm volatile("s_waitcnt lgkmcnt(0)" ::: "memory");
        __builtin_amdgcn_s_barrier();
        const float* wv = qkw + 128 * ((pn < 4) ? 0 : (pn == 4 ? 1 : (pn < 10 ? 2 : 3)));
        const f32x4 w1 = *(const f32x4*)(wv + hc), w2 = *(const f32x4*)(wv + hc + 32);
        float inv[4];
#pragma unroll
        for (int r = 0; r < 4; ++r) inv[r] = __builtin_amdgcn_exp2f((float)(16 * (wc & 1) + 4 * fq + r) * (-13.287712379549449f / 32.f));
        const PG8_LAS f32x4* xr = (const PG8_LAS f32x4*)(xch + (size_t)(wr * 128 + fr) * 8);
#pragma unroll
        for (int ai = 0; ai < 2; ++ai)
#pragma unroll
            for (int m = 0; m < 4; ++m) {
                const int row = row0 + ai * HALF + m * 16; bf16_t* rowp = zc + (size_t)row * 3072;
                float cs[4], sn[4];
                if (type == 2) { const int sp = row & 4095; const float pp = (float)((wc >> 1) ? (sp & 63) : (sp >> 6));
#pragma unroll
                    for (int r = 0; r < 4; ++r) { float rev = pp * inv[r] * 0.15915494309189535f; rev = rev - __builtin_rintf(rev); sn[r] = __builtin_amdgcn_sinf(rev); cs[r] = __builtin_amdgcn_cosf(rev); } }
#pragma unroll
                for (int bj = 0; bj < 2; ++bj) {
                    const f32x4 q = xr[(size_t)(ai * 64 + m * 16) * 2 + bj];
                    const float rstd = __builtin_amdgcn_rsqf(((q[0] + q[1]) + (q[2] + q[3])) * (1.f / 128.f) + 1e-6f);
                    f32x4 x1 = acc[ai][bj][m][0] * rstd * w1, x2 = acc[ai][bj][m][1] * rstd * w2;
                    if (type == 2) {
#pragma unroll
                        for (int r = 0; r < 4; ++r) { const float a = x1[r], b = x2[r]; x1[r] = a * cs[r] - b * sn[r]; x2[r] = b * cs[r] + a * sn[r]; } }
                    QKV_ST16(rowp + bj * HALF, cvt_pk_bf16(x1[0], x1[1]), cvt_pk_bf16(x1[2], x1[3]), cvt_pk_bf16(x2[0], x2[1]), cvt_pk_bf16(x2[2], x2[3]));
                }
            }
    }
};
struct EpiX1 {
    static __device__ __forceinline__ int bperm(int R) { return (R & ~31) + perm32(R & 31); }
    static constexpr bool PERM = true, AFTER_DRAIN = false;
    const float* x; float* out; const float* gate;
    __device__ __forceinline__ void operator()(const f32x4 (&acc)[2][2][4][2], const Unit& u, int wr, int wc, int fr, int fq) const {
        const int row0 = u.pm * BM + wr * 64 + fr, col0 = u.pn * BM + wc * 32 + 8 * fq, b = u.pm >> 4;
        typedef __attribute__((address_space(1))) f32x4 gf4;
        f32x4 gv[2][2];
#pragma unroll
        for (int bj = 0; bj < 2; ++bj)
#pragma unroll
            for (int n = 0; n < 2; ++n) gv[bj][n] = *(const f32x4*)(gate + (size_t)b * 12288 + col0 + bj * HALF + 4 * n);
        asm volatile("s_waitcnt vmcnt(0)" ::: "memory");
#define X1_LOAD(V, ai, mp) do { _Pragma("unroll") for (int mm = 0; mm < 2; ++mm) _Pragma("unroll") for (int bj = 0; bj < 2; ++bj) _Pragma("unroll") for (int n = 0; n < 2; ++n) { \
            const gf4* p_ = (const gf4*)(x + (size_t)(row0 + (ai) * HALF + ((mp) * 2 + mm) * 16) * 2048 + col0 + bj * HALF + 4 * n); \
            asm volatile("global_load_dwordx4 %0, %1, off nt" : "=v"(V[mm][bj][n]) : "v"(p_) : "memory"); } } while (0)
#define X1_WAIT(N) do { asm volatile("s_waitcnt vmcnt(" #N ")" ::: "memory"); __builtin_amdgcn_sched_barrier(0); } while (0)
#define X1_STORE(V, ai, mp) do { _Pragma("unroll") for (int mm = 0; mm < 2; ++mm) _Pragma("unroll") for (int bj = 0; bj < 2; ++bj) _Pragma("unroll") for (int n = 0; n < 2; ++n) \
            *(f32x4*)(out + (size_t)(row0 + (ai) * HALF + ((mp) * 2 + mm) * 16) * 2048 + col0 + bj * HALF + 4 * n) = V[mm][bj][n] + gv[bj][n] * acc[ai][bj][(mp) * 2 + mm][n]; } while (0)
        f32x4 xa[2][2][2], xb[2][2][2];
        X1_LOAD(xa, 0, 0); X1_LOAD(xb, 0, 1);
        X1_WAIT(8);  X1_STORE(xa, 0, 0); X1_LOAD(xa, 1, 0);
        X1_WAIT(16); X1_STORE(xb, 0, 1); X1_LOAD(xb, 1, 1);
        X1_WAIT(16); X1_STORE(xa, 1, 0);
        X1_WAIT(8);  X1_STORE(xb, 1, 1);
#undef X1_LOAD
#undef X1_WAIT
#undef X1_STORE
    }
};
struct EpiSwiGLU {
    static __device__ __forceinline__ int bperm(int R) { return (R & ~31) + perm32(R & 31); }
    static constexpr bool PERM = true, AFTER_DRAIN = false;
    unsigned char* O;
    __device__ __forceinline__ void operator()(const f32x4 (&acc)[2][2][4][2], const Unit& u, int wr, int wc, int fr, int fq) const {
        const int row0 = u.pm * BM + wr * 64 + fr, col0 = (u.pn & 15) * HALF + wc * 32 + 8 * fq;
#pragma unroll
        for (int ai = 0; ai < 2; ++ai) { unsigned lo[4], hi[4];
#pragma unroll
            for (int m = 0; m < 4; ++m) {
                float r[8];
#pragma unroll
                for (int n = 0; n < 2; ++n)
#pragma unroll
                    for (int i = 0; i < 4; ++i) { const float a = acc[ai][0][m][n][i] * (1.f / 256.f), uu = acc[ai][1][m][n][i] * (1.f / 256.f);
                        const float sg = __builtin_amdgcn_rcpf(1.f + __builtin_amdgcn_exp2f(-1.4426950408889634f * a));
                        r[n * 4 + i] = __builtin_fminf(__builtin_fmaxf(a * sg * uu, -448.f), 448.f); }
                int l_ = __builtin_amdgcn_cvt_pk_fp8_f32(r[0], r[1], 0, false); l_ = __builtin_amdgcn_cvt_pk_fp8_f32(r[2], r[3], l_, true);
                int h_ = __builtin_amdgcn_cvt_pk_fp8_f32(r[4], r[5], 0, false); h_ = __builtin_amdgcn_cvt_pk_fp8_f32(r[6], r[7], h_, true);
                lo[m] = (unsigned)l_; hi[m] = (unsigned)h_; }
#pragma unroll
            for (int p = 0; p < 2; ++p) {
                auto r0_ = __builtin_amdgcn_permlane16_swap(lo[2 * p], lo[2 * p + 1], false, false); auto r1_ = __builtin_amdgcn_permlane16_swap(hi[2 * p], hi[2 * p + 1], false, false);
                typedef unsigned u32x4_ __attribute__((ext_vector_type(4)));
                unsigned char* rowp = O + (size_t)(row0 + ai * HALF + (2 * p + (fq & 1)) * 16) * 2048 + col0 - ((fq & 1) ? 8 : 0);
                *(u32x4_*)rowp = (u32x4_){r0_[0], r1_[0], r0_[1], r1_[1]}; } }
    }
};
struct EpiDown {
    static __device__ __forceinline__ int bperm(int R) { return (R & ~31) + perm32(R & 31); }
    static constexpr bool PERM = true, AFTER_DRAIN = false;
    bf16_t* O; const float* gvr;
    __device__ __forceinline__ void operator()(const f32x4 (&acc)[2][2][4][2], const Unit& u, int wr, int wc, int fr, int fq) const {
        const int row0 = u.pm * BM + wr * 64 + fr, col0 = (u.pn & 7) * BM + wc * 32 + 8 * fq;
#pragma unroll
        for (int ai = 0; ai < 2; ++ai)
#pragma unroll
            for (int m = 0; m < 4; ++m) { const int row = row0 + ai * HALF + m * 16; const float g = (YSCALE / 256.f);
                unsigned lo[2], hi[2];
#pragma unroll
                for (int bj = 0; bj < 2; ++bj) { f32x4 v0 = acc[ai][bj][m][0] * g, v1 = acc[ai][bj][m][1] * g;
#pragma unroll
                    for (int i = 0; i < 4; ++i) { v0[i] = __builtin_fminf(__builtin_fmaxf(v0[i], -448.f), 448.f); v1[i] = __builtin_fminf(__builtin_fmaxf(v1[i], -448.f), 448.f); }
                    int l_ = __builtin_amdgcn_cvt_pk_fp8_f32(v0[0], v0[1], 0, false); l_ = __builtin_amdgcn_cvt_pk_fp8_f32(v0[2], v0[3], l_, true);
                    int h_ = __builtin_amdgcn_cvt_pk_fp8_f32(v1[0], v1[1], 0, false); h_ = __builtin_amdgcn_cvt_pk_fp8_f32(v1[2], v1[3], h_, true);
                    lo[bj] = (unsigned)l_; hi[bj] = (unsigned)h_; }
                auto r0_ = __builtin_amdgcn_permlane16_swap(lo[0], lo[1], false, false); auto r1_ = __builtin_amdgcn_permlane16_swap(hi[0], hi[1], false, false);
                unsigned char* rowp = (unsigned char*)O + (size_t)row * 2048 + col0 + ((fq & 1) ? HALF - 8 : 0);
                *(u32x4*)rowp = (u32x4){r0_[0], r1_[0], r0_[1], r1_[1]}; }
    }
};

typedef int v4i_t __attribute__((ext_vector_type(4)));
typedef int v8i_t __attribute__((ext_vector_type(8)));
template <class Epi, class Sched, bool ALIGN_EPI = false, bool SP2 = false, bool FP8 = false, bool GATHER = false>
__device__ __forceinline__ void gemm_phase(PG8_LAS unsigned char* lds, const Gemm g, const Sched& S, const Epi& E, const PG8_LAS int* rowmap = nullptr) {
    int tid_ = threadIdx.x; asm volatile("" : "+v"(tid_));
    const int tid = tid_ & 511, wid = __builtin_amdgcn_readfirstlane(tid >> 6), lane = tid & 63, wr = wid >> 2, wc = wid & 3, fr = lane & 15, fq = lane >> 4;
    constexpr int ES = FP8 ? 1 : 2, BKE = FP8 ? 128 : 64;
    const int K = g.K, nt = K / BKE;
    const unsigned Kb = (unsigned)K * ES;
    unsigned voffB[2];
#pragma unroll
    for (int i = 0; i < 2; ++i) { int R, C; stage_rc(tid * 16 + i * 8192, R, C); const int Rb = Epi::bperm(R);
        voffB[i] = (unsigned)Rb * Kb + (unsigned)C * 2u; }
    const size_t kstep = (size_t)128;
    const size_t hstep = (size_t)HALF * Kb;
    const size_t tstep = 2 * hstep;
    const unsigned ldsw = (unsigned)wid * 1024u;
    const int aoff = lds_byte(wr * 64 + fr, fq * 8), boff = lds_byte(wc * 32 + fr, fq * 8);
#define PG8_SA(b, h) (((b) * 2 + (h)) * HTB)
#define PG8_SB(b, h) ((4 + (b) * 2 + (h)) * HTB)
#define PG8_STAGE(bufoff, gbase, voff) do { _Pragma("unroll") for (int _i = 0; _i < 2; ++_i) \
        __builtin_amdgcn_global_load_lds((const unsigned*)((const char*)(gbase) + (voff)[_i]), (PG8_LAS unsigned*)(lds + (bufoff) + ldsw + _i * 8192), 16, 0, 0); } while (0)
#define PG8_LDA(dst, b, h) do { _Pragma("unroll") for (int m = 0; m < 4; ++m) _Pragma("unroll") for (int k = 0; k < 2; ++k) dst[m][k] = *(const PG8_LAS bf16x8*)(lds + PG8_SA(b, h) + aoff + m * 2048 + k * 1024); } while (0)
#define PG8_LDB(dst, b, h) do { _Pragma("unroll") for (int n = 0; n < 2; ++n) _Pragma("unroll") for (int k = 0; k < 2; ++k) dst[n][k] = *(const PG8_LAS bf16x8*)(lds + PG8_SB(b, h) + boff + n * 2048 + k * 1024); } while (0)
#define PG8_CAT(X) __builtin_shufflevector(__builtin_bit_cast(v4i_t, X[0]), __builtin_bit_cast(v4i_t, X[1]), 0, 1, 2, 3, 4, 5, 6, 7)
#define PG8_MMA(ai, bj, At, Bt) do { __builtin_amdgcn_s_setprio(1); _Pragma("unroll") for (int m = 0; m < 4; ++m) _Pragma("unroll") for (int n = 0; n < 2; ++n) { \
        if constexpr (FP8) acc[ai][bj][m][n] = __builtin_amdgcn_mfma_scale_f32_16x16x128_f8f6f4(PG8_CAT(Bt[n]), PG8_CAT(At[m]), acc[ai][bj][m][n], 0, 0, 0, 0x7F7F7F7F, 0, 0x7F7F7F7F); \
        else { _Pragma("unroll") for (int k = 0; k < 2; ++k) acc[ai][bj][m][n] = __builtin_amdgcn_mfma_f32_16x16x32_bf16(Bt[n][k], At[m][k], acc[ai][bj][m][n], 0, 0, 0); } } \
        __builtin_amdgcn_s_setprio(0); } while (0)
#define PG8_WAIT_V(n) asm volatile("s_waitcnt vmcnt(" #n ")" ::: "memory")
#define PG8_WAIT_L(n) asm volatile("s_waitcnt lgkmcnt(" #n ")" ::: "memory")
#define PG8_BAR __builtin_amdgcn_s_barrier()
#define PG8_SCHED __builtin_amdgcn_sched_barrier(0)
#define PG8_AOFFS(dst, unit, uidx) do { _Pragma("unroll") for (int i = 0; i < 2; ++i) { int R_, C_; stage_rc(tid * 16 + i * 8192, R_, C_); _Pragma("unroll") for (int h = 0; h < 2; ++h) { \
        unsigned row; if constexpr (GATHER) row = (unsigned)rowmap[(uidx) * 256 + h * HALF + R_]; else row = (unsigned)((unit).pm * BM + h * HALF + R_); \
        dst[h][i] = row * Kb + (unsigned)C_ * 2u; } } } while (0)
    Unit cur, nxt; int ui = 0;
    if (!S.next(0, cur)) return;
    f32x4 acc[2][2][4][2];
#pragma unroll
    for (int a = 0; a < 2; ++a)
#pragma unroll
        for (int b = 0; b < 2; ++b)
#pragma unroll
            for (int m = 0; m < 4; ++m)
#pragma unroll
                for (int n = 0; n < 2; ++n) acc[a][b][m][n] = (f32x4){0.f, 0.f, 0.f, 0.f};
    bf16x8 At[4][2], B0[2][2], B1[2][2];
    unsigned vA[2][2];
    PG8_AOFFS(vA, cur, 0);
    const char* const gA = (const char*)g.A;
    const char* cB = (const char*)g.Bt + (size_t)cur.pn * tstep;
    S.a_ready(cur);
    if constexpr (SP2) {
        PG8_STAGE(PG8_SB(0, 0), cB, voffB); PG8_STAGE(PG8_SB(0, 1), cB + hstep, voffB); PG8_STAGE(PG8_SA(0, 0), gA, vA[0]); PG8_STAGE(PG8_SA(0, 1), gA, vA[1]);
        if (wr == 1) PG8_BAR;
        PG8_WAIT_V(2); PG8_BAR;
        PG8_STAGE(PG8_SB(1, 0), cB + kstep, voffB); PG8_STAGE(PG8_SA(1, 0), gA + kstep, vA[0]); PG8_STAGE(PG8_SB(1, 1), cB + hstep + kstep, voffB);
        PG8_WAIT_V(6); PG8_BAR;
    } else {
        PG8_STAGE(PG8_SB(0, 0), cB, voffB); PG8_STAGE(PG8_SA(0, 0), gA, vA[0]); PG8_STAGE(PG8_SB(0, 1), cB + hstep, voffB); PG8_STAGE(PG8_SA(0, 1), gA, vA[1]);
        if (wr == 1) PG8_BAR;
        PG8_WAIT_V(4); PG8_BAR;
        PG8_STAGE(PG8_SB(1, 0), cB + kstep, voffB); PG8_STAGE(PG8_SA(1, 0), gA + kstep, vA[0]); PG8_STAGE(PG8_SB(1, 1), cB + hstep + kstep, voffB);
        PG8_WAIT_V(6); PG8_BAR;
    }
    for (;;) {
        const bool has_next = S.next(ui + 1, nxt);
        const char* nB = has_next ? (const char*)g.Bt + (size_t)nxt.pn * tstep : cB;
        for (int t = 0; t < nt; t += 2) {
            const bool last = (t == nt - 2);
            const char* a1 = gA + (size_t)(t + 1) * kstep;
            const char* a2 = last ? gA : gA + (size_t)(t + 2) * kstep; const char* b2 = last ? nB : cB + (size_t)(t + 2) * kstep;
            const char* a3 = a2 + kstep; const char* b3 = b2 + kstep;
            if (last && has_next) S.a_ready(nxt);
            if constexpr (SP2) {
            PG8_LDB(B0, 0, 0); PG8_LDB(B1, 0, 1); PG8_SCHED; PG8_LDA(At, 0, 0); PG8_STAGE(PG8_SA(1, 1), a1, vA[1]);
            if (last && has_next) { PG8_AOFFS(vA, nxt, ui + 1); }
            PG8_WAIT_V(8); PG8_WAIT_L(0); PG8_BAR; PG8_MMA(0, 0, At, B0); PG8_MMA(0, 1, At, B1); PG8_BAR; PG8_SCHED;
            PG8_LDA(At, 0, 1); PG8_STAGE(PG8_SB(0, 0), b2, voffB); PG8_STAGE(PG8_SB(0, 1), b2 + hstep, voffB); PG8_STAGE(PG8_SA(0, 0), a2, vA[0]);
            PG8_WAIT_V(8); PG8_WAIT_L(0); PG8_BAR; PG8_MMA(1, 0, At, B0); PG8_MMA(1, 1, At, B1); PG8_BAR; PG8_SCHED;
            PG8_LDB(B0, 1, 0); PG8_LDB(B1, 1, 1); PG8_SCHED; PG8_LDA(At, 1, 0); PG8_STAGE(PG8_SA(0, 1), a2, vA[1]);
            PG8_WAIT_V(8); PG8_WAIT_L(0); PG8_BAR; PG8_MMA(0, 0, At, B0); PG8_MMA(0, 1, At, B1); PG8_BAR; PG8_SCHED;
            PG8_LDA(At, 1, 1); PG8_STAGE(PG8_SB(1, 0), b3, voffB); PG8_STAGE(PG8_SB(1, 1), b3 + hstep, voffB); PG8_STAGE(PG8_SA(1, 0), a3, vA[0]);
            PG8_WAIT_V(8); PG8_WAIT_L(0); PG8_BAR; PG8_MMA(1, 0, At, B0); PG8_MMA(1, 1, At, B1); PG8_BAR; PG8_SCHED;
            } else {
            PG8_LDB(B0, 0, 0); PG8_SCHED; PG8_LDA(At, 0, 0); PG8_STAGE(PG8_SA(1, 1), a1, vA[1]);
            if (last && has_next) { PG8_AOFFS(vA, nxt, ui + 1); }
            PG8_WAIT_L(8); PG8_BAR; PG8_WAIT_L(0); PG8_MMA(0, 0, At, B0); PG8_BAR; PG8_SCHED;
            PG8_LDB(B1, 0, 1); PG8_STAGE(PG8_SB(0, 0), b2, voffB);
            PG8_BAR; PG8_WAIT_L(0); PG8_MMA(0, 1, At, B1); PG8_BAR;
            PG8_LDA(At, 0, 1); PG8_STAGE(PG8_SA(0, 0), a2, vA[0]);
            PG8_BAR; PG8_WAIT_L(0); PG8_MMA(1, 0, At, B0); PG8_BAR; PG8_SCHED;
            PG8_STAGE(PG8_SB(0, 1), b2 + hstep, voffB);
            PG8_WAIT_V(6); PG8_BAR; PG8_MMA(1, 1, At, B1); PG8_BAR;
            PG8_LDB(B0, 1, 0); PG8_SCHED; PG8_LDA(At, 1, 0); PG8_STAGE(PG8_SA(0, 1), a2, vA[1]);
            PG8_WAIT_L(8); PG8_BAR; PG8_WAIT_L(0); PG8_MMA(0, 0, At, B0); PG8_BAR; PG8_SCHED;
            PG8_LDB(B1, 1, 1); PG8_STAGE(PG8_SB(1, 0), b3, voffB);
            PG8_BAR; PG8_WAIT_L(0); PG8_MMA(0, 1, At, B1); PG8_BAR;
            PG8_LDA(At, 1, 1); PG8_STAGE(PG8_SA(1, 0), a3, vA[0]);
            PG8_BAR; PG8_WAIT_L(0); PG8_MMA(1, 0, At, B0); PG8_BAR; PG8_SCHED;
            PG8_STAGE(PG8_SB(1, 1), b3 + hstep, voffB);
            PG8_WAIT_V(6); PG8_BAR; PG8_MMA(1, 1, At, B1); PG8_BAR;
            }
        }
        if constexpr (ALIGN_EPI) { if (wr == 0) PG8_BAR; }
        if constexpr (!Epi::AFTER_DRAIN) { E(acc, cur, wr, wc, fr, fq); S.done(cur); }
        if (!has_next) break;
#pragma unroll
        for (int a = 0; a < 2; ++a)
#pragma unroll
            for (int b = 0; b < 2; ++b)
#pragma unroll
                for (int m = 0; m < 4; ++m)
#pragma unroll
                    for (int n = 0; n < 2; ++n) acc[a][b][m][n] = (f32x4){0.f, 0.f, 0.f, 0.f};
        cur = nxt; cB = nB; ++ui;
        if constexpr (ALIGN_EPI) { if (wr == 1) PG8_BAR; }
    }
    PG8_WAIT_V(0);
    if constexpr (!ALIGN_EPI) { if (wr == 0) PG8_BAR; }
    PG8_BAR;
#undef PG8_SA
#undef PG8_SB
#undef PG8_STAGE
#undef PG8_LDA
#undef PG8_LDB
#undef PG8_CAT
#undef PG8_MMA
#undef PG8_WAIT_V
#undef PG8_WAIT_L
#undef PG8_BAR
#undef PG8_SCHED
#undef PG8_AOFFS
}
}

namespace att {
using bf16 = unsigned short;
using bf16x8 = __attribute__((ext_vector_type(8))) short;
using s16x4  = __attribute__((ext_vector_type(4))) short;
using f32x16 = __attribute__((ext_vector_type(16))) float;
using u32x4  = __attribute__((ext_vector_type(4))) unsigned;
constexpr int D = 128, NW = 8, QBLK = 32, KVBLK = 64;
constexpr float SCALE = 0.088388347648318440f;
constexpr float THR = 8.f;
#ifndef ATT_SDEPTH
#define ATT_SDEPTH 2
#endif
constexpr int SDEPTH = ATT_SDEPTH;
constexpr int LDZ = 3072, LDO = 2048;
constexpr int SHM_V = KVBLK * D * 2, SHM_K = KVBLK * D * 2;
constexpr int OFF_WS = 2 * SHM_V + 2 * SHM_K, OFF_TAB = OFF_WS + NW * 64 * 4, SHM_ATTN = OFF_TAB + 768 * 4;
constexpr float MASKV = -1e37f;
#define KSWZ(row, colB) ((row) * 256 + ((colB) ^ (((row) & 7) << 4)))
#define SBAR() __builtin_amdgcn_sched_barrier(0)
__device__ __forceinline__ int crow(int r, int hi) { return (r & 3) + 8 * (r >> 2) + 4 * hi; }
__device__ __forceinline__ unsigned cvtpk(float lo, float hi) { unsigned r; asm volatile("v_cvt_pk_bf16_f32 %0, %1, %2" : "=v"(r) : "v"(lo), "v"(hi)); return r; }
__device__ __forceinline__ float bf2f(unsigned short h) { return __builtin_bit_cast(float, (unsigned)h << 16); }

__device__ __forceinline__ void partialSM(f32x16& p0, f32x16& p1, float& m_reg, float& mn, float& alpha) {
  constexpr float C = SCALE * 1.4426950408889634f;
  float pmax = p0[0];
#pragma unroll
  for (int r = 1; r < 16; ++r) pmax = fmaxf(pmax, p0[r]);
#pragma unroll
  for (int r = 0; r < 16; ++r) pmax = fmaxf(pmax, p1[r]);
  { auto rr = __builtin_amdgcn_permlane32_swap(__float_as_uint(pmax), __float_as_uint(pmax), false, false);
    pmax = fmaxf(__uint_as_float(rr[0]), __uint_as_float(rr[1])); }
  if (__builtin_expect(__all(pmax - m_reg <= THR / SCALE), 1)) { mn = m_reg; alpha = 1.f; }
  else { mn = fmaxf(m_reg, pmax); alpha = __builtin_amdgcn_exp2f((m_reg - mn) * C); m_reg = mn; }
  float mnC = -mn * C;
#pragma unroll
  for (int r = 0; r < 16; ++r) p0[r] = fmaf(p0[r], C, mnC);
#pragma unroll
  for (int r = 0; r < 16; ++r) p1[r] = fmaf(p1[r], C, mnC);
#pragma unroll
  for (int r = 0; r < 16; ++r) p0[r] = __builtin_amdgcn_exp2f(p0[r]);
}
__device__ __forceinline__ void finishSM(f32x16& p0, f32x16& p1, float alpha, float& l_reg, bf16x8& pa0, bf16x8& pa1, bf16x8& pa2, bf16x8& pa3) {
#pragma unroll
  for (int r = 0; r < 16; ++r) p1[r] = __builtin_amdgcn_exp2f(p1[r]);
  float ps = 0;
#pragma unroll
  for (int r = 0; r < 16; ++r) ps += p0[r];
#pragma unroll
  for (int r = 0; r < 16; ++r) ps += p1[r];
  { auto rr = __builtin_amdgcn_permlane32_swap(__float_as_uint(ps), __float_as_uint(ps), false, false);
    ps = __uint_as_float(rr[0]) + __uint_as_float(rr[1]); }
  l_reg = l_reg * alpha + ps;
#define PK4(P, BASE, OUT) do { unsigned a0 = cvtpk(P[BASE + 0], P[BASE + 1]), a1 = cvtpk(P[BASE + 2], P[BASE + 3]);   \
    unsigned b0 = cvtpk(P[BASE + 4], P[BASE + 5]), b1 = cvtpk(P[BASE + 6], P[BASE + 7]);                              \
    auto r0 = __builtin_amdgcn_permlane32_swap(a0, b0, false, false); auto r1 = __builtin_amdgcn_permlane32_swap(a1, b1, false, false); \
    u32x4 w = {r0[0], r1[0], r0[1], r1[1]}; OUT = *reinterpret_cast<bf16x8*>(&w); } while (0)
  PK4(p0, 0, pa0); PK4(p0, 8, pa1); PK4(p1, 0, pa2); PK4(p1, 8, pa3);
#undef PK4
}
__device__ __forceinline__ void qkt(f32x16& p0, f32x16& p1, const char* Ks, const bf16x8* qr, int r32, int hi) {
  p0 = f32x16{}; p1 = f32x16{};
#pragma unroll
  for (int d0 = 0; d0 < 8; ++d0) { int cb = (d0 * 16 + hi * 8) * 2;
    bf16x8 b0 = *reinterpret_cast<const bf16x8*>(Ks + KSWZ(r32, cb));
    bf16x8 b1 = *reinterpret_cast<const bf16x8*>(Ks + KSWZ(32 + r32, cb));
    p0 = __builtin_amdgcn_mfma_f32_32x32x16_bf16(b0, qr[d0], p0, 0, 0, 0);
    p1 = __builtin_amdgcn_mfma_f32_32x32x16_bf16(b1, qr[d0], p1, 0, 0, 0); }
}
__device__ __forceinline__ int v_st(int k, int c) { const int kk = (k & ~0xC) | ((k & 4) << 1) | ((k & 8) >> 1); return ((kk >> 3) * 4 + (c >> 5)) * 512 + ((kk & 7) * 32 + (c & 31)) * 2; }
__device__ __forceinline__ int v_rd_base(int lane) { return ((lane & 3) << 3) | (((lane >> 2) & 3) << 6) | (((lane >> 4) & 1) << 5) | (((lane >> 5) & 1) << 8); }
constexpr int v_rd_off(int d0, int ks, int half) { return d0 * 512 + ks * 4096 + half * 2048; }
template <int OFF> __device__ __forceinline__ s16x4 tr_read(int vb) {
  s16x4 r; asm volatile("ds_read_b64_tr_b16 %0, %1 offset:%2" : "=&v"(r) : "v"(vb), "i"(OFF) : "memory"); return r;
}
template <int D0> __device__ __forceinline__ void pv_one(f32x16& od, int vb, bf16x8 pa0, bf16x8 pa1, bf16x8 pa2, bf16x8 pa3) {
  const s16x4 l0 = tr_read<v_rd_off(D0, 0, 0)>(vb), h0 = tr_read<v_rd_off(D0, 0, 1)>(vb), l1 = tr_read<v_rd_off(D0, 1, 0)>(vb), h1 = tr_read<v_rd_off(D0, 1, 1)>(vb);
  const s16x4 l2 = tr_read<v_rd_off(D0, 2, 0)>(vb), h2 = tr_read<v_rd_off(D0, 2, 1)>(vb), l3 = tr_read<v_rd_off(D0, 3, 0)>(vb), h3 = tr_read<v_rd_off(D0, 3, 1)>(vb);
  asm volatile("s_waitcnt lgkmcnt(0)" ::: "memory"); SBAR();
#define PK(L, H) (bf16x8){L[0], L[1], L[2], L[3], H[0], H[1], H[2], H[3]}
  od = __builtin_amdgcn_mfma_f32_32x32x16_bf16(pa0, PK(l0, h0), od, 0, 0, 0);
  od = __builtin_amdgcn_mfma_f32_32x32x16_bf16(pa1, PK(l1, h1), od, 0, 0, 0);
  od = __builtin_amdgcn_mfma_f32_32x32x16_bf16(pa2, PK(l2, h2), od, 0, 0, 0);
  od = __builtin_amdgcn_mfma_f32_32x32x16_bf16(pa3, PK(l3, h3), od, 0, 0, 0);
#undef PK
}
__device__ __forceinline__ void pv_d0(f32x16* o, int vb, bf16x8 pa0, bf16x8 pa1, bf16x8 pa2, bf16x8 pa3) {
  pv_one<0>(o[0], vb, pa0, pa1, pa2, pa3); pv_one<1>(o[1], vb, pa0, pa1, pa2, pa3); pv_one<2>(o[2], vb, pa0, pa1, pa2, pa3); pv_one<3>(o[3], vb, pa0, pa1, pa2, pa3);
}
__device__ __forceinline__ int t5_bucket(int rel) {
  const int n = rel < 0 ? -rel : rel;
  const int large = 8 + (n >= 12) + (n >= 16) + (n >= 23) + (n >= 32) + (n >= 46) + (n >= 64) + (n >= 91);
  return (rel > 0 ? 16 : 0) + (n < 8 ? n : large);
}
__device__ __forceinline__ float rope_inv(int i) { return __builtin_amdgcn_exp2f((float)i * (-13.287712379549449f / 32.f)); }
__device__ __forceinline__ void sincos_rev(float ang, float& s, float& c) {
  float rev = ang * 0.15915494309189535f; rev = rev - __builtin_rintf(rev);
  s = __builtin_amdgcn_sinf(rev); c = __builtin_amdgcn_cosf(rev);
}

template <bool WIN>
__device__ __forceinline__ void attn_unit(const bf16* __restrict__ Zq, const bf16* __restrict__ Kh, const bf16* __restrict__ Vh, bf16* __restrict__ Ob, int NT,
                                          int relk0, float sinkv, const float* __restrict__ relb, char* lds) {
  int tid_ = threadIdx.x; asm volatile("" : "+v"(tid_));
  const int tid = tid_ & 511, wid = tid >> 6, lane = tid & 63, r32 = lane & 31, hi = lane >> 5;
  char* V_lds = lds; char* K_lds = lds + 2 * SHM_V;
  float* ws = (float*)(lds + OFF_WS) + wid * 64; float* li_l = ws; float* al_l = ws + 32;
  float* tab = (float*)(lds + OFF_TAB);
  __syncthreads();
  if constexpr (WIN) {
    for (int i = tid; i < 768; i += 512) { const int rel = i - 384; const int n = rel < 0 ? -rel : rel;
      tab[i] = (n <= 128) ? relb[t5_bucket(rel) * 8] * (1.0f / SCALE) : MASKV; }
  }
  float m_reg = -1e30f, l_reg = 0; f32x16 o[4] = {}; bf16x8 qr[8];
  {
    const bf16* Qw = Zq + (long)(wid * QBLK + r32) * LDZ + hi * 8;
#pragma unroll
    for (int d0 = 0; d0 < 8; ++d0) qr[d0] = *reinterpret_cast<const bf16x8*>(Qw + d0 * 16);
  }
  const int sr = tid >> 4, sc = (tid & 15) * 8, vst0 = v_st(sr, sc), vst1 = v_st(32 + sr, sc);
  const int vb0 = (int)(uintptr_t)V_lds + v_rd_base(lane);
  struct { bf16x8 vs0, vs1, ks0, ks1; } sr_[SDEPTH];
#define LD8(p) (*reinterpret_cast<const bf16x8*>(p))
#define SLOAD(i, k0) do { sr_[i].vs0 = LD8(&Vh[(long)((k0) + sr) * LDZ + sc]); sr_[i].vs1 = LD8(&Vh[(long)((k0) + 32 + sr) * LDZ + sc]); \
    sr_[i].ks0 = LD8(&Kh[(long)((k0) + sr) * LDZ + sc]); sr_[i].ks1 = LD8(&Kh[(long)((k0) + 32 + sr) * LDZ + sc]); } while (0)
#define SWRITE(b, i) do { *(bf16x8*)(V_lds + (b) * SHM_V + vst0) = sr_[i].vs0;          \
    *(bf16x8*)(V_lds + (b) * SHM_V + vst1) = sr_[i].vs1; int kc = sc * 2;               \
    *(bf16x8*)(K_lds + (b) * SHM_K + KSWZ(sr, kc)) = sr_[i].ks0;                       \
    *(bf16x8*)(K_lds + (b) * SHM_K + KSWZ(32 + sr, kc)) = sr_[i].ks1; } while (0)
#define SWAIT() do { if constexpr (SDEPTH == 2) asm volatile("s_waitcnt vmcnt(4)" ::: "memory"); else asm volatile("s_waitcnt vmcnt(0)" ::: "memory"); } while (0)
#define RESC(a) do { if (__any((a) < 1.f)) { if (hi == 0) al_l[r32] = (a); asm volatile("s_waitcnt lgkmcnt(0)" ::: "memory"); \
    _Pragma("unroll") for (int d = 0; d < 4; ++d) _Pragma("unroll") for (int r = 0; r < 16; ++r) o[d][r] *= al_l[crow(r, hi)]; } } while (0)
#define BIAS(P0, P1, t) do { if constexpr (WIN) { const float* tp = tab + (384 + relk0 + 64 * (t) - (wid * QBLK + r32) + 4 * hi); \
    _Pragma("unroll") for (int r = 0; r < 16; ++r) { P0[r] += tp[(r & 3) + 8 * (r >> 2)]; P1[r] += tp[32 + (r & 3) + 8 * (r >> 2)]; } } } while (0)
  f32x16 pA0, pA1, pB0, pB1; float mnA, mnB, alA, alB; bf16x8 pa0, pa1, pa2, pa3;
  constexpr int SE = 0, SO = SDEPTH - 1;
  SLOAD(SE, 0); asm volatile("s_waitcnt vmcnt(0)" ::: "memory"); SWRITE(0, SE); __syncthreads();
  qkt(pA0, pA1, K_lds, qr, r32, hi); BIAS(pA0, pA1, 0); partialSM(pA0, pA1, m_reg, mnA, alA);
  SLOAD(SO, KVBLK); if constexpr (SDEPTH == 2) { if (2 < NT) SLOAD(SE, 2 * KVBLK); }
  SWAIT(); SWRITE(1, SO); __syncthreads();
  for (int j = 1; j + 1 < NT; j += 2) {
    SBAR(); qkt(pB0, pB1, K_lds + SHM_K, qr, r32, hi);
    finishSM(pA0, pA1, alA, l_reg, pa0, pa1, pa2, pa3); SBAR();
    SLOAD(SO, (j + SDEPTH) * KVBLK); SBAR();
    pv_d0(o, vb0, pa0, pa1, pa2, pa3); BIAS(pB0, pB1, j); partialSM(pB0, pB1, m_reg, mnB, alB);
    __syncthreads(); SWAIT(); SWRITE(0, SE);
    RESC(alB); __syncthreads();
    SBAR(); qkt(pA0, pA1, K_lds, qr, r32, hi);
    finishSM(pB0, pB1, alB, l_reg, pa0, pa1, pa2, pa3); SBAR();
    if (SDEPTH == 1 || j + 3 < NT) SLOAD(SE, (j + 1 + SDEPTH) * KVBLK); SBAR();
    pv_d0(o, vb0 + SHM_V, pa0, pa1, pa2, pa3); BIAS(pA0, pA1, j + 1); partialSM(pA0, pA1, m_reg, mnA, alA);
    __syncthreads(); SWAIT(); SWRITE(1, SO);
    RESC(alA); __syncthreads();
  }
  SBAR(); qkt(pB0, pB1, K_lds + SHM_K, qr, r32, hi);
  finishSM(pA0, pA1, alA, l_reg, pa0, pa1, pa2, pa3); SBAR();
  pv_d0(o, vb0, pa0, pa1, pa2, pa3); BIAS(pB0, pB1, NT - 1); partialSM(pB0, pB1, m_reg, mnB, alB);
  __syncthreads(); RESC(alB);
  finishSM(pB0, pB1, alB, l_reg, pa0, pa1, pa2, pa3); SBAR();
  pv_d0(o, vb0 + SHM_V, pa0, pa1, pa2, pa3);
  if constexpr (WIN) { constexpr float C = SCALE * 1.4426950408889634f; l_reg += __builtin_amdgcn_exp2f(fminf(sinkv * 1.4426950408889634f - m_reg * C, 120.f)); }
  if (hi == 0) li_l[r32] = l_reg; asm volatile("s_waitcnt lgkmcnt(0)" ::: "memory");
  float rli[16];
#pragma unroll
  for (int r = 0; r < 16; ++r) rli[r] = __builtin_amdgcn_rcpf(li_l[crow(r, hi)]);
  bf16* Ow = Ob + (long)(wid * QBLK) * LDO;
  const int odd = lane & 1;
#pragma unroll
  for (int r = 0; r < 16; r += 2) { const int orow = crow(r, hi) + odd;
#pragma unroll
    for (int d0 = 0; d0 < 4; ++d0) { const float v0 = o[d0][r] * rli[r], v1 = o[d0][r + 1] * rli[r + 1];
      const float snd = odd ? v0 : v1;
      const float rcv = __builtin_bit_cast(float, __builtin_amdgcn_update_dpp(0, __builtin_bit_cast(int, snd), 0xB1, 0xF, 0xF, true));
      const unsigned w = odd ? cvtpk(rcv, v1) : cvtpk(v0, rcv);
      *(unsigned*)(Ow + (long)orow * LDO + d0 * 32 + (r32 & ~1)) = w; } }
#undef LD8
#undef SLOAD
#undef SWRITE
#undef SWAIT
#undef RESC
#undef BIAS
}
#undef KSWZ
}

constexpr int NWAVES = 8;
constexpr int NB = 4, SEQ = 4096, DM = 2048, M = NB * SEQ, DIN = 3072, NE = 16, CAP = 512, DE = 2048, RE = NE * NB * CAP;
constexpr int N_PHASES = 10;
constexpr float WSCALE = 256.f, WSCALE_INV = 1.f / 256.f;
constexpr size_t MiB = 1u << 20;
constexpr size_t WS_CTL = 0, CTL_ZERO_BYTES = 64 * 1024;
constexpr size_t WS_MOD = 256 * 1024;
constexpr size_t WS_WIN = 2 * MiB, WS_WOUT = 14 * MiB;
constexpr size_t WS_WGU = 24 * MiB, WS_WDN = 152 * MiB;
constexpr size_t WS_H = 216 * MiB;
constexpr size_t WS_Z = 280 * MiB, WS_O = 376 * MiB;
constexpr size_t WS_ACT = 440 * MiB;
constexpr size_t WS_Y = 280 * MiB;
constexpr size_t WS_AFF = 504 * MiB, WS_IDX = 505 * MiB, WS_GVR = 505 * MiB + 128 * 1024, WS_RMAP = 505 * MiB + 256 * 1024, WS_INV = 506 * MiB, WS_PART = 507 * MiB, WS_QKW = 513 * MiB + 512 * 1024, WS_END = 514 * MiB;
constexpr int CW_BAR = 4096;
constexpr int CW_GEMV = 8192;
constexpr int RING_OFF = 0, RING_BYTES = 131072;
constexpr int LDSCTL_OFF = RING_BYTES, MISC_OFF = LDSCTL_OFF + 320, RMAP_OFF = LDSCTL_OFF + 1024;
constexpr int LDS_BYTES = 147456;

#define GAS __attribute__((address_space(1)))
#define LAS __attribute__((address_space(3)))
typedef unsigned short bf16;
typedef unsigned v4u __attribute__((ext_vector_type(4)));
typedef unsigned v2u __attribute__((ext_vector_type(2)));
typedef float f32x4 __attribute__((ext_vector_type(4)));
typedef float f32x2 __attribute__((ext_vector_type(2)));
typedef GAS unsigned gu32;
#define RLX_AGENT __ATOMIC_RELAXED, __HIP_MEMORY_SCOPE_AGENT
#define LDS_WAIT() asm volatile("s_waitcnt lgkmcnt(0)" ::: "memory")
#define VM_WAIT() asm volatile("s_waitcnt vmcnt(0)" ::: "memory")
__device__ __forceinline__ unsigned f2bf(float f) { unsigned u = __builtin_bit_cast(unsigned, f); return (u + 0x7fffu + ((u >> 16) & 1u)) >> 16; }
__device__ __forceinline__ unsigned pk2(float lo, float hi) { return f2bf(lo) | (f2bf(hi) << 16); }
__device__ __forceinline__ float bf_lo(unsigned w) { return __builtin_bit_cast(float, w << 16); }
__device__ __forceinline__ float bf_hi(unsigned w) { return __builtin_bit_cast(float, w & 0xffff0000u); }

__device__ __forceinline__ unsigned pk4_fp8(float a, float b, float c, float d) {
    int v = __builtin_amdgcn_cvt_pk_fp8_f32(a, b, 0, false); v = __builtin_amdgcn_cvt_pk_fp8_f32(c, d, v, true); return (unsigned)v; }
#define XB_TMO      128
#define XB_XCNT(j)  (256  + 64 * (j))
#define XB_XSUB(j)  (1280 + 64 * (j))
#define XB_XGEN(j)  (2304 + 64 * (j))
#define XB_TOP      3328
#define XB_TOPGEN   3392
#define XCD_BAR_WORDS 3456
#define XB_SPIN_CAP (1u << 18)
__device__ __forceinline__ unsigned xb_ld(unsigned* p)              { return __hip_atomic_load(p, __ATOMIC_RELAXED, __HIP_MEMORY_SCOPE_AGENT); }
__device__ __forceinline__ unsigned xb_add(unsigned* p, unsigned v) { return __hip_atomic_fetch_add(p, v, __ATOMIC_RELAXED, __HIP_MEMORY_SCOPE_AGENT); }
__device__ __forceinline__ unsigned xb_xcc_id() { return (unsigned)__builtin_amdgcn_s_getreg((3 << 11) | 20) & 0xFu; }
#define XB_SPIN(cond, bar) do { unsigned _sp = 0; while (cond) { __builtin_amdgcn_s_sleep(1); \
    if ((++_sp & 255u) == 0u) { if (xb_ld(&(bar)[XB_TMO])) break; if (_sp > XB_SPIN_CAP) { atomicAdd(&(bar)[XB_TMO], 1u); break; } } } } while (0)
struct XcdBarrier { unsigned* bar; unsigned x; volatile LAS unsigned* st; };
__device__ __forceinline__ XcdBarrier xcd_barrier_post(unsigned* bar, volatile LAS unsigned* st) {
    XcdBarrier b; b.bar = bar; b.x = xb_xcc_id(); b.st = st;
    if (threadIdx.x == 0) (void)xb_add(&bar[XB_XCNT(b.x)], 1u);
    return b;
}
__device__ __forceinline__ void xcd_barrier_complete(unsigned* bar, unsigned x, unsigned& nloc, unsigned& nx, volatile LAS unsigned* bst) {
    const unsigned G = bst[2];
    unsigned sum, cnt, mine, sp = 0u;
    for (;;) {
        sum = 0u; cnt = 0u; mine = 0u;
#pragma unroll
        for (unsigned j = 0; j < 16; ++j) { const unsigned c = xb_ld(&bar[XB_XCNT(j)]); sum += c; cnt += (c > 0u) ? 1u : 0u; mine = (j == x) ? c : mine; }
        if (sum == G) break;
        __builtin_amdgcn_s_sleep(1);
        if ((++sp & 255u) == 0u) { if (xb_ld(&bar[XB_TMO])) break; if (sp > XB_SPIN_CAP) { atomicAdd(&bar[XB_TMO], 1u); break; } }
    }
    nloc = mine > 0u ? mine : 1u; nx = cnt > 0u ? cnt : 1u;
}
__device__ __forceinline__ void xcd_barrier(const XcdBarrier& b) {
    asm volatile("s_waitcnt vmcnt(0)" ::: "memory");
    __syncthreads();
    int tid0_ = threadIdx.x; asm volatile("" : "+v"(tid0_));
    if (tid0_ == 0) {
        unsigned* bar = b.bar;
        __builtin_amdgcn_s_waitcnt(0);
        unsigned nloc = b.st[0], nx = b.st[1];
        if (nloc == 0u) { xcd_barrier_complete(bar, b.x, nloc, nx, b.st); b.st[0] = nloc; b.st[1] = nx; }
        const unsigned old = xb_add(&bar[XB_XSUB(b.x)], 1u);
        const unsigned gen = old / nloc;
        if (old + 1u == (gen + 1u) * nloc) {
            __builtin_amdgcn_fence(__ATOMIC_RELEASE, "agent");
            asm volatile("s_waitcnt vmcnt(0)" ::: "memory");
            const unsigned og = xb_add(&bar[XB_TOP], 1u);
            const unsigned tg = og / nx;
            if (og + 1u == (tg + 1u) * nx) xb_add(&bar[XB_TOPGEN], 1u);
            else XB_SPIN(xb_ld(&bar[XB_TOPGEN]) == tg, bar);
            __builtin_amdgcn_fence(__ATOMIC_ACQUIRE, "agent");
            xb_add(&bar[XB_XGEN(b.x)], 1u);
            asm volatile("s_waitcnt vmcnt(0)" ::: "memory");
        } else {
            XB_SPIN(xb_ld(&bar[XB_XGEN(b.x)]) == gen, bar);
            __builtin_amdgcn_fence(__ATOMIC_ACQUIRE, "agent");
            asm volatile("s_waitcnt vmcnt(0)" ::: "memory");
        }
    }
    __syncthreads();
}

struct Frame {
    LAS unsigned char* lds;
    volatile LAS unsigned* MISC;
    int tid, lane, wave, vcu, G;
};
__device__ __forceinline__ float wave_sum(float v) {
    v += __builtin_bit_cast(float, __builtin_amdgcn_update_dpp(0, __builtin_bit_cast(int, v), 0xB1, 0xF, 0xF, true));
    v += __builtin_bit_cast(float, __builtin_amdgcn_update_dpp(0, __builtin_bit_cast(int, v), 0x4E, 0xF, 0xF, true));
    v += __builtin_bit_cast(float, __builtin_amdgcn_update_dpp(0, __builtin_bit_cast(int, v), 0x141, 0xF, 0xF, true));
    v += __builtin_bit_cast(float, __builtin_amdgcn_update_dpp(0, __builtin_bit_cast(int, v), 0x140, 0xF, 0xF, true));
    { auto r = __builtin_amdgcn_permlane16_swap(__float_as_uint(v), __float_as_uint(v), false, false); v = __uint_as_float(r[0]) + __uint_as_float(r[1]); }
    { auto r = __builtin_amdgcn_permlane32_swap(__float_as_uint(v), __float_as_uint(v), false, false); v = __uint_as_float(r[0]) + __uint_as_float(r[1]); }
    return v;
}
__device__ __forceinline__ float wave_max(float v) {
#pragma unroll
    for (int o = 1; o < 64; o <<= 1) v = fmaxf(v, __shfl_xor(v, o));
    return v;
}
#ifndef CVT_ITEM128
#define CVT_ITEM128 1
#endif
template <int MODE>
__device__ __forceinline__ void convert_weights(const float* __restrict__ wa, const float* __restrict__ wb, const float* __restrict__ wc, unsigned char* da, unsigned char* db,
                                                LAS float* scr, int gw, int NGW, int lane) {
    constexpr bool EXPERTS = (MODE == 2);
    constexpr int NBW = (MODE == 0) ? 96 : 64;
    constexpr int I_M = 16 * NBW;
    constexpr int NITEMS = EXPERTS ? 48 * I_M : I_M;
    constexpr int NN = (MODE == 0) ? 3072 : 2048;
    constexpr int ES = EXPERTS ? 1 : 2, KB = 2048 * ES;
    const int nitems = (gw < NITEMS) ? ((NITEMS - 1 - gw) / NGW + 1) : 0;
    const float* nsrc = nullptr; unsigned char* dst = nullptr; unsigned char* ndst = nullptr;
#define CVT_DECODE(itx, SRC, DST) do { const int r = gw + (itx) * NGW; \
        if constexpr (!EXPERTS) { const int kb = r / NBW, nb = r % NBW, k0 = 128 * kb, n0 = 32 * nb; SRC = wa + (size_t)k0 * NN + n0; DST = da + ((size_t)n0 * 2048 + k0) * 2; } \
        else { const int mat = r / I_M, q = r % I_M, kb = q / NBW, nb = q % NBW, n0 = 32 * nb, k0 = 128 * kb; \
            if (mat < 16)      { SRC = wa + (size_t)mat * 2048 * 2048 + (size_t)k0 * 2048 + n0;        DST = da + (size_t)mat * 4096 * 2048 + (size_t)((n0 >> 7) * 256 + (n0 & 127)) * 2048 + k0; } \
            else if (mat < 32) { SRC = wb + (size_t)(mat - 16) * 2048 * 2048 + (size_t)k0 * 2048 + n0; DST = da + (size_t)(mat - 16) * 4096 * 2048 + (size_t)((n0 >> 7) * 256 + 128 + (n0 & 127)) * 2048 + k0; } \
            else               { SRC = wc + (size_t)(mat - 32) * 2048 * 2048 + (size_t)k0 * 2048 + n0; DST = db + (size_t)(mat - 32) * 2048 * 2048 + (size_t)n0 * 2048 + k0; } } } while (0)
    const unsigned voff = (unsigned)((lane >> 3) * NN + 4 * (lane & 7)) * 4u;
#define CVT_LOAD(V, SRC, HF) do { _Pragma("unroll") for (int i = 0; i < 8; ++i) { const float* b_ = (SRC) + (size_t)((HF) * 64 + 8 * i) * NN; \
            asm volatile("s_nop 4\n\tglobal_load_dwordx4 %0, %1, %2 nt" : "=v"(V[i]) : "v"(voff), "s"(b_) : "memory"); } } while (0)
#define CVT_WAIT(V, N) asm volatile("s_waitcnt vmcnt(" #N ")" : "+v"(V[0]), "+v"(V[1]), "+v"(V[2]), "+v"(V[3]), "+v"(V[4]), "+v"(V[5]), "+v"(V[6]), "+v"(V[7]) :: "memory")
#define CVT_HALF(V, HF) do { CVT_WAIT(V, 16); \
        if constexpr (EXPERTS) { LAS unsigned* s8_ = (LAS unsigned*)scr; \
            _Pragma("unroll") for (int i = 0; i < 8; ++i) { const f32x4 t_ = V[i] * WSCALE; s8_[72 * i + lane] = pk4_fp8(t_.x, t_.y, t_.z, t_.w); } \
            CVT_LOAD(V, nsrc, HF); \
            LDS_WAIT(); asm volatile("" ::: "memory"); \
            const int c = lane & 7, nq = lane >> 3; const LAS unsigned* r8_ = s8_ + 72 * c + nq; unsigned D_[8]; \
            _Pragma("unroll") for (int i = 0; i < 8; ++i) D_[i] = r8_[8 * i]; \
            unsigned T_[2][4]; \
            _Pragma("unroll") for (int h = 0; h < 2; ++h) { \
                const unsigned p01l = __builtin_amdgcn_perm(D_[4 * h + 1], D_[4 * h + 0], 0x05010400u), p01h = __builtin_amdgcn_perm(D_[4 * h + 1], D_[4 * h + 0], 0x07030602u); \
                const unsigned p23l = __builtin_amdgcn_perm(D_[4 * h + 3], D_[4 * h + 2], 0x05010400u), p23h = __builtin_amdgcn_perm(D_[4 * h + 3], D_[4 * h + 2], 0x07030602u); \
                T_[h][0] = __builtin_amdgcn_perm(p23l, p01l, 0x05040100u); T_[h][1] = __builtin_amdgcn_perm(p23l, p01l, 0x07060302u); \
                T_[h][2] = __builtin_amdgcn_perm(p23h, p01h, 0x05040100u); T_[h][3] = __builtin_amdgcn_perm(p23h, p01h, 0x07060302u); } \
            _Pragma("unroll") for (int s_ = 0; s_ < 4; ++s_) { v2u o; o.x = T_[0][s_]; o.y = T_[1][s_]; \
                __builtin_nontemporal_store(o, (GAS v2u*)(dst + (size_t)(4 * nq + s_) * KB + (HF) * 64 + 8 * c)); } \
            LDS_WAIT(); asm volatile("" ::: "memory"); \
        } else { \
        _Pragma("unroll") for (int i = 0; i < 8; ++i) { LAS float* w_ = scr + (8 * i + (lane >> 3)) * 33 + 4 * (lane & 7); const f32x4 t_ = V[i]; \
            w_[0] = t_.x; w_[1] = t_.y; w_[2] = t_.z; w_[3] = t_.w; } \
        CVT_LOAD(V, nsrc, HF); \
        LDS_WAIT(); asm volatile("" ::: "memory"); \
        const int c = lane & 7; \
        _Pragma("unroll") for (int j = 0; j < 4; ++j) { const int n = (lane >> 3) + 8 * j; const LAS float* sp = scr + (8 * c) * 33 + n; \
            v4u o; o.x = pk2(sp[0 * 33], sp[1 * 33]); o.y = pk2(sp[2 * 33], sp[3 * 33]); o.z = pk2(sp[4 * 33], sp[5 * 33]); o.w = pk2(sp[6 * 33], sp[7 * 33]); \
            *(GAS v4u*)(dst + (size_t)n * KB + (HF) * 128 + 16 * c) = o; } \
        LDS_WAIT(); asm volatile("" ::: "memory"); } } while (0)
    f32x4 va[8], vb[8];
    if (nitems > 0) {
        const int lastit = nitems - 1;
        { const float* s_; CVT_DECODE(0, s_, dst); CVT_LOAD(va, s_, 0); CVT_LOAD(vb, s_, 1); }
        CVT_WAIT(va, 0); CVT_WAIT(vb, 0);
        for (int it = 0; it < nitems; ++it) {
            const int nx = it + 1 < lastit ? it + 1 : lastit;
            CVT_DECODE(nx, nsrc, ndst);
            if constexpr (EXPERTS && CVT_ITEM128) {
                CVT_WAIT(va, 4); CVT_WAIT(vb, 4);
                LAS unsigned* s8_ = (LAS unsigned*)scr;
#pragma unroll
                for (int i = 0; i < 8; ++i) { const f32x4 t_ = va[i] * WSCALE; s8_[68 * i + lane] = pk4_fp8(t_.x, t_.y, t_.z, t_.w); }
#pragma unroll
                for (int i = 0; i < 8; ++i) { const f32x4 t_ = vb[i] * WSCALE; s8_[68 * (8 + i) + lane] = pk4_fp8(t_.x, t_.y, t_.z, t_.w); }
                CVT_LOAD(va, nsrc, 0); CVT_LOAD(vb, nsrc, 1);
                LDS_WAIT(); asm volatile("" ::: "memory");
                const int c = lane & 7, nq = lane >> 3; const LAS unsigned* r8_ = s8_ + 136 * c + nq; unsigned D_[16];
#pragma unroll
                for (int t = 0; t < 16; ++t) D_[t] = r8_[68 * (t >> 3) + 8 * (t & 7)];
                unsigned T_[4][4];
#pragma unroll
                for (int h = 0; h < 4; ++h) {
                    const unsigned p01l = __builtin_amdgcn_perm(D_[4 * h + 1], D_[4 * h + 0], 0x05010400u), p01h = __builtin_amdgcn_perm(D_[4 * h + 1], D_[4 * h + 0], 0x07030602u);
                    const unsigned p23l = __builtin_amdgcn_perm(D_[4 * h + 3], D_[4 * h + 2], 0x05010400u), p23h = __builtin_amdgcn_perm(D_[4 * h + 3], D_[4 * h + 2], 0x07030602u);
                    T_[h][0] = __builtin_amdgcn_perm(p23l, p01l, 0x05040100u); T_[h][1] = __builtin_amdgcn_perm(p23l, p01l, 0x07060302u);
                    T_[h][2] = __builtin_amdgcn_perm(p23h, p01h, 0x05040100u); T_[h][3] = __builtin_amdgcn_perm(p23h, p01h, 0x07060302u); }
#pragma unroll
                for (int s_ = 0; s_ < 4; ++s_) { v4u o; o.x = T_[0][s_]; o.y = T_[1][s_]; o.z = T_[2][s_]; o.w = T_[3][s_];
                    __builtin_nontemporal_store(o, (GAS v4u*)(dst + (size_t)(4 * nq + s_) * KB + 16 * c)); }
                LDS_WAIT(); asm volatile("" ::: "memory");
            } else {
            CVT_HALF(va, 0);
            CVT_HALF(vb, 1);
            }
            dst = ndst;
        }
        CVT_WAIT(va, 0); CVT_WAIT(vb, 0);
    }
#undef CVT_WAIT
#undef CVT_DECODE
#undef CVT_LOAD
#undef CVT_HALF
}

__device__ __forceinline__ void convert_experts64(const float* __restrict__ wa, const float* __restrict__ wb, const float* __restrict__ wc, unsigned char* da, unsigned char* db,
                                                  LAS float* scr, int gw, int NGW, int lane, int busy) {
    constexpr int NBW = 32, I_M = 16 * NBW, NITEMS = 48 * I_M, NN = 2048, KB = 2048;
    const bool rebal = (busy > 0) && (busy * 2 == NGW) && (NITEMS % NGW == 0) && (NITEMS / NGW >= 2);
    const int per = NITEMS / NGW;
    const int nitems = rebal ? (gw < busy ? per - 1 : per + 1) : ((gw < NITEMS) ? ((NITEMS - 1 - gw) / NGW + 1) : 0);
    const float* nsrc = nullptr; unsigned char* dst = nullptr; unsigned char* ndst = nullptr;
#define CX_DECODE(itx, SRC, DST) do { const int r = (rebal && (itx) == per) ? (gw - busy) + (per - 1) * NGW : gw + (itx) * NGW; const int mat = r / I_M, q = r % I_M, kb = q / NBW, nb = q % NBW, n0 = 64 * nb, k0 = 128 * kb; \
        if (mat < 16)      { SRC = wa + (size_t)mat * 2048 * 2048 + (size_t)k0 * 2048 + n0;        DST = da + (size_t)mat * 4096 * 2048 + (size_t)((n0 >> 7) * 256 + (n0 & 127)) * 2048 + k0; } \
        else if (mat < 32) { SRC = wb + (size_t)(mat - 16) * 2048 * 2048 + (size_t)k0 * 2048 + n0; DST = da + (size_t)(mat - 16) * 4096 * 2048 + (size_t)((n0 >> 7) * 256 + 128 + (n0 & 127)) * 2048 + k0; } \
        else               { SRC = wc + (size_t)(mat - 32) * 2048 * 2048 + (size_t)k0 * 2048 + n0; DST = db + (size_t)(mat - 32) * 2048 * 2048 + (size_t)n0 * 2048 + k0; } } while (0)
    const unsigned voff = (unsigned)((lane >> 4) * NN + 4 * (lane & 15)) * 4u;
#define CX_LOAD(V, SRC, HF) do { _Pragma("unroll") for (int i = 0; i < 16; ++i) { const float* b_ = (SRC) + (size_t)((HF) * 64 + 4 * i) * NN; \
            asm volatile("s_nop 4\n\tglobal_load_dwordx4 %0, %1, %2 nt" : "=v"(V[i]) : "v"(voff), "s"(b_) : "memory"); } } while (0)
#define CX_WAIT(V, N) asm volatile("s_waitcnt vmcnt(" #N ")" : "+v"(V[0]), "+v"(V[1]), "+v"(V[2]), "+v"(V[3]), "+v"(V[4]), "+v"(V[5]), "+v"(V[6]), "+v"(V[7]), \
        "+v"(V[8]), "+v"(V[9]), "+v"(V[10]), "+v"(V[11]), "+v"(V[12]), "+v"(V[13]), "+v"(V[14]), "+v"(V[15]) :: "memory")
    f32x4 va[16], vb[16];
    if (nitems > 0) {
        const int lastit = nitems - 1;
        { const float* s_; CX_DECODE(0, s_, dst); CX_LOAD(va, s_, 0); CX_LOAD(vb, s_, 1); }
        CX_WAIT(va, 0); CX_WAIT(vb, 0);
        LAS unsigned* s8_ = (LAS unsigned*)scr;
        const int c = lane & 7, nq = lane >> 3;
        for (int it = 0; it < nitems; ++it) {
            const int nx = it + 1 < lastit ? it + 1 : lastit;
            CX_DECODE(nx, nsrc, ndst);
            CX_WAIT(va, 8); CX_WAIT(vb, 8);
#pragma unroll
            for (int i = 0; i < 16; ++i) { const f32x4 t_ = va[i] * WSCALE; s8_[66 * i + lane] = pk4_fp8(t_.x, t_.y, t_.z, t_.w); }
#pragma unroll
            for (int i = 0; i < 16; ++i) { const f32x4 t_ = vb[i] * WSCALE; s8_[66 * (16 + i) + lane] = pk4_fp8(t_.x, t_.y, t_.z, t_.w); }
            CX_LOAD(va, nsrc, 0); CX_LOAD(vb, nsrc, 1);
            LDS_WAIT(); asm volatile("" ::: "memory");
#pragma unroll
            for (int g = 0; g < 2; ++g) { const int ng = nq + 8 * g; const LAS unsigned* r8_ = s8_ + 264 * c + ng; unsigned D_[16];
#pragma unroll
                for (int t = 0; t < 16; ++t) D_[t] = r8_[66 * (t >> 2) + 16 * (t & 3)];
                unsigned T_[4][4];
#pragma unroll
                for (int h = 0; h < 4; ++h) {
                    const unsigned p01l = __builtin_amdgcn_perm(D_[4 * h + 1], D_[4 * h + 0], 0x05010400u), p01h = __builtin_amdgcn_perm(D_[4 * h + 1], D_[4 * h + 0], 0x07030602u);
                    const unsigned p23l = __builtin_amdgcn_perm(D_[4 * h + 3], D_[4 * h + 2], 0x05010400u), p23h = __builtin_amdgcn_perm(D_[4 * h + 3], D_[4 * h + 2], 0x07030602u);
                    T_[h][0] = __builtin_amdgcn_perm(p23l, p01l, 0x05040100u); T_[h][1] = __builtin_amdgcn_perm(p23l, p01l, 0x07060302u);
                    T_[h][2] = __builtin_amdgcn_perm(p23h, p01h, 0x05040100u); T_[h][3] = __builtin_amdgcn_perm(p23h, p01h, 0x07060302u); }
#pragma unroll
                for (int s_ = 0; s_ < 4; ++s_) { v4u o; o.x = T_[0][s_]; o.y = T_[1][s_]; o.z = T_[2][s_]; o.w = T_[3][s_];
                    __builtin_nontemporal_store(o, (GAS v4u*)(dst + (size_t)(4 * ng + s_) * KB + 16 * c)); } }
            LDS_WAIT(); asm volatile("" ::: "memory");
            dst = ndst;
        }
        CX_WAIT(va, 0); CX_WAIT(vb, 0);
    }
#undef CX_WAIT
#undef CX_DECODE
#undef CX_LOAD
}

__device__ __forceinline__ void adaln_gemv(const float* __restrict__ cvec, const float* __restrict__ w_ada, const float* __restrict__ b_ada, float* MOD, float* PART, gu32* ctl,
                                           int cg0, int ncg, int gw, int NGW, int lane) {
    for (int it = gw; it < ncg * 32; it += NGW) {
        const int cg = cg0 + it % ncg, kc = it / ncg, k0 = kc * 64, col0 = cg * 256 + lane * 4;
        float sc[4];
#pragma unroll
        for (int b = 0; b < 4; ++b) { const float v = cvec[b * 2048 + k0 + lane]; sc[b] = v / (1.f + __expf(-v)); }
        f32x4 acc[4];
#pragma unroll
        for (int b = 0; b < 4; ++b) acc[b] = (f32x4){0.f, 0.f, 0.f, 0.f};
#pragma unroll 8
        for (int kk = 0; kk < 64; ++kk) { const f32x4 w = __builtin_nontemporal_load((const GAS f32x4*)(w_ada + (size_t)(k0 + kk) * 12288 + col0));
#pragma unroll
            for (int b = 0; b < 4; ++b) { const float s = __builtin_bit_cast(float, __builtin_amdgcn_readlane(__builtin_bit_cast(int, sc[b]), kk)); acc[b] += w * s; } }
#pragma unroll
        for (int b = 0; b < 4; ++b) {
            GAS unsigned long long* pp = (GAS unsigned long long*)(PART + ((size_t)kc * 4 + b) * 12288 + col0);
            const float ax = acc[b].x, ay = acc[b].y, az = acc[b].z, aw = acc[b].w;
            __hip_atomic_store(pp, ((unsigned long long)__float_as_uint(ay) << 32) | __float_as_uint(ax), RLX_AGENT);
            __hip_atomic_store(pp + 1, ((unsigned long long)__float_as_uint(aw) << 32) | __float_as_uint(az), RLX_AGENT); }
        VM_WAIT();
        unsigned old = 0;
        if (lane == 0) old = __hip_atomic_fetch_add((unsigned*)(ctl + CW_GEMV + cg * 64), 1u, __ATOMIC_RELAXED, __HIP_MEMORY_SCOPE_AGENT);
        old = (unsigned)__builtin_amdgcn_readfirstlane((int)old);
        if (old == 31u) {
            __builtin_amdgcn_fence(__ATOMIC_ACQUIRE, "agent");
            VM_WAIT();
            const f32x4 bb = *(const f32x4*)(b_ada + col0);
            f32x4 tot[4] = {bb, bb, bb, bb};
            for (int k2 = 0; k2 < 32; ++k2) {
#pragma unroll
                for (int b = 0; b < 4; ++b) { const f32x4 p = *(const GAS f32x4*)(PART + ((size_t)k2 * 4 + b) * 12288 + col0); tot[b] += p; } }
#pragma unroll
            for (int b = 0; b < 4; ++b) *(GAS f32x4*)(MOD + b * 12288 + col0) = tot[b];
        }
    }
}

struct Args { const float* in[18]; float* out; unsigned char* ws; int ph_lo, ph_hi; };

__global__ void __launch_bounds__(NWAVES * 64, 2) fwd_kernel(Args args) {
    extern __shared__ __attribute__((aligned(16))) unsigned char lds[];
    Frame F;
    F.lds = (LAS unsigned char*)lds;
    F.MISC = (volatile LAS unsigned*)(F.lds + MISC_OFF);
    F.tid = threadIdx.x; F.lane = F.tid & 63; F.wave = __builtin_amdgcn_readfirstlane(F.tid >> 6);
    F.G = gridDim.x; { const int bx = blockIdx.x; F.vcu = (F.G % 8 == 0) ? (bx % 8) * (F.G / 8) + bx / 8 : bx; }
#define PHASE_PTRS() const __attribute__((address_space(4))) unsigned long long* kap = (const __attribute__((address_space(4))) unsigned long long*)__builtin_amdgcn_kernarg_segment_ptr(); asm volatile("" : "+s"(kap)); \
    unsigned char* const ws = (unsigned char*)(GAS unsigned char*)kap[19]; (void)ws
#define KIN(i) ((const float*)(const GAS float*)kap[i])
#define KOUT ((float*)(GAS float*)kap[18])
#define P_MOD ((float*)(ws + WS_MOD))
#define P_WIN_T ((bf16*)(ws + WS_WIN))
#define P_WOUT_T ((bf16*)(ws + WS_WOUT))
#define P_WGU_T ((bf16*)(ws + WS_WGU))
#define P_WDN_T ((bf16*)(ws + WS_WDN))
#define P_HB ((bf16*)(ws + WS_H))
#define P_ZB ((bf16*)(ws + WS_Z))
#define P_OB ((bf16*)(ws + WS_O))
#define P_ACT ((unsigned char*)(ws + WS_ACT))
#define P_YB ((bf16*)(ws + WS_Y))
#define P_AFF ((float*)(ws + WS_AFF))
#define P_IDX ((int*)(ws + WS_IDX))
#define P_GVR ((float*)(ws + WS_GVR))
#define P_INV ((int*)(ws + WS_INV))
#define P_RMAP ((int*)(ws + WS_RMAP))
    gu32* ctl = (gu32*)(args.ws + WS_CTL);
    for (int u = F.tid; u < (LDS_BYTES - LDSCTL_OFF) / 4; u += NWAVES * 64) ((LAS unsigned*)(F.lds + LDSCTL_OFF))[u] = 0u;
    if (F.tid == 0) F.MISC[10] = (unsigned)F.G;
    __syncthreads();
    const int lo = args.ph_lo, hi = args.ph_hi;
    XcdBarrier bar; bar.bar = (unsigned*)(ctl + CW_BAR); bar.x = 0; bar.st = nullptr;
    if (hi - lo > 1) bar = xcd_barrier_post((unsigned*)(ctl + CW_BAR), F.MISC + 8);
#ifndef PH_MASK
#define PH_MASK 0x3FF
#endif
#define IN(k) (((PH_MASK >> (k)) & 1) && lo <= (k) && (k) < hi)
#define BOTH(k) (IN(k) && IN((k) + 1))
#ifndef DUP_MASK
#define DUP_MASK 0
#endif
#define REP(k) for (int rep_ = 0; rep_ < (((DUP_MASK >> (k)) & 1) ? 2 : 1); ++rep_)
#ifndef TS_A
#define TS_A (-1)
#define TS_B (-1)
#endif
#ifndef TS_F
#define TS_F 8
#endif
#define TS_SLOT(i) do { if (TS_A >= 0 && blockIdx.x == 0 && F.tid == 0) F.MISC[16 + (i)] = (unsigned)__builtin_amdgcn_s_memrealtime(); } while (0)
#define TS_MARK(k) TS_SLOT((k) + 1)
    TS_SLOT(0);
#define GRID_BAR() xcd_barrier(bar)
    const int gw = F.vcu * NWAVES + F.wave, NGW = F.G * NWAVES;

    if (IN(0)) {
        if (blockIdx.x == 0) { PHASE_PTRS(); float* qkw = (float*)(ws + WS_QKW); const int v = F.tid >> 7, j = F.tid & 127;
            qkw[F.tid] = (v == 0 ? KIN(6) : v == 1 ? KIN(7) : v == 2 ? KIN(8) : KIN(9))[j]; }
        constexpr int W_CONV = 1536;
        if (NGW >= W_CONV + 512) {
            if (gw < W_CONV) { PHASE_PTRS();
                convert_weights<0>(KIN(5), nullptr, nullptr, (unsigned char*)P_WIN_T, nullptr, (LAS float*)(F.lds + RING_OFF + F.wave * 16384), gw, W_CONV, F.lane); }
            else { PHASE_PTRS();
                adaln_gemv(KIN(1), KIN(2), KIN(3), P_MOD, (float*)(ws + WS_PART), ctl, 0, 16, gw - W_CONV, NGW - W_CONV, F.lane); }
        } else {
            { PHASE_PTRS(); adaln_gemv(KIN(1), KIN(2), KIN(3), P_MOD, (float*)(ws + WS_PART), ctl, 0, 16, gw, NGW, F.lane); }
            { PHASE_PTRS(); convert_weights<0>(KIN(5), nullptr, nullptr, (unsigned char*)P_WIN_T, nullptr, (LAS float*)(F.lds + RING_OFF + F.wave * 16384), gw, NGW, F.lane); }
        }
        if (BOTH(0)) GRID_BAR();
        TS_MARK(0);
    }

    if (IN(1)) REP(1) {
        PHASE_PTRS(); const float* x = KIN(0); const float* g_norm1 = KIN(4); const float* MOD = P_MOD; bf16* HB = P_HB;
        if ((F.G & 3) == 0 && (SEQ % (NGW >> 2)) == 0) {
            const int b = F.vcu & 3, r0 = (F.vcu >> 2) * NWAVES + F.wave, rstep = NGW >> 2, nrow = SEQ / rstep;
            const float* modb = MOD + b * 12288;
            LAS f32x4* sal = (LAS f32x4*)(F.lds + RING_OFF);
            { const f32x4 g = *(const f32x4*)(g_norm1 + 4 * F.tid), scl = *(const f32x4*)(modb + 2048 + 4 * F.tid); sal[512 + F.tid] = g * (scl + 1.0f); sal[F.tid] = *(const f32x4*)(modb + 4 * F.tid); }
            __syncthreads();
            LAS f32x4* sgl = sal + F.lane; asm volatile("" : "+v"(sgl));
            const unsigned voff = (unsigned)F.lane * 16u;
#define P1_LOADA(V, row) do { const float* b_ = x + (size_t)(row) * DM; _Pragma("unroll") for (int j = 0; j < 8; ++j) \
                asm volatile("s_nop 4\n\tglobal_load_dwordx4 %0, %1, %2 nt" : "=v"(V[j]) : "v"(voff), "s"(b_ + 256 * j) : "memory"); } while (0)
#define P1_WAIT(N) do { asm volatile("s_waitcnt vmcnt(" #N ")" ::: "memory"); __builtin_amdgcn_sched_barrier(0); } while (0)
#define P1_STEP(CUR, NXT, i) do { const int row_ = b * SEQ + r0 + (i) * rstep, nrow_ = b * SEQ + r0 + (((i) + 2 < nrow) ? (i) + 2 : nrow - 1) * rstep; \
                P1_LOADA(NXT, nrow_); P1_WAIT(32); \
                float sq_ = 0.f; _Pragma("unroll") for (int j = 0; j < 8; ++j) sq_ += (CUR[j].x * CUR[j].x + CUR[j].y * CUR[j].y) + (CUR[j].z * CUR[j].z + CUR[j].w * CUR[j].w); \
                const float rstd_ = 1.0f / sqrtf(wave_sum(sq_) * (1.f / DM) + 1e-6f); \
                GAS v2u* o8_ = (GAS v2u*)(HB + (size_t)row_ * DM) + F.lane; \
                _Pragma("unroll") for (int j = 0; j < 8; ++j) { const f32x4 h_ = CUR[j] * rstd_ * sgl[512 + 64 * j] + sgl[64 * j]; v2u w_; w_.x = pk2(h_.x, h_.y); w_.y = pk2(h_.z, h_.w); o8_[64 * j] = w_; } } while (0)
            f32x4 va[8], vb[8], vc[8];
            P1_LOADA(va, b * SEQ + r0); P1_LOADA(vb, b * SEQ + r0 + ((1 < nrow) ? 1 : 0) * rstep); P1_WAIT(0);
            for (int i = 0; i < nrow; i += 3) { P1_STEP(va, vc, i); if (i + 1 < nrow) P1_STEP(vb, va, i + 1); else break; if (i + 2 < nrow) P1_STEP(vc, vb, i + 2); else break; }
            P1_WAIT(0);
            __syncthreads();
#undef P1_LOADA
#undef P1_WAIT
#undef P1_STEP
        } else {
        f32x4 v[8], v1[8], v2[8];
#ifndef P1_NT
#define P1_NT 1
#endif
#ifndef P1_CHUNK
#define P1_CHUNK 0
#endif
#define P1_LOAD(dst, row) do { if ((row) < M) { const GAS f32x4* xr_ = (const GAS f32x4*)(x + (size_t)(row) * DM) + F.lane; _Pragma("unroll") for (int j = 0; j < 8; ++j) dst[j] = P1_NT ? __builtin_nontemporal_load(xr_ + 64 * j) : xr_[64 * j]; } } while (0)
        const bool chunk = P1_CHUNK && (M % F.G == 0) && ((M / F.G) % NWAVES == 0);
        const int mstart = chunk ? F.vcu * (M / F.G) + F.wave : gw, mstep = chunk ? NWAVES : NGW, mend = chunk ? (F.vcu + 1) * (M / F.G) : M;
#define P1_LOADC(dst, row) do { if ((row) < mend) P1_LOAD(dst, row); } while (0)
        P1_LOADC(v1, mstart); P1_LOADC(v2, mstart + mstep);
        for (int m = mstart; m < mend; m += mstep) {
#pragma unroll
            for (int j = 0; j < 8; ++j) { v[j] = v1[j]; v1[j] = v2[j]; }
            P1_LOADC(v2, m + 2 * mstep);
            const int b = m >> 12; const float* modb = MOD + b * 12288;
            float s = 0.f;
#pragma unroll
            for (int j = 0; j < 8; ++j) s += (v[j].x * v[j].x + v[j].y * v[j].y) + (v[j].z * v[j].z + v[j].w * v[j].w);
            const float rstd = 1.0f / sqrtf(wave_sum(s) * (1.f / DM) + 1e-6f);
            GAS v2u* o8 = (GAS v2u*)(HB + (size_t)m * DM) + F.lane;
#pragma unroll
            for (int j = 0; j < 8; ++j) { const int c0 = 256 * j + 4 * F.lane;
                const f32x4 g = *(const f32x4*)(g_norm1 + c0), sh = *(const f32x4*)(modb + c0), scl = *(const f32x4*)(modb + 2048 + c0);
                const f32x4 h = v[j] * rstd * g * (scl + 1.0f) + sh;
                v2u w; w.x = pk2(h.x, h.y); w.y = pk2(h.z, h.w); o8[64 * j] = w; }
        }
#undef P1_LOAD
#undef P1_LOADC
        }
        if (BOTH(1)) GRID_BAR();
        TS_MARK(1);
    }

    if (IN(2)) REP(2) {
        PHASE_PTRS(); bf16* HB = P_HB; bf16* WIN_T = P_WIN_T; bf16* ZB = P_ZB;
        pg8::Gemm g{HB, WIN_T, M, DIN, DM}; pg8::StaticOrder S; S.init(M, DIN, F.G, (int)blockIdx.x);
        pg8::EpiQKV E{ZB, (const float*)(ws + WS_QKW), (LAS float*)(F.lds + RMAP_OFF)};
        pg8::gemm_phase<pg8::EpiQKV, pg8::StaticOrder, true, true>(F.lds + RING_OFF, g, S, E);
        if (BOTH(2)) GRID_BAR();
        TS_MARK(2);
    }

    if (IN(3)) REP(3) {
        const int cgrp = ((int)blockIdx.x >> 3) % 3;
#define P4_AUNIT(i) do { const int w = (i) * F.G + (int)blockIdx.x; if (w < 512) { PHASE_PTRS(); bf16* ZB = P_ZB; bf16* OB = P_OB; \
            const int combo = w & 7, local = w >> 3, b = combo >> 1, kvh = combo & 1, g = local >> 4, qblk = local & 15, h = kvh * 4 + g; \
            const int q0 = qblk * 256; const size_t rowq = (size_t)b * SEQ + q0; \
            int ntA = SEQ / 64; asm volatile("" : "+s"(ntA)); \
            att::attn_unit<false>(ZB + rowq * DIN + h * 128, ZB + (size_t)b * SEQ * DIN + 1024 + kvh * 128, ZB + (size_t)b * SEQ * DIN + 1280 + kvh * 128, \
                                  OB + rowq * DM + h * 128, ntA, 0, 0.f, nullptr, (char*)lds + RING_OFF); } } while (0)
        const int nAu = (512 - (int)blockIdx.x + F.G - 1) / F.G;
        const int nbefore = cgrp < nAu ? cgrp : nAu;
        for (int i = 0; i < nbefore; ++i) P4_AUNIT(i);
        {
            PHASE_PTRS(); __syncthreads();
            adaln_gemv(KIN(1), KIN(2), KIN(3), P_MOD, (float*)(ws + WS_PART), ctl, 16, 32, gw, NGW, F.lane);
            convert_weights<1>(KIN(12), nullptr, nullptr, (unsigned char*)P_WOUT_T, nullptr, (LAS float*)(F.lds + RING_OFF + F.wave * 16384), (NGW == 2048) ? (gw >= 1024 ? gw - 1024 : NGW) : gw, NGW, F.lane);
            convert_experts64(KIN(15), KIN(16), KIN(17), (unsigned char*)P_WGU_T, (unsigned char*)P_WDN_T, (LAS float*)(F.lds + RING_OFF + F.wave * 16384), gw, NGW, F.lane, 32 * 32);
        }
        for (int i = nbefore; i < nAu; ++i) P4_AUNIT(i);
#undef P4_AUNIT
        { PHASE_PTRS(); const float* sink_b = KIN(10); const float* rel_bias = KIN(11); bf16* ZB = P_ZB; bf16* OB = P_OB;
        for (int i = 0; ; ++i) {
            const int w = i * F.G + (int)blockIdx.x; if (w >= 512) break;
            const int combo = w & 7, local = w >> 3, b = combo >> 1, kvh = combo & 1, g = local >> 4, qblk = local & 15, h = kvh * 4 + g;
            const int q0 = qblk * 256; const size_t rowq = (size_t)b * SEQ + q0;
            const int ks = (q0 - 128 < 0) ? 0 : q0 - 128, ke = (q0 + 384 > SEQ) ? SEQ : q0 + 384;
            const size_t rowk = (size_t)b * SEQ + ks;
            att::attn_unit<true>(ZB + rowq * DIN + 1536 + h * 128, ZB + rowk * DIN + 2560 + kvh * 128, ZB + rowk * DIN + 2816 + kvh * 128,
                                 OB + rowq * DM + 1024 + h * 128, (ke - ks) / 64, ks - q0, sink_b[h], rel_bias + h, (char*)lds + RING_OFF);
        }
        }
        __syncthreads();
        if (BOTH(3)) GRID_BAR();
        TS_MARK(3);
    }

    if (IN(4)) REP(4) {
        PHASE_PTRS(); const float* x = KIN(0); float* out = KOUT; const float* MOD = P_MOD; bf16* OB = P_OB; bf16* WOUT_T = P_WOUT_T;
        pg8::Gemm g{OB, WOUT_T, M, DM, DM}; pg8::StaticOrder S; S.init(M, DM, F.G, (int)blockIdx.x);
        pg8::EpiX1 E{x, out, MOD + 4096};
        pg8::gemm_phase<pg8::EpiX1, pg8::StaticOrder, true, true>(F.lds + RING_OFF, g, S, E);
        if (BOTH(4)) GRID_BAR();
        TS_MARK(4);
    }

    if (IN(5)) REP(5) {
        PHASE_PTRS(); const float* g_norm2 = KIN(13); const float* w_router = KIN(14); float* out = KOUT; const float* MOD = P_MOD; bf16* HB = P_HB; float* AFF = P_AFF;
        LAS f32x4* wr = (LAS f32x4*)(F.lds + RING_OFF);
        for (int gidx = F.tid; gidx < 8192; gidx += NWAVES * 64) { const int k = gidx >> 2, q = gidx & 3, j = k >> 8, ln = (k & 255) >> 2, i = k & 3;
            wr[((j * 4 + i) * 4 + q) * 64 + ln] = *(const f32x4*)(w_router + (size_t)gidx * 4); }
        __syncthreads();
        if ((F.G & 3) == 0 && (SEQ % (NGW >> 2)) == 0) {
            const int b = F.vcu & 3, r0 = (F.vcu >> 2) * NWAVES + F.wave, rstep = NGW >> 2, nrow = SEQ / rstep;
            const float* modb = MOD + b * 12288;
            LAS f32x4* sal = (LAS f32x4*)(F.lds + RMAP_OFF);
            sal[F.tid] = *(const f32x4*)(modb + 6144 + 4 * F.tid);
            __syncthreads();
            f32x4 ga[8];
#pragma unroll
            for (int j = 0; j < 8; ++j) { const int c0 = 256 * j + 4 * F.lane; const f32x4 g = *(const f32x4*)(g_norm2 + c0), scl = *(const f32x4*)(modb + 8192 + c0); ga[j] = g * (scl + 1.0f); }
            const unsigned voff = (unsigned)F.lane * 16u;
#define P5_LOADA(V, row) do { const float* b_ = out + (size_t)(row) * DM; _Pragma("unroll") for (int j = 0; j < 8; ++j) \
                asm volatile("s_nop 4\n\tglobal_load_dwordx4 %0, %1, %2" : "=v"(V[j]) : "v"(voff), "s"(b_ + 256 * j) : "memory"); } while (0)
#ifndef P5_RB
#define P5_RB 4
#endif
#define P5_WAIT(N) do { asm volatile("s_waitcnt vmcnt(" #N ")" ::: "memory"); __builtin_amdgcn_sched_barrier(0); } while (0)
#define P5_STEP(CUR, NXT, i) do { const int s_ = r0 + (i) * rstep, row_ = b * SEQ + s_, nrow_ = b * SEQ + r0 + (((i) + 1 < nrow) ? (i) + 1 : (i)) * rstep; \
                P5_LOADA(NXT, nrow_); P5_WAIT(17); \
                float sq_ = 0.f; _Pragma("unroll") for (int j = 0; j < 8; ++j) sq_ += (CUR[j].x * CUR[j].x + CUR[j].y * CUR[j].y) + (CUR[j].z * CUR[j].z + CUR[j].w * CUR[j].w); \
                const float rstd_ = 1.0f / sqrtf(wave_sum(sq_) * (1.f / DM) + 1e-6f); \
                GAS unsigned* o4_ = (GAS unsigned*)((unsigned char*)HB + (size_t)row_ * DM) + F.lane; \
                _Pragma("unroll") for (int j = 0; j < 8; ++j) { CUR[j] = CUR[j] * rstd_ * ga[j] + sal[64 * j + F.lane]; o4_[64 * j] = pk4_fp8(CUR[j].x, CUR[j].y, CUR[j].z, CUR[j].w); } \
                f32x2 l2_[8]; _Pragma("unroll") for (int e = 0; e < 8; ++e) l2_[e] = (f32x2){0.f, 0.f}; \
                _Pragma("unroll") for (int j = 0; j < 8; ++j) { _Pragma("unroll") for (int hb = 0; hb < 4 / P5_RB; ++hb) { f32x4 wv_[P5_RB][4]; \
                    _Pragma("unroll") for (int i2 = 0; i2 < P5_RB; ++i2) _Pragma("unroll") for (int q = 0; q < 4; ++q) wv_[i2][q] = wr[((j * 4 + hb * P5_RB + i2) * 4 + q) * 64 + F.lane]; \
                    __builtin_amdgcn_sched_barrier(0); \
                    _Pragma("unroll") for (int i2 = 0; i2 < P5_RB; ++i2) _Pragma("unroll") for (int q = 0; q < 4; ++q) { const f32x4 wv = wv_[i2][q]; \
                        const f32x2 c2_ = {CUR[j][hb * P5_RB + i2], CUR[j][hb * P5_RB + i2]}; \
                        l2_[2 * q + 0] = __builtin_elementwise_fma(c2_, (f32x2){wv.x, wv.y}, l2_[2 * q + 0]); l2_[2 * q + 1] = __builtin_elementwise_fma(c2_, (f32x2){wv.z, wv.w}, l2_[2 * q + 1]); } \
                    __builtin_amdgcn_sched_barrier(0); } } \
                float lg_[16]; _Pragma("unroll") for (int e = 0; e < 8; ++e) { lg_[2 * e] = l2_[e].x; lg_[2 * e + 1] = l2_[e].y; } \
                float mx_ = -1e30f; _Pragma("unroll") for (int e = 0; e < 16; ++e) { lg_[e] = wave_sum(lg_[e]); mx_ = fmaxf(mx_, lg_[e]); } \
                float den_ = 0.f, mine_ = 0.f; _Pragma("unroll") for (int e = 0; e < 16; ++e) { const float p_ = __expf(lg_[e] - mx_); den_ += p_; if (e == (F.lane & 15)) mine_ = p_; } \
                if (F.lane < 16) AFF[((size_t)b * NE + F.lane) * SEQ + s_] = mine_ / den_; } while (0)
            f32x4 va[8], vb[8];
            P5_LOADA(va, b * SEQ + r0); P5_WAIT(0);
            for (int i = 0; i < nrow; i += 2) { P5_STEP(va, vb, i); if (i + 1 < nrow) P5_STEP(vb, va, i + 1); else break; }
            P5_WAIT(0);
#undef P5_LOADA
#undef P5_WAIT
#undef P5_STEP
        } else {
        for (int m = gw; m < M; m += NGW) {
            const int b = m >> 12, s = m & (SEQ - 1); const float* modb = MOD + b * 12288;
            const GAS f32x4* xr = (const GAS f32x4*)(out + (size_t)m * DM) + F.lane;
            f32x4 v[8]; float sq = 0.f;
#pragma unroll
            for (int j = 0; j < 8; ++j) { v[j] = xr[64 * j]; sq += (v[j].x * v[j].x + v[j].y * v[j].y) + (v[j].z * v[j].z + v[j].w * v[j].w); }
            const float rstd = 1.0f / sqrtf(wave_sum(sq) * (1.f / DM) + 1e-6f);
            GAS unsigned* o4 = (GAS unsigned*)((unsigned char*)HB + (size_t)m * DM) + F.lane;
#pragma unroll
            for (int j = 0; j < 8; ++j) { const int c0 = 256 * j + 4 * F.lane;
                const f32x4 g = *(const f32x4*)(g_norm2 + c0), sh = *(const f32x4*)(modb + 6144 + c0), scl = *(const f32x4*)(modb + 8192 + c0);
                v[j] = v[j] * rstd * g * (scl + 1.0f) + sh;
                o4[64 * j] = pk4_fp8(v[j].x, v[j].y, v[j].z, v[j].w); }
            float lg[16];
#pragma unroll
            for (int e = 0; e < 16; ++e) lg[e] = 0.f;
#pragma unroll
            for (int j = 0; j < 8; ++j) {
#pragma unroll
                for (int i = 0; i < 4; ++i)
#pragma unroll
                    for (int q = 0; q < 4; ++q) { const f32x4 wv = wr[((j * 4 + i) * 4 + q) * 64 + F.lane];
                        lg[4 * q + 0] = fmaf(v[j][i], wv.x, lg[4 * q + 0]); lg[4 * q + 1] = fmaf(v[j][i], wv.y, lg[4 * q + 1]);
                        lg[4 * q + 2] = fmaf(v[j][i], wv.z, lg[4 * q + 2]); lg[4 * q + 3] = fmaf(v[j][i], wv.w, lg[4 * q + 3]); }
                __builtin_amdgcn_sched_barrier(0); }
            float mx = -1e30f;
#pragma unroll
            for (int e = 0; e < 16; ++e) { lg[e] = wave_sum(lg[e]); mx = fmaxf(mx, lg[e]); }
            float den = 0.f, mine = 0.f;
#pragma unroll
            for (int e = 0; e < 16; ++e) { const float p = __expf(lg[e] - mx); den += p; if (e == (F.lane & 15)) mine = p; }
            if (F.lane < 16) AFF[((size_t)b * NE + F.lane) * SEQ + s] = mine / den;
        }
        }
        __syncthreads();
        if (BOTH(5)) GRID_BAR();
        TS_MARK(5);
    }

    if (IN(6)) REP(6) {
        PHASE_PTRS(); const float* AFF = P_AFF; int* IDX = P_IDX; float* GVR = P_GVR; int* INV = P_INV; int* RMAP = P_RMAP;
        LAS unsigned* cnts = (LAS unsigned*)(F.lds + RING_OFF);
        for (int u = (int)blockIdx.x; u < NB * NE * 4; u += F.G) {
            const int p = u >> 2, qd = u & 3;
            const int b = p >> 4, e = p & 15; const float* af = AFF + (size_t)p * SEQ;
            const int s0 = F.tid * 8;
            const f32x4 a0 = *(const f32x4*)(af + s0), a1 = *(const f32x4*)(af + s0 + 4);
            float av[8] = {a0.x, a0.y, a0.z, a0.w, a1.x, a1.y, a1.z, a1.w};
            unsigned key[8];
#pragma unroll
            for (int j = 0; j < 8; ++j) key[j] = __builtin_bit_cast(unsigned, av[j]);
            unsigned prefix = 0u;
            __syncthreads();
            for (int bit = 31; bit >= 1; bit -= 2) {
                const unsigned hb = 1u << bit, lb = 1u << (bit - 1);
                const unsigned c10 = prefix | hb, c11 = c10 | lb, c01 = prefix | lb;
                unsigned n10 = 0, n11 = 0, n01 = 0;
#pragma unroll
                for (int j = 0; j < 8; ++j) { n10 += (unsigned)__builtin_popcountll(__ballot(key[j] >= c10)); n11 += (unsigned)__builtin_popcountll(__ballot(key[j] >= c11));
                                              n01 += (unsigned)__builtin_popcountll(__ballot(key[j] >= c01)); }
                LAS unsigned* cb = cnts + ((bit >> 1) & 1) * 24;
                if (F.lane == 0) { cb[F.wave] = n10; cb[8 + F.wave] = n11; cb[16 + F.wave] = n01; }
                __syncthreads();
                unsigned t10 = 0, t11 = 0, t01 = 0;
#pragma unroll
                for (int w = 0; w < 8; ++w) { t10 += cb[w]; t11 += cb[8 + w]; t01 += cb[16 + w]; }
                if (t10 >= (unsigned)CAP) prefix = (t11 >= (unsigned)CAP) ? c11 : c10;
                else if (t01 >= (unsigned)CAP) prefix = c01;
            }
            const unsigned T = prefix;
            unsigned cg = 0, ce = 0;
#pragma unroll
            for (int j = 0; j < 8; ++j) { cg += key[j] > T; ce += key[j] == T; }
            unsigned pk = cg | (ce << 16), inc = pk;
#pragma unroll
            for (int o = 1; o < 64; o <<= 1) { const unsigned t = __shfl_up(inc, o); if (F.lane >= o) inc += t; }
            __syncthreads();
            if (F.lane == 63) cnts[48 + F.wave] = inc;
            __syncthreads();
            unsigned base = 0, total = 0;
#pragma unroll
            for (int w = 0; w < 8; ++w) { const unsigned t = cnts[48 + w]; if (w < F.wave) base += t; total += t; }
            const unsigned excl = base + inc - pk;
            unsigned rg = excl & 0xffffu, re = excl >> 16;
            const unsigned need = (unsigned)CAP - (total & 0xffffu);
            if ((F.tid >> 7) == qd) {
#pragma unroll
            for (int j = 0; j < 8; ++j) {
                const int s = s0 + j; int slot = -1;
                if (key[j] > T) { slot = (int)(rg + (re < need ? re : need)); ++rg; }
                else if (key[j] == T) { if (re < need) slot = (int)(rg + re); ++re; }
                INV[((size_t)b * SEQ + s) * NE + e] = slot;
                if (slot >= 0) { IDX[p * CAP + slot] = s; GVR[e * (NB * CAP) + b * CAP + slot] = av[j]; RMAP[e * (NB * CAP) + b * CAP + slot] = b * SEQ + s; }
            }
            }
        }
        __syncthreads();
        if (BOTH(6)) GRID_BAR();
        TS_MARK(6);
    }

    if (IN(7)) REP(7) {
        PHASE_PTRS(); const unsigned char* H8 = (const unsigned char*)P_HB; const unsigned char* WGU_T = (const unsigned char*)P_WGU_T; unsigned char* ACT = (unsigned char*)P_ACT; const int* RMAP = P_RMAP;
        pg8::OrderGU S{F.G, (int)blockIdx.x};
        LAS int* rm = (LAS int*)(F.lds + RMAP_OFF);
        { pg8::Unit u; for (int i = (F.tid >> 8); i < 8; i += 2) { if (S.next(i, u)) rm[i * 256 + (F.tid & 255)] = RMAP[u.pm * 256 + (F.tid & 255)]; } }
        __syncthreads();
        pg8::Gemm g{(const pg8::bf16_t*)H8, (const pg8::bf16_t*)WGU_T, RE, 2 * DE, DM};
        pg8::EpiSwiGLU E{ACT};
        pg8::gemm_phase<pg8::EpiSwiGLU, pg8::OrderGU, true, true, true, true>(F.lds + RING_OFF, g, S, E, rm);
        if (BOTH(7)) GRID_BAR();
        TS_MARK(7);
    }

    if (IN(8)) REP(8) {
        PHASE_PTRS(); const unsigned char* ACT = (const unsigned char*)P_ACT; const unsigned char* WDN_T = (const unsigned char*)P_WDN_T; bf16* YB = P_YB; const float* GVR = P_GVR;
        pg8::Gemm g{(const pg8::bf16_t*)ACT, (const pg8::bf16_t*)WDN_T, RE, DM, DE}; pg8::OrderDN S{F.G, (int)blockIdx.x};
        pg8::EpiDown E{YB, GVR};
        pg8::gemm_phase<pg8::EpiDown, pg8::OrderDN, true, true, true, false>(F.lds + RING_OFF, g, S, E);
        if (BOTH(8)) GRID_BAR();
        TS_MARK(8);
    }

    if (IN(9)) {
        PHASE_PTRS(); float* out = KOUT; const float* MOD = P_MOD; const bf16* YB = P_YB; const int* INV = P_INV; const float* GVR = P_GVR;
        f32x4 v[8], vn[8]; int inv_n = -1;
        if (gw < M) { inv_n = INV[(size_t)gw * NE + (F.lane & 15)]; const GAS f32x4* xr = (const GAS f32x4*)(out + (size_t)gw * DM) + F.lane;
#pragma unroll
            for (int j = 0; j < 8; ++j) vn[j] = __builtin_nontemporal_load(xr + 64 * j); }
        for (int t = gw; t < M; t += NGW) {
            const int b = t >> 12; const float* gt2 = MOD + b * 12288 + 10240;
            const int inv = inv_n;
            f32x4 acc[8];
#pragma unroll
            for (int j = 0; j < 8; ++j) { v[j] = vn[j]; acc[j] = (f32x4){0.f, 0.f, 0.f, 0.f}; }
            if (t + NGW < M) { inv_n = INV[(size_t)(t + NGW) * NE + (F.lane & 15)]; const GAS f32x4* xr = (const GAS f32x4*)(out + (size_t)(t + NGW) * DM) + F.lane;
#pragma unroll
                for (int j = 0; j < 8; ++j) vn[j] = __builtin_nontemporal_load(xr + 64 * j); }
            unsigned mask = (unsigned)(__ballot(inv >= 0) & 0xffffull);
            while (mask) {
                const int e = __builtin_ctz(mask); mask &= mask - 1;
                const int slot = __builtin_amdgcn_readlane(inv, e);
                const size_t yrow = (size_t)e * (NB * CAP) + b * CAP + slot;
                const GAS unsigned* yr = (const GAS unsigned*)((const unsigned char*)YB + yrow * DM) + F.lane;
                const float g = __hip_atomic_load(GVR + yrow, __ATOMIC_RELAXED, __HIP_MEMORY_SCOPE_AGENT) * (1.f / YSCALE);
                unsigned w[8];
#pragma unroll
                for (int j = 0; j < 8; ++j) w[j] = __builtin_nontemporal_load(yr + 64 * j);
#pragma unroll
                for (int j = 0; j < 8; ++j) { const auto lo_ = __builtin_amdgcn_cvt_pk_f32_fp8((int)w[j], false), hi_ = __builtin_amdgcn_cvt_pk_f32_fp8((int)w[j], true);
                    acc[j].x = fmaf(g, lo_[0], acc[j].x); acc[j].y = fmaf(g, lo_[1], acc[j].y); acc[j].z = fmaf(g, hi_[0], acc[j].z); acc[j].w = fmaf(g, hi_[1], acc[j].w); }
            }
            GAS f32x4* xw = (GAS f32x4*)(out + (size_t)t * DM) + F.lane;
#pragma unroll
            for (int j = 0; j < 8; ++j) { const f32x4 g = *(const f32x4*)(gt2 + 256 * j + 4 * F.lane); __builtin_nontemporal_store(v[j] + g * acc[j], xw + 64 * j); }
        }
    }
    if (TS_A >= 0 && blockIdx.x == 0) { TS_SLOT(10); __syncthreads(); const unsigned d = F.MISC[16 + (TS_B >= 0 ? TS_B : 0)] - F.MISC[16 + (TS_A >= 0 ? TS_A : 0)];
        const unsigned long long target = __builtin_amdgcn_s_memrealtime() + (unsigned long long)TS_F * d;
        while (__builtin_amdgcn_s_memrealtime() < target) __builtin_amdgcn_s_sleep(20); }
#undef IN
#undef BOTH
#undef GRID_BAR
}

extern "C" void kernel_launch(void* const* d_in, const int* in_sizes, int n_in, void* d_out, int out_size, void* d_ws, size_t ws_size, hipStream_t stream) {
    static int grid = 0;
    if (grid == 0) {
        if (n_in != 18 || in_sizes[0] != M * DM || out_size != M * DM || ws_size < WS_END) { fprintf(stderr, "kernel_launch: shape/workspace mismatch (n_in %d, in0 %d, out %d, ws %zu)\n", n_in, n_in > 0 ? in_sizes[0] : -1, out_size, ws_size); grid = -1; return; }
        int dev = 0, cus = 0, per_cu = 0;
        if (hipGetDevice(&dev) != hipSuccess || hipDeviceGetAttribute(&cus, hipDeviceAttributeMultiprocessorCount, dev) != hipSuccess) { grid = -1; return; }
        if (hipFuncSetAttribute((const void*)fwd_kernel, hipFuncAttributeMaxDynamicSharedMemorySize, LDS_BYTES) != hipSuccess) { fprintf(stderr, "kernel_launch: hipFuncSetAttribute failed\n"); grid = -1; return; }
        if (hipOccupancyMaxActiveBlocksPerMultiprocessor(&per_cu, (const void*)fwd_kernel, NWAVES * 64, LDS_BYTES) != hipSuccess || per_cu < 1)
            fprintf(stderr, "kernel_launch: note: occupancy query reports %d workgroups per CU\n", per_cu);
        (void)hipGetLastError();
        grid = cus;
    }
    if (grid < 0) return;
    if (hipMemsetAsync((char*)d_ws + WS_CTL, 0, CTL_ZERO_BYTES, stream) != hipSuccess) return;
    Args a{};
    for (int i = 0; i < 18; ++i) a.in[i] = (const float*)d_in[i];
    a.out = (float*)d_out; a.ws = (unsigned char*)d_ws;
#if MK_PER_PHASE
    for (int p = 0; p < N_PHASES; ++p) { a.ph_lo = p; a.ph_hi = p + 1; hipLaunchKernelGGL(fwd_kernel, dim3(grid), dim3(NWAVES * 64), LDS_BYTES, stream, a); }
#else
    a.ph_lo = 0; a.ph_hi = N_PHASES; hipLaunchKernelGGL(fwd_kernel, dim3(grid), dim3(NWAVES * 64), LDS_BYTES, stream, a);
#endif
    const hipError_t le = hipPeekAtLastError();
    if (le != hipSuccess) fprintf(stderr, "kernel_launch: launch failed: %s\n", hipGetErrorName(le));
}
```
